# Optimizing an MI355X kernel written in HIP

```python
import math
import jax
import jax.numpy as jnp
from jax import lax
import numpy as np

D_MODEL = 2048
BATCH = 4
SEQ = 8192
DEPTH = 4
DEC_BATCH = 2
DEC_SEQ = 4096
PAST_LEN = 128

N_MIXERS = 4
N_DN = (DEPTH + 3) // N_MIXERS
N_S5 = (DEPTH + 2) // N_MIXERS
N_SSD = (DEPTH + 1) // N_MIXERS
N_HY = DEPTH // N_MIXERS

D_FF = -(-(8 * D_MODEL) // (3 * 256)) * 256
EPS = 1e-6
CONV_K = 5
HY_CONV_K = 3

DN_HEADS = 16
DN_HEAD_DIM = D_MODEL // DN_HEADS
DN_WIDTH = DN_HEADS * DN_HEAD_DIM
DN_CHUNK = 64
DN_IN = 4 * DN_WIDTH + 4 * DN_HEADS

S5_GROUP = 16
S5_GROUPS = D_MODEL // S5_GROUP
S5_STATE = 64

SSD_INNER = 2 * D_MODEL
SSD_HEAD_DIM = 64
SSD_HEADS = SSD_INNER // SSD_HEAD_DIM
SSD_GROUPS = 8
SSD_HPG = SSD_HEADS // SSD_GROUPS
SSD_STATE = 128
SSD_CHUNK = 128
SSD_CONV_CH = SSD_INNER + 2 * SSD_GROUPS * SSD_STATE
SSD_IN = SSD_INNER + SSD_CONV_CH + 2 * SSD_HEADS

HY_EMB = 33
HY_BANDS = (HY_EMB - 1) // 2
HY_FW = 64
HY_TARGET = 1e-2
HY_FAST = 0.3
HY_SLOW = 1.5

kernel_name = 'hybrid_bidir_encoder_trunk'


def rmsnorm(x, g):
    x32 = x.astype(jnp.float32)
    y = x32 * lax.rsqrt(jnp.mean(x32 * x32, axis=-1, keepdims=True) + EPS)
    return (y * g.astype(jnp.float32)).astype(x.dtype)


def l2norm(x):
    return x * lax.rsqrt(jnp.sum(x * x, axis=-1, keepdims=True) + EPS)


def centred_dwconv(x, w):
    k_width = w.shape[0]
    pad = k_width // 2
    length = x.shape[1]
    xp = jnp.pad(x, ((0, 0), (pad, pad), (0, 0)))
    out = xp[:, 0:length] * w[0]
    for tap in range(1, k_width):
        out = out + xp[:, tap:tap + length] * w[tap]
    return out


def _gated_delta_chunked(q, k, v, g, beta):
    b_, h_, length, dk = q.shape
    dv = v.shape[-1]
    c_ = DN_CHUNK
    n_chunks = length // c_

    def chunks(t):
        return jnp.moveaxis(t.reshape(b_, h_, n_chunks, c_, *t.shape[3:]), 2, 0)

    qc, kc, vc, gc, bc = (chunks(t) for t in (q, k, v, g, beta))
    gc = jnp.cumsum(gc, axis=-1)
    incl = jnp.tril(jnp.ones((c_, c_), bool))
    strict = jnp.tril(jnp.ones((c_, c_), bool), -1)

    def step(state, inp):
        qi, ki, vi, gi, bi = inp
        decay = jnp.exp(jnp.where(incl, gi[..., :, None] - gi[..., None, :], -jnp.inf))
        kb = ki * bi[..., None]
        a_mat = jnp.where(strict, jnp.einsum('bhik,bhjk->bhij', kb, ki) * decay, 0.0)
        rhs = jnp.concatenate([vi * bi[..., None], kb * jnp.exp(gi)[..., None]], axis=-1)
        sol = lax.linalg.triangular_solve(a_mat, rhs, left_side=True, lower=True, unit_diagonal=True)
        u, w = sol[..., :dv], sol[..., dv:]
        v_new = u - jnp.einsum('bhik,bhkv->bhiv', w, state)
        scores = jnp.where(incl, jnp.einsum('bhik,bhjk->bhij', qi, ki) * decay, 0.0)
        o = (jnp.einsum('bhik,bhkv->bhiv', qi * jnp.exp(gi)[..., None], state)
             + jnp.einsum('bhij,bhjv->bhiv', scores, v_new))
        g_last = gi[..., -1]
        state = (state * jnp.exp(g_last)[..., None, None]
                 + jnp.einsum('bhik,bhiv->bhkv', ki * jnp.exp(g_last[..., None] - gi)[..., None], v_new))
        return state, o

    s0 = jnp.zeros((b_, h_, dk, dv), jnp.float32)
    _, o = lax.scan(step, s0, (qc, kc, vc, gc, bc))
    return jnp.moveaxis(o, 0, 2).reshape(b_, h_, length, dv)


def deltanet_mixer(h, w_in, conv_w, a_log, dt_bias, norm_g, w_out):
    b_, length, _ = h.shape
    nh, hd, wd = DN_HEADS, DN_HEAD_DIM, DN_WIDTH
    proj = h @ w_in
    qkv = jax.nn.silu(centred_dwconv(proj[..., :3 * wd], conv_w)).astype(jnp.float32)
    z = proj[..., 3 * wd:4 * wd].astype(jnp.float32)
    b_raw = proj[..., 4 * wd:4 * wd + 2 * nh].reshape(b_, length, 2, nh).astype(jnp.float32)
    a_raw = proj[..., 4 * wd + 2 * nh:].reshape(b_, length, 2, nh).astype(jnp.float32)
    beta = jax.nn.sigmoid(b_raw).transpose(0, 2, 3, 1)
    g = (-jnp.exp(a_log.astype(jnp.float32))
         * jax.nn.softplus(a_raw + dt_bias.astype(jnp.float32))).transpose(0, 2, 3, 1)

    def heads(t):
        return t.reshape(b_, length, nh, hd).transpose(0, 2, 1, 3)

    q = l2norm(heads(qkv[..., :wd])) * (hd ** -0.5)
    k = l2norm(heads(qkv[..., wd:2 * wd]))
    v = heads(qkv[..., 2 * wd:])
    o_f = _gated_delta_chunked(q, k, v, g[:, 0], beta[:, 0])
    o_b = jnp.flip(_gated_delta_chunked(jnp.flip(q, 2), jnp.flip(k, 2), jnp.flip(v, 2),
                                        jnp.flip(g[:, 1], 2), jnp.flip(beta[:, 1], 2)), 2)
    o = (o_f + o_b).transpose(0, 2, 1, 3)
    o = rmsnorm(o, norm_g) * jax.nn.silu(z.reshape(b_, length, nh, hd))
    return o.reshape(b_, length, wd).astype(h.dtype) @ w_out


def _s5_discretise(lam_re, lam_im, log_step, b_re, b_im):
    step = jnp.exp(log_step.astype(jnp.float32))[:, None]
    lr = jnp.minimum(lam_re.astype(jnp.float32), -1e-4)
    li = lam_im.astype(jnp.float32)
    mag = jnp.exp(lr * step)
    ar = mag * jnp.cos(li * step)
    ai = mag * jnp.sin(li * step)
    den = lr * lr + li * li
    nr = ar - 1.0
    cr = (nr * lr + ai * li) / den
    ci = (ai * lr - nr * li) / den
    br, bi = b_re.astype(jnp.float32), b_im.astype(jnp.float32)
    bbr = cr[..., None] * br - ci[..., None] * bi
    bbi = cr[..., None] * bi + ci[..., None] * br
    return ar, ai, bbr, bbi


def _complex_affine_combine(e1, e2):
    a1r, a1i, b1r, b1i = e1
    a2r, a2i, b2r, b2i = e2
    return (a2r * a1r - a2i * a1i, a2r * a1i + a2i * a1r,
            a2r * b1r - a2i * b1i + b2r, a2r * b1i + a2i * b1r + b2i)


def s5_mixer(h, lam_re, lam_im, log_step, b_re, b_im, c_re, c_im, d, w_glu, b_glu):
    _, length, dm = h.shape
    disc = [_s5_discretise(lam_re[j], lam_im[j], log_step[j], b_re, b_im) for j in range(2)]
    d32 = d.astype(jnp.float32)

    def one_sequence(u):
        u32 = u.astype(jnp.float32)
        ug = u32.reshape(length, S5_GROUPS, S5_GROUP)
        y = u32 * d32
        for j in range(2):
            ar, ai, bbr, bbi = disc[j]
            bur = jnp.einsum('lgc,gpc->lgp', ug, bbr)
            bui = jnp.einsum('lgc,gpc->lgp', ug, bbi)
            elems = (jnp.broadcast_to(ar, bur.shape), jnp.broadcast_to(ai, bur.shape), bur, bui)
            _, _, xr, xi = lax.associative_scan(_complex_affine_combine, elems, reverse=(j == 1), axis=0)
            yj = (jnp.einsum('gcp,lgp->lgc', c_re[j].astype(jnp.float32), xr)
                  - jnp.einsum('gcp,lgp->lgc', c_im[j].astype(jnp.float32), xi))
            y = y + yj.reshape(length, dm)
        return y

    y = jax.nn.gelu(lax.map(one_sequence, h))
    return (y * jax.nn.sigmoid(y @ w_glu + b_glu)).astype(h.dtype)


def _ssd_chunked(x, a, bm, cm):
    b_, length, ng, hg, hp = x.shape
    ns = bm.shape[-1]
    c_ = SSD_CHUNK
    n_chunks = length // c_

    def chunks(t):
        return jnp.moveaxis(t.reshape(b_, n_chunks, c_, *t.shape[2:]), 1, 0)

    xc, ac, bc, cc = (chunks(t) for t in (x, a, bm, cm))
    incl = jnp.tril(jnp.ones((c_, c_), bool))[None, :, :, None, None]

    def step(state, inp):
        xi, ai, bi, ci = inp
        cum = jnp.cumsum(ai, axis=1)
        seg = jnp.exp(jnp.where(incl, cum[:, :, None] - cum[:, None, :], -jnp.inf))
        cb = jnp.einsum('blgn,bsgn->blsg', ci, bi)
        y = jnp.einsum('blsg,blsgh,bsghp->blghp', cb, seg, xi)
        y = y + jnp.einsum('blgn,bghpn,blgh->blghp', ci, state, jnp.exp(cum))
        last = cum[:, -1]
        state = (state * jnp.exp(last)[..., None, None]
                 + jnp.einsum('blgn,blgh,blghp->bghpn', bi, jnp.exp(last[:, None] - cum), xi))
        return state, y

    s0 = jnp.zeros((b_, ng, hg, hp, ns), jnp.float32)
    _, y = lax.scan(step, s0, (xc, ac, bc, cc))
    return jnp.moveaxis(y, 0, 1).reshape(b_, length, ng, hg, hp)


def ssd_mixer(h, w_in, conv_w, a_log, dt_bias, d, norm_g, w_out):
    b_, length, _ = h.shape
    di, ng, ns, nh, hpg = SSD_INNER, SSD_GROUPS, SSD_STATE, SSD_HEADS, SSD_HPG
    proj = h @ w_in
    z = proj[..., :di].astype(jnp.float32)
    xbc = jax.nn.silu(centred_dwconv(proj[..., di:di + SSD_CONV_CH], conv_w)).astype(jnp.float32)
    dt_raw = proj[..., di + SSD_CONV_CH:].reshape(b_, length, 2, nh).astype(jnp.float32)
    x = xbc[..., :di].reshape(b_, length, ng, hpg, SSD_HEAD_DIM)
    bm = xbc[..., di:di + ng * ns].reshape(b_, length, ng, ns)
    cm = xbc[..., di + ng * ns:].reshape(b_, length, ng, ns)
    dt = jax.nn.softplus(dt_raw + dt_bias.astype(jnp.float32))
    a_cont = -jnp.exp(a_log.astype(jnp.float32))
    y = x * d.astype(jnp.float32).reshape(ng, hpg)[..., None]
    for j in range(2):
        dtj = dt[:, :, j].reshape(b_, length, ng, hpg)
        aj = dtj * a_cont[j].reshape(ng, hpg)
        xj = x * dtj[..., None]
        if j == 0:
            y = y + _ssd_chunked(xj, aj, bm, cm)
        else:
            y = y + jnp.flip(_ssd_chunked(jnp.flip(xj, 1), jnp.flip(aj, 1),
                                          jnp.flip(bm, 1), jnp.flip(cm, 1)), 1)
    y = y.reshape(b_, length, di) * jax.nn.silu(z)
    y = rmsnorm(y.reshape(b_, length, ng, di // ng), norm_g.reshape(ng, di // ng))
    return y.reshape(b_, length, di).astype(h.dtype) @ w_out


def _hyena_filters(length, fw1, fb1, fw2, fb2, fw3, fb3, fw_out, freq):
    f32 = jnp.float32
    t = jnp.linspace(0.0, 1.0, length, dtype=f32)[:, None]
    w = 2.0 * math.pi * jnp.arange(length, dtype=f32)[:, None] / length
    fr = jnp.linspace(1e-4, HY_BANDS - 1, HY_BANDS, dtype=f32)[None]
    z = jnp.concatenate([t, jnp.cos(fr * w), -jnp.sin(fr * w)], axis=-1)
    fq = freq.astype(f32)
    hd = jnp.sin(fq[0] * (z @ fw1.astype(f32) + fb1.astype(f32)))
    hd = jnp.sin(fq[1] * (hd @ fw2.astype(f32) + fb2.astype(f32)))
    hd = jnp.sin(fq[2] * (hd @ fw3.astype(f32) + fb3.astype(f32)))
    filt = hd @ fw_out.astype(f32)
    max_decay = math.log(HY_TARGET) / HY_FAST
    min_decay = math.log(HY_TARGET) / HY_SLOW
    deltas = jnp.linspace(min_decay, max_decay, D_MODEL, dtype=f32)
    window = jnp.exp(-t * jnp.abs(deltas))
    filt = filt.reshape(length, 2, D_MODEL) * window[:, None]
    return filt[:, 0], filt[:, 1]


def hyena_mixer(h, w_in, b_in, conv_w, fw1, fb1, fw2, fb2, fw3, fb3, fw_out, freq,
                filt_bias, w_out, b_out):
    _, length, dm = h.shape
    u = centred_dwconv(h @ w_in + b_in, conv_w).astype(jnp.float32)
    x0, x1, v = u[..., :dm], u[..., dm:2 * dm], u[..., 2 * dm:]
    h_fwd, h_bwd = _hyena_filters(length, fw1, fb1, fw2, fb2, fw3, fb3, fw_out, freq)
    filt = jnp.concatenate([h_fwd, jnp.zeros((1, dm), jnp.float32), h_bwd[:0:-1]], axis=0)
    s = v * x1
    spec = jnp.fft.rfft(s, n=2 * length, axis=1) * jnp.fft.rfft(filt, n=2 * length, axis=0)
    y = jnp.fft.irfft(spec, n=2 * length, axis=1)[:, :length] + s * filt_bias.astype(jnp.float32)
    y = y * x0
    return y.astype(h.dtype) @ w_out + b_out


def setup_inputs(seed: int = 0) -> dict:
    key = jax.random.key(seed)
    keys = jax.random.split(key, 64)
    counter = [0]

    def nk():
        counter[0] += 1
        return keys[counter[0] - 1]

    def nrm(shape, scale):
        return jax.random.normal(nk(), shape, jnp.float32) * scale

    def unif(shape, lo, hi):
        return jax.random.uniform(nk(), shape, jnp.float32, lo, hi)

    def gain(shape):
        return 1.0 + nrm(shape, 0.02)

    def dt_bias(shape):
        dt = jnp.exp(unif(shape, math.log(1e-3), math.log(1e-1)))
        return dt + jnp.log(-jnp.expm1(-dt))

    dm = D_MODEL
    return {
        'x_prompt': nrm((BATCH, SEQ, dm), 1.0),
        'x_sample': nrm((DEC_BATCH, DEC_SEQ, dm), 1.0),
        'c_prompt': nrm((BATCH, dm), 1.0),
        'c_sample': nrm((DEC_BATCH, dm), 1.0),
        'ada_w': nrm((DEPTH, dm, 6 * dm), 0.5 * dm ** -0.5),
        'ada_b': nrm((DEPTH, 6 * dm), 0.02),
        'norm_g': gain((DEPTH, 4, dm)),
        'ffn_wg': nrm((DEPTH, dm, D_FF), dm ** -0.5),
        'ffn_wu': nrm((DEPTH, dm, D_FF), dm ** -0.5),
        'ffn_wd': nrm((DEPTH, D_FF, dm), D_FF ** -0.5),
        'dn_w_in': nrm((N_DN, dm, DN_IN), dm ** -0.5),
        'dn_conv': nrm((N_DN, CONV_K, 3 * DN_WIDTH), CONV_K ** -0.5),
        'dn_a_log': jnp.log(unif((N_DN, 2, DN_HEADS), 1.0, 16.0)),
        'dn_dt_bias': dt_bias((N_DN, 2, DN_HEADS)),
        'dn_norm': gain((N_DN, DN_HEAD_DIM)),
        'dn_w_out': nrm((N_DN, DN_WIDTH, dm), DN_WIDTH ** -0.5),
        's5_lam_re': -0.5 + nrm((N_S5, 2, S5_GROUPS, S5_STATE), 0.01),
        's5_lam_im': math.pi * jnp.arange(S5_STATE, dtype=jnp.float32) + nrm((N_S5, 2, S5_GROUPS, S5_STATE), 0.01),
        's5_log_step': unif((N_S5, 2, S5_GROUPS), math.log(1e-3), math.log(1e-1)),
        's5_b_re': nrm((N_S5, S5_GROUPS, S5_STATE, S5_GROUP), (2 * S5_GROUP) ** -0.5),
        's5_b_im': nrm((N_S5, S5_GROUPS, S5_STATE, S5_GROUP), (2 * S5_GROUP) ** -0.5),
        's5_c_re': nrm((N_S5, 2, S5_GROUPS, S5_GROUP, S5_STATE), (2 * S5_STATE) ** -0.5),
        's5_c_im': nrm((N_S5, 2, S5_GROUPS, S5_GROUP, S5_STATE), (2 * S5_STATE) ** -0.5),
        's5_d': nrm((N_S5, dm), 1.0),
        's5_w_glu': nrm((N_S5, dm, dm), dm ** -0.5),
        's5_b_glu': nrm((N_S5, dm), 0.02),
        'ssd_w_in': nrm((N_SSD, dm, SSD_IN), dm ** -0.5),
        'ssd_conv': nrm((N_SSD, CONV_K, SSD_CONV_CH), CONV_K ** -0.5),
        'ssd_a_log': jnp.log(unif((N_SSD, 2, SSD_HEADS), 1.0, 16.0)),
        'ssd_dt_bias': dt_bias((N_SSD, 2, SSD_HEADS)),
        'ssd_d': 1.0 + nrm((N_SSD, SSD_HEADS), 0.1),
        'ssd_norm': gain((N_SSD, SSD_INNER)),
        'ssd_w_out': nrm((N_SSD, SSD_INNER, dm), SSD_INNER ** -0.5),
        'hy_w_in': nrm((N_HY, dm, 3 * dm), dm ** -0.5),
        'hy_b_in': nrm((N_HY, 3 * dm), 0.02),
        'hy_conv': nrm((N_HY, HY_CONV_K, 3 * dm), HY_CONV_K ** -0.5),
        'hy_fw1': nrm((N_HY, HY_EMB, HY_FW), HY_EMB ** -0.5),
        'hy_fb1': nrm((N_HY, HY_FW), 0.02),
        'hy_fw2': nrm((N_HY, HY_FW, HY_FW), HY_FW ** -0.5),
        'hy_fb2': nrm((N_HY, HY_FW), 0.02),
        'hy_fw3': nrm((N_HY, HY_FW, HY_FW), HY_FW ** -0.5),
        'hy_fb3': nrm((N_HY, HY_FW), 0.02),
        'hy_fw_out': nrm((N_HY, HY_FW, 2 * dm), HY_FW ** -0.5),
        'hy_freq': 1.0 + nrm((N_HY, 3, HY_FW), 0.02),
        'hy_filt_bias': nrm((N_HY, dm), 1.0),
        'hy_w_out': nrm((N_HY, dm, dm), dm ** -0.5),
        'hy_b_out': nrm((N_HY, dm), 0.02),
    }


def reference(x_prompt, x_sample, c_prompt, c_sample,
              ada_w, ada_b, norm_g, ffn_wg, ffn_wu, ffn_wd,
              dn_w_in, dn_conv, dn_a_log, dn_dt_bias, dn_norm, dn_w_out,
              s5_lam_re, s5_lam_im, s5_log_step, s5_b_re, s5_b_im, s5_c_re, s5_c_im,
              s5_d, s5_w_glu, s5_b_glu,
              ssd_w_in, ssd_conv, ssd_a_log, ssd_dt_bias, ssd_d, ssd_norm, ssd_w_out,
              hy_w_in, hy_b_in, hy_conv, hy_fw1, hy_fb1, hy_fw2, hy_fb2, hy_fw3, hy_fb3,
              hy_fw_out, hy_freq, hy_filt_bias, hy_w_out, hy_b_out):

    def token_mixer(i, h):
        m, j = i % N_MIXERS, i // N_MIXERS
        if m == 0:
            return deltanet_mixer(h, dn_w_in[j], dn_conv[j], dn_a_log[j], dn_dt_bias[j],
                                  dn_norm[j], dn_w_out[j])
        if m == 1:
            return s5_mixer(h, s5_lam_re[j], s5_lam_im[j], s5_log_step[j], s5_b_re[j], s5_b_im[j],
                            s5_c_re[j], s5_c_im[j], s5_d[j], s5_w_glu[j], s5_b_glu[j])
        if m == 2:
            return ssd_mixer(h, ssd_w_in[j], ssd_conv[j], ssd_a_log[j], ssd_dt_bias[j],
                             ssd_d[j], ssd_norm[j], ssd_w_out[j])
        return hyena_mixer(h, hy_w_in[j], hy_b_in[j], hy_conv[j], hy_fw1[j], hy_fb1[j],
                           hy_fw2[j], hy_fb2[j], hy_fw3[j], hy_fb3[j], hy_fw_out[j], hy_freq[j],
                           hy_filt_bias[j], hy_w_out[j], hy_b_out[j])

    def trunk(x, c):
        b_ = x.shape[0]
        c_act = jax.nn.silu(c.astype(jnp.float32))
        for i in range(DEPTH):
            mod = (c_act @ ada_w[i] + ada_b[i]).reshape(b_, 6, 1, D_MODEL)
            shift_m, scale_m, gate_m, shift_f, scale_f, gate_f = (mod[:, k] for k in range(6))
            h = (rmsnorm(x, norm_g[i, 0]) * (1.0 + scale_m) + shift_m).astype(x.dtype)
            h = token_mixer(i, h)
            x = (x + gate_m * rmsnorm(h, norm_g[i, 1])).astype(x.dtype)
            h = (rmsnorm(x, norm_g[i, 2]) * (1.0 + scale_f) + shift_f).astype(x.dtype)
            h = (jax.nn.silu(h @ ffn_wg[i]) * (h @ ffn_wu[i])) @ ffn_wd[i]
            x = (x + gate_f * rmsnorm(h, norm_g[i, 3])).astype(x.dtype)
        return x

    y_prompt = trunk(x_prompt, c_prompt)
    y_sample = trunk(x_sample, c_sample)
    return (y_prompt, y_sample)
```

```cpp
#define MK_PER_PHASE 0
#define DUPMASK 0ull
#include <hip/hip_runtime.h>
#include <cstdio>
#include <cstdint>
namespace pg8 {
#define PG8_LAS __attribute__((address_space(3)))
typedef unsigned short bf16_t;
typedef short bf16x8 __attribute__((ext_vector_type(8)));
typedef float f32x4 __attribute__((ext_vector_type(4)));
typedef unsigned u32x4 __attribute__((ext_vector_type(4)));
constexpr int BM = 256, BK = 64, HALF = 128, HTB = HALF * BK * 2  , STAGE_BYTES = 8 * HTB, NXCD = 8, WGM = 8;

__host__ __device__ __forceinline__ int lds_byte(int r, int c) { const int st = (r >> 4) * 2 + (c >> 5), rr = r & 15, cc = c & 31, ob = rr * 64 + cc * 2; return st * 1024 + (ob ^ (((ob >> 9) & 1) << 5)); }
__host__ __device__ __forceinline__ void stage_rc(int b, int& R, int& C) { const int st = b / 1024, sb = b % 1024, swz = sb ^ (((sb >> 9) & 1) << 5); R = (st >> 1) * 16 + swz / 64; C = (st & 1) * 32 + (swz % 64) / 2; }
__host__ __device__ __forceinline__ int perm32(int rho) { const int n = rho >> 4, i = rho & 15; return 8 * (i >> 2) + 4 * n + (i & 3); }

struct Unit { int pm, pn; };
struct Gemm { const bf16_t* A; const bf16_t* Bt; int M, N, K, lda, ldb; };

struct StaticOrder {
    int nM, nN, nwg, G, c;
    __host__ __device__ void init(int M, int N, int G_, int c_) { nM = M / BM; nN = N / BM; nwg = nM * nN; G = G_; c = c_; }
    __host__ __device__ bool next(int i, Unit& u) const {
        const long L = (long)i * G + c; if (L >= nwg) return false;
        int wgid = (int)L; { const int q = nwg / NXCD, r = nwg % NXCD, xcd = wgid % NXCD, off = wgid / NXCD; wgid = (xcd < r ? xcd * (q + 1) : r * (q + 1) + (xcd - r) * q) + off; }
        const int nig = WGM * nN, gid = wgid / nig, fm = gid * WGM, gsz = (nM - fm) < WGM ? (nM - fm) : WGM;
        u.pm = fm + ((wgid % nig) % gsz); u.pn = (wgid % nig) / gsz; return true;
    }
    __device__ __forceinline__ void a_ready(const Unit&) const {}
    __device__ __forceinline__ void done(const Unit&) const {}
};
typedef __bf16 bf16x2_cv __attribute__((ext_vector_type(2)));
typedef float f32x2_cv __attribute__((ext_vector_type(2)));
__device__ __forceinline__ unsigned cvt_pk_bf16(float lo, float hi) { const bf16x2_cv v = __builtin_convertvector((f32x2_cv){lo, hi}, bf16x2_cv); return __builtin_bit_cast(unsigned, v); }
__device__ __forceinline__ float sigmoid_f(float x) { return __builtin_amdgcn_rcpf(1.0f + __expf(-x)); }

template <bool BIAS> struct EpiStoreT {
    static constexpr bool PERM = true, AFTER_DRAIN = false;
    bf16_t* O; int ldc; const float* bias;
    __device__ __forceinline__ void operator()(const f32x4 (&acc)[2][2][4][2], const Unit& u, int wr, int wc, int fr, int fq) const {
        const int row0 = u.pm * BM + wr * 64 + fr; const int col0 = u.pn * BM + wc * 32 + 8 * fq;
        f32x4 bv[2][2];
        if (BIAS) {
#pragma unroll
            for (int bj = 0; bj < 2; ++bj)
#pragma unroll
                for (int n = 0; n < 2; ++n) bv[bj][n] = *(const f32x4*)(bias + col0 + bj * HALF + 4 * n); }
#pragma unroll
        for (int ai = 0; ai < 2; ++ai)
#pragma unroll
            for (int m = 0; m < 4; ++m) { bf16_t* rowp = O + (size_t)(row0 + ai * HALF + m * 16) * ldc + col0;
#pragma unroll
                for (int bj = 0; bj < 2; ++bj) { f32x4 v0 = acc[ai][bj][m][0], v1 = acc[ai][bj][m][1]; if (BIAS) { v0 = v0 + bv[bj][0]; v1 = v1 + bv[bj][1]; }
                    u32x4 w; w.x = cvt_pk_bf16(v0[0], v0[1]); w.y = cvt_pk_bf16(v0[2], v0[3]); w.z = cvt_pk_bf16(v1[0], v1[1]); w.w = cvt_pk_bf16(v1[2], v1[3]);
                    *(u32x4*)(rowp + bj * HALF) = w; } }
    }
};
struct EpiSwiGLU {
    static constexpr bool PERM = true, AFTER_DRAIN = false;
    bf16_t* O; int ldc;
    __device__ __forceinline__ void operator()(const f32x4 (&acc)[2][2][4][2], const Unit& u, int wr, int wc, int fr, int fq) const {
        const int row0 = u.pm * BM + wr * 64 + fr; const int col0 = u.pn * HALF + wc * 32 + 8 * fq;
#pragma unroll
        for (int ai = 0; ai < 2; ++ai)
#pragma unroll
            for (int m = 0; m < 4; ++m) { bf16_t* rowp = O + (size_t)(row0 + ai * HALF + m * 16) * ldc + col0;
                float o[8];
#pragma unroll
                for (int n = 0; n < 2; ++n)
#pragma unroll
                    for (int j = 0; j < 4; ++j) { const float g = acc[ai][0][m][n][j], up = acc[ai][1][m][n][j]; o[n * 4 + j] = g * sigmoid_f(g) * up; }
                u32x4 w; w.x = cvt_pk_bf16(o[0], o[1]); w.y = cvt_pk_bf16(o[2], o[3]); w.z = cvt_pk_bf16(o[4], o[5]); w.w = cvt_pk_bf16(o[6], o[7]);
                *(u32x4*)rowp = w; }
    }
};
struct EpiGLU {
    static constexpr bool PERM = true, AFTER_DRAIN = false;
    bf16_t* O; int ldc; const float* bias; const bf16_t* Y;
    __device__ __forceinline__ void operator()(const f32x4 (&acc)[2][2][4][2], const Unit& u, int wr, int wc, int fr, int fq) const {
        const int row0 = u.pm * BM + wr * 64 + fr; const int col0 = u.pn * BM + wc * 32 + 8 * fq;
        f32x4 bv[2][2];
#pragma unroll
        for (int bj = 0; bj < 2; ++bj)
#pragma unroll
            for (int n = 0; n < 2; ++n) bv[bj][n] = *(const f32x4*)(bias + col0 + bj * HALF + 4 * n);
#pragma unroll
        for (int ai = 0; ai < 2; ++ai)
#pragma unroll
            for (int m = 0; m < 4; ++m) { const size_t ro = (size_t)(row0 + ai * HALF + m * 16) * ldc + col0;
#pragma unroll
                for (int bj = 0; bj < 2; ++bj) { f32x4 v0 = acc[ai][bj][m][0] + bv[bj][0], v1 = acc[ai][bj][m][1] + bv[bj][1];
                    const u32x4 yw = *(const u32x4*)(Y + ro + bj * HALF);
                    float o[8];
                    o[0] = __uint_as_float(yw.x << 16) * sigmoid_f(v0[0]); o[1] = __uint_as_float(yw.x & 0xffff0000u) * sigmoid_f(v0[1]);
                    o[2] = __uint_as_float(yw.y << 16) * sigmoid_f(v0[2]); o[3] = __uint_as_float(yw.y & 0xffff0000u) * sigmoid_f(v0[3]);
                    o[4] = __uint_as_float(yw.z << 16) * sigmoid_f(v1[0]); o[5] = __uint_as_float(yw.z & 0xffff0000u) * sigmoid_f(v1[1]);
                    o[6] = __uint_as_float(yw.w << 16) * sigmoid_f(v1[2]); o[7] = __uint_as_float(yw.w & 0xffff0000u) * sigmoid_f(v1[3]);
                    u32x4 w; w.x = cvt_pk_bf16(o[0], o[1]); w.y = cvt_pk_bf16(o[2], o[3]); w.z = cvt_pk_bf16(o[4], o[5]); w.w = cvt_pk_bf16(o[6], o[7]);
                    *(u32x4*)(O + ro + bj * HALF) = w; } }
    }
};
struct EpiStoreTiled {
    static constexpr bool PERM = true, AFTER_DRAIN = false;
    bf16_t* O; int ldo; bf16_t* XT; bf16_t* halo; int c0; bf16_t* GT; int g0, gn;
    __device__ __forceinline__ void operator()(const f32x4 (&acc)[2][2][4][2], const Unit& u, int wr, int wc, int fr, int fq) const {
        const int row0 = u.pm * BM + wr * 64 + fr; const int col0 = u.pn * BM + wc * 32 + 8 * fq;
#pragma unroll
        for (int ai = 0; ai < 2; ++ai)
#pragma unroll
            for (int m = 0; m < 4; ++m) { const int row = row0 + ai * HALF + m * 16;
                const bool edge = (m == 0 && fr < 2) || (m == 3 && fr >= 14); const int slot = (m == 0) ? fr : fr - 12;
#pragma unroll
                for (int bj = 0; bj < 2; ++bj) { const f32x4 v0 = acc[ai][bj][m][0], v1 = acc[ai][bj][m][1];
                    u32x4 w; w.x = cvt_pk_bf16(v0[0], v0[1]); w.y = cvt_pk_bf16(v0[2], v0[3]); w.z = cvt_pk_bf16(v1[0], v1[1]); w.w = cvt_pk_bf16(v1[2], v1[3]);
                    const int col = col0 + bj * HALF, hc = col - c0;
                    if (hc >= 0 && hc < 6144) { *(u32x4*)(XT + (((size_t)(row >> 6) * 768 + (hc >> 3)) * 64 + (row & 63)) * 8) = w;
                        if (edge) *(u32x4*)(halo + ((size_t)(row >> 6) * 4 + slot) * 6144 + hc) = w; }
                    else { *(u32x4*)(O + (size_t)row * ldo + (hc < 0 ? col : col - 6144)) = w;
                        const int gc = col - g0;
                        if (gc >= 0 && gc < gn) { bf16_t* gp = GT + ((size_t)(row >> 6) * gn + gc) * 64 + (row & 63);
                            gp[0] = (bf16_t)(w.x & 0xffffu); gp[64] = (bf16_t)(w.x >> 16); gp[128] = (bf16_t)(w.y & 0xffffu); gp[192] = (bf16_t)(w.y >> 16);
                            gp[256] = (bf16_t)(w.z & 0xffffu); gp[320] = (bf16_t)(w.z >> 16); gp[384] = (bf16_t)(w.w & 0xffffu); gp[448] = (bf16_t)(w.w >> 16); } } } }
    }
};
template <class Epi, class Sched, bool ALIGN_EPI = false, bool SP2 = false>
__device__ __forceinline__ void gemm_phase(PG8_LAS unsigned char* lds, const Gemm g, const Sched& S, const Epi& E) {
    const int tid = threadIdx.x, wid = __builtin_amdgcn_readfirstlane(tid >> 6), lane = tid & 63, wr = wid >> 2, wc = wid & 3, fr = lane & 15, fq = lane >> 4;
    const int K = g.K, nt = K / BK;
    unsigned voffA[2], voffB[2];
#pragma unroll
    for (int i = 0; i < 2; ++i) { int R, C; stage_rc(tid * 16 + i * 8192, R, C); const int Rb = Epi::PERM ? ((R & ~31) + perm32(R & 31)) : R;
        voffA[i] = (unsigned)(R * g.lda + C) * 2u; voffB[i] = (unsigned)(Rb * g.ldb + C) * 2u; }
    const size_t kstep = (size_t)(BK * 2);
    const size_t hstepA = (size_t)HALF * g.lda * 2, hstepB = (size_t)HALF * g.ldb * 2;
    const size_t tstepA = 2 * hstepA, tstepB = 2 * hstepB;
    const unsigned ldsw = (unsigned)wid * 1024u;
    const int aoff = lds_byte(wr * 64 + fr, fq * 8), boff = lds_byte(wc * 32 + fr, fq * 8);
#define PG8_SA(b, h) (((b) * 2 + (h)) * HTB)
#define PG8_SB(b, h) ((4 + (b) * 2 + (h)) * HTB)
#define PG8_STAGE(bufoff, gbase, voff) do { _Pragma("unroll") for (int _i = 0; _i < 2; ++_i) \
        __builtin_amdgcn_global_load_lds((const unsigned*)((const char*)(gbase) + (voff)[_i]), (PG8_LAS unsigned*)(lds + (bufoff) + ldsw + _i * 8192), 16, 0, 0); } while (0)
#define PG8_LDA(dst, b, h) do { _Pragma("unroll") for (int m = 0; m < 4; ++m) _Pragma("unroll") for (int k = 0; k < 2; ++k) dst[m][k] = *(const PG8_LAS bf16x8*)(lds + PG8_SA(b, h) + aoff + m * 2048 + k * 1024); } while (0)
#define PG8_LDB(dst, b, h) do { _Pragma("unroll") for (int n = 0; n < 2; ++n) _Pragma("unroll") for (int k = 0; k < 2; ++k) dst[n][k] = *(const PG8_LAS bf16x8*)(lds + PG8_SB(b, h) + boff + n * 2048 + k * 1024); } while (0)
#define PG8_MMA(ai, bj, At, Bt) do { __builtin_amdgcn_s_setprio(1); _Pragma("unroll") for (int m = 0; m < 4; ++m) _Pragma("unroll") for (int n = 0; n < 2; ++n) _Pragma("unroll") for (int k = 0; k < 2; ++k) \
        acc[ai][bj][m][n] = __builtin_amdgcn_mfma_f32_16x16x32_bf16(Bt[n][k], At[m][k], acc[ai][bj][m][n], 0, 0, 0); __builtin_amdgcn_s_setprio(0); } while (0)
#define PG8_WAIT_V(n) asm volatile("s_waitcnt vmcnt(" #n ")" ::: "memory")
#define PG8_WAIT_L(n) asm volatile("s_waitcnt lgkmcnt(" #n ")" ::: "memory")
#define PG8_BAR __builtin_amdgcn_s_barrier()
#define PG8_SCHED __builtin_amdgcn_sched_barrier(0)
    Unit cur, nxt; int ui = 0;
    if (!S.next(0, cur)) return;
    f32x4 acc[2][2][4][2];
#pragma unroll
    for (int a = 0; a < 2; ++a)
#pragma unroll
        for (int b = 0; b < 2; ++b)
#pragma unroll
            for (int m = 0; m < 4; ++m)
#pragma unroll
                for (int n = 0; n < 2; ++n) acc[a][b][m][n] = (f32x4){0.f, 0.f, 0.f, 0.f};
    bf16x8 At[4][2], B0[2][2], B1[2][2];
    const char* cA = (const char*)g.A + (size_t)cur.pm * tstepA; const char* cB = (const char*)g.Bt + (size_t)cur.pn * tstepB;
    S.a_ready(cur);
    if constexpr (SP2) {
        PG8_STAGE(PG8_SB(0, 0), cB, voffB); PG8_STAGE(PG8_SB(0, 1), cB + hstepB, voffB); PG8_STAGE(PG8_SA(0, 0), cA, voffA); PG8_STAGE(PG8_SA(0, 1), cA + hstepA, voffA);
        if (wr == 1) PG8_BAR;
        PG8_WAIT_V(2); PG8_BAR;
        PG8_STAGE(PG8_SB(1, 0), cB + kstep, voffB); PG8_STAGE(PG8_SA(1, 0), cA + kstep, voffA); PG8_STAGE(PG8_SB(1, 1), cB + hstepB + kstep, voffB);
        PG8_WAIT_V(6); PG8_BAR;
    } else {
        PG8_STAGE(PG8_SB(0, 0), cB, voffB); PG8_STAGE(PG8_SA(0, 0), cA, voffA); PG8_STAGE(PG8_SB(0, 1), cB + hstepB, voffB); PG8_STAGE(PG8_SA(0, 1), cA + hstepA, voffA);
        if (wr == 1) PG8_BAR;
        PG8_WAIT_V(4); PG8_BAR;
        PG8_STAGE(PG8_SB(1, 0), cB + kstep, voffB); PG8_STAGE(PG8_SA(1, 0), cA + kstep, voffA); PG8_STAGE(PG8_SB(1, 1), cB + hstepB + kstep, voffB);
        PG8_WAIT_V(6); PG8_BAR;
    }
    for (;;) {
        const bool has_next = S.next(ui + 1, nxt);
        const char* nA = has_next ? (const char*)g.A + (size_t)nxt.pm * tstepA : cA; const char* nB = has_next ? (const char*)g.Bt + (size_t)nxt.pn * tstepB : cB;
        for (int t = 0; t < nt; t += 2) {
            const bool last = (t == nt - 2);
            const char* a1 = cA + (size_t)(t + 1) * kstep;
            const char* a2 = last ? nA : cA + (size_t)(t + 2) * kstep; const char* b2 = last ? nB : cB + (size_t)(t + 2) * kstep;
            const char* a3 = a2 + kstep; const char* b3 = b2 + kstep;
            if (last && has_next) S.a_ready(nxt);
            if constexpr (SP2) {
            PG8_LDB(B0, 0, 0); PG8_LDB(B1, 0, 1); PG8_SCHED; PG8_LDA(At, 0, 0); PG8_STAGE(PG8_SA(1, 1), a1 + hstepA, voffA);
            PG8_WAIT_V(8); PG8_WAIT_L(0); PG8_BAR; PG8_MMA(0, 0, At, B0); PG8_MMA(0, 1, At, B1); PG8_BAR; PG8_SCHED;
            PG8_LDA(At, 0, 1); PG8_STAGE(PG8_SB(0, 0), b2, voffB); PG8_STAGE(PG8_SB(0, 1), b2 + hstepB, voffB); PG8_STAGE(PG8_SA(0, 0), a2, voffA);
            PG8_WAIT_V(8); PG8_WAIT_L(0); PG8_BAR; PG8_MMA(1, 0, At, B0); PG8_MMA(1, 1, At, B1); PG8_BAR; PG8_SCHED;
            PG8_LDB(B0, 1, 0); PG8_LDB(B1, 1, 1); PG8_SCHED; PG8_LDA(At, 1, 0); PG8_STAGE(PG8_SA(0, 1), a2 + hstepA, voffA);
            PG8_WAIT_V(8); PG8_WAIT_L(0); PG8_BAR; PG8_MMA(0, 0, At, B0); PG8_MMA(0, 1, At, B1); PG8_BAR; PG8_SCHED;
            PG8_LDA(At, 1, 1); PG8_STAGE(PG8_SB(1, 0), b3, voffB); PG8_STAGE(PG8_SB(1, 1), b3 + hstepB, voffB); PG8_STAGE(PG8_SA(1, 0), a3, voffA);
            PG8_WAIT_V(8); PG8_WAIT_L(0); PG8_BAR; PG8_MMA(1, 0, At, B0); PG8_MMA(1, 1, At, B1); PG8_BAR; PG8_SCHED;
            } else {
            PG8_LDB(B0, 0, 0); PG8_SCHED; PG8_LDA(At, 0, 0); PG8_STAGE(PG8_SA(1, 1), a1 + hstepA, voffA);
            PG8_WAIT_L(8); PG8_BAR; PG8_WAIT_L(0); PG8_MMA(0, 0, At, B0); PG8_BAR; PG8_SCHED;
            PG8_LDB(B1, 0, 1); PG8_STAGE(PG8_SB(0, 0), b2, voffB);
            PG8_BAR; PG8_WAIT_L(0); PG8_MMA(0, 1, At, B1); PG8_BAR;
            PG8_LDA(At, 0, 1); PG8_STAGE(PG8_SA(0, 0), a2, voffA);
            PG8_BAR; PG8_WAIT_L(0); PG8_MMA(1, 0, At, B0); PG8_BAR; PG8_SCHED;
            PG8_STAGE(PG8_SB(0, 1), b2 + hstepB, voffB);
            PG8_WAIT_V(6); PG8_BAR; PG8_MMA(1, 1, At, B1); PG8_BAR;
            PG8_LDB(B0, 1, 0); PG8_SCHED; PG8_LDA(At, 1, 0); PG8_STAGE(PG8_SA(0, 1), a2 + hstepA, voffA);
            PG8_WAIT_L(8); PG8_BAR; PG8_WAIT_L(0); PG8_MMA(0, 0, At, B0); PG8_BAR; PG8_SCHED;
            PG8_LDB(B1, 1, 1); PG8_STAGE(PG8_SB(1, 0), b3, voffB);
            PG8_BAR; PG8_WAIT_L(0); PG8_MMA(0, 1, At, B1); PG8_BAR;
            PG8_LDA(At, 1, 1); PG8_STAGE(PG8_SA(1, 0), a3, voffA);
            PG8_BAR; PG8_WAIT_L(0); PG8_MMA(1, 0, At, B0); PG8_BAR; PG8_SCHED;
            PG8_STAGE(PG8_SB(1, 1), b3 + hstepB, voffB);
            PG8_WAIT_V(6); PG8_BAR; PG8_MMA(1, 1, At, B1); PG8_BAR;
            }
        }
        if constexpr (ALIGN_EPI) { if (wr == 0) PG8_BAR; }
        if constexpr (!Epi::AFTER_DRAIN) { E(acc, cur, wr, wc, fr, fq); S.done(cur); }
        if (!has_next) break;
#pragma unroll
        for (int a = 0; a < 2; ++a)
#pragma unroll
            for (int b = 0; b < 2; ++b)
#pragma unroll
                for (int m = 0; m < 4; ++m)
#pragma unroll
                    for (int n = 0; n < 2; ++n) acc[a][b][m][n] = (f32x4){0.f, 0.f, 0.f, 0.f};
        cur = nxt; cA = nA; cB = nB; ++ui;
        if constexpr (ALIGN_EPI) { if (wr == 1) PG8_BAR; }
    }
    PG8_WAIT_V(0);
    if constexpr (!ALIGN_EPI) { if (wr == 0) PG8_BAR; }
    PG8_BAR;
    if constexpr (Epi::AFTER_DRAIN) { E.fused(acc, cur, wr, wc, fr, fq, lds, wid, lane); S.done(cur); }
#undef PG8_SA
#undef PG8_SB
#undef PG8_STAGE
#undef PG8_LDA
#undef PG8_LDB
#undef PG8_MMA
#undef PG8_WAIT_V
#undef PG8_WAIT_L
#undef PG8_BAR
#undef PG8_SCHED
}
}
#define XB_TMO      128
#define XB_XCNT(j)  (256  + 64 * (j))
#define XB_XSUB(j)  (1280 + 64 * (j))
#define XB_XGEN(j)  (2304 + 64 * (j))
#define XB_TOP      3328
#define XB_TOPGEN   3392
#define XCD_BAR_WORDS 3456
#define XB_SPIN_CAP (1u << 18)
#define LAS __attribute__((address_space(3)))

__device__ __forceinline__ unsigned xb_ld(unsigned* p)              { return __hip_atomic_load(p, __ATOMIC_RELAXED, __HIP_MEMORY_SCOPE_AGENT); }
__device__ __forceinline__ unsigned xb_add(unsigned* p, unsigned v) { return __hip_atomic_fetch_add(p, v, __ATOMIC_RELAXED, __HIP_MEMORY_SCOPE_AGENT); }
__device__ __forceinline__ unsigned xb_xcc_id() { return (unsigned)__builtin_amdgcn_s_getreg((3 << 11) | 20) & 0xFu; }
#define XB_SPIN(cond, bar) do { unsigned _sp = 0; while (cond) { __builtin_amdgcn_s_sleep(1); \
    if ((++_sp & 255u) == 0u) { if (xb_ld(&(bar)[XB_TMO])) break; if (_sp > XB_SPIN_CAP) { atomicAdd(&(bar)[XB_TMO], 1u); break; } } } } while (0)

struct XcdBarrier {
    unsigned* bar; unsigned x;
    volatile LAS unsigned* st;
};

__device__ __forceinline__ XcdBarrier xcd_barrier_post(unsigned* bar, volatile LAS unsigned* st) {
    XcdBarrier b; b.bar = bar; b.x = xb_xcc_id(); b.st = st;
    if (threadIdx.x == 0) (void)xb_add(&bar[XB_XCNT(b.x)], 1u);
    return b;
}
__device__ __forceinline__ void xcd_barrier_complete(unsigned* bar, unsigned x, unsigned& nloc, unsigned& nx) {
    const unsigned G = gridDim.x * gridDim.y * gridDim.z;
    unsigned sum, cnt, mine, sp = 0u;
    for (;;) {
        sum = 0u; cnt = 0u; mine = 0u;
#pragma unroll
        for (unsigned j = 0; j < 16; ++j) { const unsigned c = xb_ld(&bar[XB_XCNT(j)]); sum += c; cnt += (c > 0u) ? 1u : 0u; mine = (j == x) ? c : mine; }
        if (sum == G) break;
        __builtin_amdgcn_s_sleep(1);
        if ((++sp & 255u) == 0u) { if (xb_ld(&bar[XB_TMO])) break; if (sp > XB_SPIN_CAP) { atomicAdd(&bar[XB_TMO], 1u); break; } }
    }
    nloc = mine > 0u ? mine : 1u; nx = cnt > 0u ? cnt : 1u;
}

__device__ __forceinline__ void xcd_barrier(const XcdBarrier& b) {
    asm volatile("s_waitcnt vmcnt(0)" ::: "memory");
    __syncthreads();
    if (threadIdx.x == 0) {
        unsigned* bar = b.bar;
        __builtin_amdgcn_s_waitcnt(0);
        unsigned nloc = b.st[0], nx = b.st[1];
        if (nloc == 0u) { xcd_barrier_complete(bar, b.x, nloc, nx); b.st[0] = nloc; b.st[1] = nx; }
        const unsigned old = xb_add(&bar[XB_XSUB(b.x)], 1u);
        const unsigned gen = old / nloc;
        if (old + 1u == (gen + 1u) * nloc) {
            __builtin_amdgcn_fence(__ATOMIC_RELEASE, "agent");
            asm volatile("s_waitcnt vmcnt(0)" ::: "memory");
            const unsigned og = xb_add(&bar[XB_TOP], 1u);
            const unsigned tg = og / nx;
            if (og + 1u == (tg + 1u) * nx) xb_add(&bar[XB_TOPGEN], 1u);
            else XB_SPIN(xb_ld(&bar[XB_TOPGEN]) == tg, bar);
            __builtin_amdgcn_fence(__ATOMIC_ACQUIRE, "agent");
            xb_add(&bar[XB_XGEN(b.x)], 1u);
            asm volatile("s_waitcnt vmcnt(0)" ::: "memory");
        } else {
            XB_SPIN(xb_ld(&bar[XB_XGEN(b.x)]) == gen, bar);
            __builtin_amdgcn_fence(__ATOMIC_ACQUIRE, "agent");
            asm volatile("s_waitcnt vmcnt(0)" ::: "memory");
        }
    }
    __syncthreads();
}


typedef pg8::bf16_t bf16_t;
typedef float vf4 __attribute__((ext_vector_type(4)));
typedef float vf2 __attribute__((ext_vector_type(2)));
typedef unsigned vu4 __attribute__((ext_vector_type(4)));
typedef LAS unsigned char lds_u8;
constexpr int DM = 2048, NTOK = 40960, DFF = 5632, NTHR = 512;
constexpr float EPSN = 1e-6f;
constexpr int LDS_BYTES = 155648;
constexpr int LDS_BAR_OFF = LDS_BYTES - 16;
constexpr size_t MiB = 1024 * 1024;
constexpr int WQ_WORD = 4096;
constexpr size_t WS_BAR = 0, WS_MOD = 65536;
constexpr size_t WS_H = 4 * MiB, WS_HO = 164 * MiB, WS_W = 324 * MiB, WS_ARENA = 448 * MiB, WS_END = 1536 * MiB;
constexpr size_t W_GU = 0, W_DN = 44 * MiB, W_MIN = 66 * MiB, W_MOUT = 107 * MiB;
constexpr int DN_LD = 8448, DN_LD2 = 2304;
constexpr int SSD_LD = 10496, SSD_LD2 = 4352;

struct Args { const float* in[47]; float* out; unsigned char* ws; int ph_lo, ph_hi; };
__device__ __forceinline__ const float* ARG_IN(int i) {
    const __attribute__((address_space(4))) unsigned char* base = (const __attribute__((address_space(4))) unsigned char*)__builtin_amdgcn_kernarg_segment_ptr();
    asm volatile("" : "+s"(base));
    return *(const float* const __attribute__((address_space(4)))*)(base + 8 * i); }

#define LDS_SYNC() do { asm volatile("s_waitcnt lgkmcnt(0)" ::: "memory"); __builtin_amdgcn_s_barrier(); asm volatile("" ::: "memory"); } while (0)
__device__ __forceinline__ int seq_of_row(int row) { return row < 32768 ? (row >> 13) : 4 + ((row - 32768) >> 12); }
__device__ __forceinline__ int seq_start(int s) { return s < 4 ? s * 8192 : 32768 + (s - 4) * 4096; }
__device__ __forceinline__ int seq_len(int s) { return s < 4 ? 8192 : 4096; }
__device__ __forceinline__ float bf2f(bf16_t b) { return __uint_as_float(((unsigned)b) << 16); }
__device__ __forceinline__ void unpack8(const vu4 w, float (&f)[8]) {
    f[0] = __uint_as_float(w.x << 16); f[1] = __uint_as_float(w.x & 0xffff0000u); f[2] = __uint_as_float(w.y << 16); f[3] = __uint_as_float(w.y & 0xffff0000u);
    f[4] = __uint_as_float(w.z << 16); f[5] = __uint_as_float(w.z & 0xffff0000u); f[6] = __uint_as_float(w.w << 16); f[7] = __uint_as_float(w.w & 0xffff0000u); }
__device__ __forceinline__ vu4 pack8(const float (&f)[8]) { vu4 w; w.x = pg8::cvt_pk_bf16(f[0], f[1]); w.y = pg8::cvt_pk_bf16(f[2], f[3]); w.z = pg8::cvt_pk_bf16(f[4], f[5]); w.w = pg8::cvt_pk_bf16(f[6], f[7]); return w; }

__device__ __forceinline__ float wave_scan_incl(float v) {
#define DPP_ADD(ctrl, rmask) v += __builtin_bit_cast(float, __builtin_amdgcn_update_dpp(0, __builtin_bit_cast(int, v), ctrl, rmask, 0xf, false))
    DPP_ADD(0x111, 0xf); DPP_ADD(0x112, 0xf); DPP_ADD(0x114, 0xf); DPP_ADD(0x118, 0xf); DPP_ADD(0x142, 0xa); DPP_ADD(0x143, 0xc);
#undef DPP_ADD
    return v; }
__device__ __forceinline__ float lane63(float v) { return __builtin_bit_cast(float, __builtin_amdgcn_readlane(__builtin_bit_cast(int, v), 63)); }
__device__ __forceinline__ float wave_sum(float v) { return lane63(wave_scan_incl(v)); }
__device__ __forceinline__ float softplus_fast(float x) { return x > 20.f ? x : __logf(1.0f + __expf(x)); }
__device__ __forceinline__ float silu_f(float x) { return x * __builtin_amdgcn_rcpf(1.0f + __expf(-x)); }
__device__ __forceinline__ float softplus_f(float x) { return x > 20.f ? x : log1pf(__expf(x)); }
__device__ __forceinline__ void load8f(const float* p, float (&f)[8]) { const vf4 a = *(const vf4*)p, b = *(const vf4*)(p + 4); f[0] = a.x; f[1] = a.y; f[2] = a.z; f[3] = a.w; f[4] = b.x; f[5] = b.y; f[6] = b.z; f[7] = b.w; }
__device__ __forceinline__ void store8f(float* p, const float (&f)[8]) { *(vf4*)p = (vf4){f[0], f[1], f[2], f[3]}; *(vf4*)(p + 4) = (vf4){f[4], f[5], f[6], f[7]}; }

__device__ __forceinline__ void ph_ada(const Args& a, lds_u8* lds, int u_lo, int u_hi, int rank, int nrank) {
    LAS float* cact = (LAS float*)lds;
    LAS float* red = cact + 6 * 2048;
    const int tid = threadIdx.x, lane = tid & 63, wave = __builtin_amdgcn_readfirstlane(tid >> 6);
    float* mod = (float*)(a.ws + WS_MOD);
    for (int i = tid; i < 6 * 2048; i += NTHR) { const int b = i >> 11, k = i & 2047; const float c = b < 4 ? ARG_IN(2)[b * 2048 + k] : ARG_IN(3)[(b - 4) * 2048 + k]; cact[i] = c / (1.0f + expf(-c)); }
    LDS_SYNC();
    for (int u = u_lo + rank; u < u_hi; u += nrank) {
        const int layer = u / 192, col0 = (u % 192) * 64;
        const float* W = ARG_IN(4) + (size_t)layer * 2048 * 12288 + col0 + lane;
        float acc[6] = {0.f, 0.f, 0.f, 0.f, 0.f, 0.f};
        const int k0 = wave * 256;
#pragma unroll 1
        for (int k = k0; k < k0 + 256; k += 16) {
            float w[16];
#pragma unroll
            for (int j = 0; j < 16; ++j) w[j] = W[(size_t)(k + j) * 12288];
#pragma unroll
            for (int j4 = 0; j4 < 4; ++j4)
#pragma unroll
                for (int b = 0; b < 6; ++b) { const vf4 c4 = *(const LAS vf4*)(cact + b * 2048 + k + 4 * j4); acc[b] += w[4 * j4] * c4.x + w[4 * j4 + 1] * c4.y + w[4 * j4 + 2] * c4.z + w[4 * j4 + 3] * c4.w; }
        }
#pragma unroll
        for (int b = 0; b < 6; ++b) red[(wave * 6 + b) * 64 + lane] = acc[b];
        LDS_SYNC();
        if (tid < 384) { const int b = tid >> 6; float s = 0.f;
#pragma unroll
            for (int w = 0; w < 8; ++w) s += red[(w * 6 + b) * 64 + lane];
            s += ARG_IN(5)[layer * 12288 + col0 + lane];
            { const int kidx = col0 >> 11, c = (col0 & 2047) + lane; const float* ng = ARG_IN(6) + (size_t)layer * 4 * 2048;
                if (kidx == 1) s = ng[0 * 2048 + c] * (1.0f + s); else if (kidx == 4) s = ng[2 * 2048 + c] * (1.0f + s); else if (kidx == 2) s *= ng[1 * 2048 + c]; else if (kidx == 5) s *= ng[3 * 2048 + c]; }
            mod[(size_t)(layer * 6 + b) * 12288 + col0 + lane] = s; }
        LDS_SYNC();
    }
}

__device__ __forceinline__ void cvt_wT(const float* W, int K, int N, bf16_t* Bt, int mode, lds_u8* lds, int rank = -1, int nrank = 0, const float* rowscale = nullptr) {
    LAS float* tile = (LAS float*)lds;
    const int tid = threadIdx.x;
    const int nkt = K >> 8, nnt = N >> 6;
    if (rank < 0) { rank = (int)blockIdx.x; nrank = (int)gridDim.x; }
    const unsigned voff = (unsigned)(tid >> 6) * (unsigned)N + (unsigned)(tid & 63);
    LAS float* tw = tile + (tid >> 6) * 65 + (tid & 63);
    float v32[32];
    if (rank < nkt * nnt) { const int kt = rank % nkt, nt = rank / nkt, k0 = kt * 256, n0 = nt * 64;
#pragma unroll
        for (int i = 0; i < 32; ++i) { const float* rowp = W + (size_t)(k0 + 8 * i) * N + n0; v32[i] = rowp[voff]; if (rowscale) v32[i] *= rowscale[k0 + 8 * i + (tid >> 6)]; } }
    for (int u = rank; u < nkt * nnt; u += nrank) {
        const int kt = u % nkt, nt = u / nkt, k0 = kt * 256, n0 = nt * 64;
#pragma unroll
        for (int i = 0; i < 32; ++i) tw[i * 8 * 65] = v32[i];
        LDS_SYNC();
        if (u + nrank < nkt * nnt) { const int u2 = u + nrank, kt2 = u2 % nkt, nt2 = u2 / nkt, k2 = kt2 * 256, n2 = nt2 * 64;
#pragma unroll
            for (int i = 0; i < 32; ++i) { const float* rowp = W + (size_t)(k2 + 8 * i) * N + n2; v32[i] = rowp[voff]; if (rowscale) v32[i] *= rowscale[k2 + 8 * i + (tid >> 6)]; } }
        { const int n = tid >> 3, kk = (tid & 7) * 8; const int nn = n0 + n; const int drow = mode == 0 ? nn : ((nn >> 7) * 256 + (nn & 127) + (mode == 2 ? 128 : 0));
#pragma unroll
            for (int q = 0; q < 4; ++q) { float v[8];
#pragma unroll
                for (int j = 0; j < 8; ++j) v[j] = tile[(q * 64 + kk + j) * 65 + n];
                *(vu4*)(Bt + (size_t)drow * K + k0 + q * 64 + kk) = pack8(v); } }
        LDS_SYNC();
    }
}
__device__ __forceinline__ void cvt_ffn(const Args& a, int layer, lds_u8* lds, int rank = -1, int nrank = 0, unsigned char* dst = nullptr) {
    bf16_t* wgu = (bf16_t*)(dst ? dst : a.ws + WS_W + W_GU); bf16_t* wdn = (bf16_t*)(dst ? dst + 44 * MiB : a.ws + WS_W + W_DN);
    cvt_wT(ARG_IN(7) + (size_t)layer * DM * DFF, DM, DFF, wgu, 1, lds, rank, nrank);
    cvt_wT(ARG_IN(8) + (size_t)layer * DM * DFF, DM, DFF, wgu, 2, lds, rank, nrank);
    cvt_wT(ARG_IN(9) + (size_t)layer * DFF * DM, DFF, DM, wdn, 0, lds, rank, nrank);
}
__device__ __forceinline__ void cvt_ffn_part(const Args& a, int layer, lds_u8* lds, int rank, int nrank, unsigned char* dst, bool down) {
    bf16_t* wgu = (bf16_t*)(dst ? dst : a.ws + WS_W + W_GU); bf16_t* wdn = (bf16_t*)(dst ? dst + 44 * MiB : a.ws + WS_W + W_DN);
    if (!down) { cvt_wT(ARG_IN(7) + (size_t)layer * DM * DFF, DM, DFF, wgu, 1, lds, rank, nrank); cvt_wT(ARG_IN(8) + (size_t)layer * DM * DFF, DM, DFF, wgu, 2, lds, rank, nrank); }
    else cvt_wT(ARG_IN(9) + (size_t)layer * DFF * DM, DFF, DM, wdn, 0, lds, rank, nrank);
}

template <bool XSRC_BF, bool XDST_BF>
__device__ __forceinline__ void ph_row(const float* __restrict__ x0, const float* __restrict__ x1, float* x_dst, const bf16_t* ho, const float* g_post, const float* mgate,
                                       const float* g_pre, const float* mpre, bf16_t* h, bf16_t* ug = nullptr) {
    const int tid = threadIdx.x, lane = tid & 63, wave = __builtin_amdgcn_readfirstlane(tid >> 6);
    const int G = gridDim.x, niter = (NTOK / 8 + G - 1) / G;
#define ROW_OF(it_) (ug ? ((blockIdx.x + G * ((it_) >> 2)) >= 1280 ? -1 : (int)(blockIdx.x + G * ((it_) >> 2)) * 32 + wave * 4 + ((it_) & 3)) : ((blockIdx.x + G * (it_)) >= NTOK / 8 ? -1 : (int)(blockIdx.x + G * (it_)) * 8 + wave))
    vu4 nxb[4], nho[4]; float nxf[4][8];
#define ROW_LOAD(r_) { const float* xr_ = (r_) < 32768 ? x0 + (size_t)(r_) * DM : x1 + (size_t)((r_) - 32768) * DM; \
        _Pragma("unroll") for (int j = 0; j < 4; ++j) { if (XSRC_BF) nxb[j] = *(const vu4*)((const bf16_t*)x0 + (size_t)(r_) * DM + 8 * lane + 512 * j); else load8f(xr_ + 8 * lane + 512 * j, nxf[j]); \
            if (ho) nho[j] = *(const vu4*)(ho + (size_t)(r_) * DM + 8 * lane + 512 * j); } }
    int rown = ROW_OF(0);
    if (rown >= 0) ROW_LOAD(rown)
    for (int it = 0; it < niter; ++it) {
        const int row = rown; if (row < 0) break;
        const int b = seq_of_row(row);
        float xv[4][8]; vu4 hraw[4];
#pragma unroll
        for (int j = 0; j < 4; ++j) { if (XSRC_BF) unpack8(nxb[j], xv[j]); else {
#pragma unroll
                for (int e = 0; e < 8; ++e) xv[j][e] = nxf[j][e]; }
            hraw[j] = nho[j]; }
        rown = it + 1 < niter ? ROW_OF(it + 1) : -1;
        if (rown >= 0) ROW_LOAD(rown)
        if (ho) {
            float hv[4][8]; float ss = 0.f;
#pragma unroll
            for (int j = 0; j < 4; ++j) { unpack8(hraw[j], hv[j]);
#pragma unroll
                for (int e = 0; e < 8; ++e) ss += hv[j][e] * hv[j][e]; }
            ss = wave_sum(ss);
            const float r1 = rsqrtf(ss * (1.0f / DM) + EPSN);
#pragma unroll
            for (int j = 0; j < 4; ++j) { float gt[8]; load8f(mgate + (size_t)b * 12288 + 8 * lane + 512 * j, gt);
#pragma unroll
                for (int e = 0; e < 8; ++e) xv[j][e] += gt[e] * (hv[j][e] * r1); }
        }
        if (x_dst) {
#pragma unroll
            for (int j = 0; j < 4; ++j) { if (XDST_BF) *(vu4*)((bf16_t*)x_dst + (size_t)row * DM + 8 * lane + 512 * j) = pack8(xv[j]); else store8f(x_dst + (size_t)row * DM + 8 * lane + 512 * j, xv[j]); }
        }
        if (h || ug) {
            float ss = 0.f;
#pragma unroll
            for (int j = 0; j < 4; ++j)
#pragma unroll
                for (int e = 0; e < 8; ++e) ss += xv[j][e] * xv[j][e];
            ss = wave_sum(ss);
            const float r2 = rsqrtf(ss * (1.0f / DM) + EPSN);
#pragma unroll
            for (int j = 0; j < 4; ++j) { float sh[8], sc[8], o[8]; load8f(mpre + (size_t)b * 12288 + 8 * lane + 512 * j, sh); load8f(mpre + (size_t)b * 12288 + 2048 + 8 * lane + 512 * j, sc);
#pragma unroll
                for (int e = 0; e < 8; ++e) o[e] = xv[j][e] * r2 * sc[e] + sh[e];
                if (ug) { const int col = 8 * lane + 512 * j; *(vu4*)(ug + ((size_t)((col >> 4) * 1280 + (row >> 5))) * 768 + (row & 31) * 16 + (col & 8)) = pack8(o); }
                else *(vu4*)(h + (size_t)row * DM + 8 * lane + 512 * j) = pack8(o); }
        }
    }
}

__device__ __forceinline__ void ph_dn_combine(const Args& a, const bf16_t* of, const bf16_t* ob, const bf16_t* proj, bf16_t* O) {
    const int tid = threadIdx.x, lane = tid & 63, wave = __builtin_amdgcn_readfirstlane(tid >> 6);
    const float* gn = ARG_IN(14);
    for (int row = blockIdx.x * 8 + wave; row < NTOK; row += gridDim.x * 8) {
#pragma unroll
        for (int j = 0; j < 4; ++j) { const int col = 8 * lane + 512 * j;
            float x[8], y[8], z[8], g8[8], o[8];
            unpack8(*(const vu4*)(of + (size_t)row * DM + col), x); unpack8(*(const vu4*)(ob + (size_t)row * DM + col), y);
            unpack8(*(const vu4*)(proj + (size_t)row * DN_LD2 + col), z); load8f(gn + (col & 127), g8);
            float ss = 0.f;
#pragma unroll
            for (int e = 0; e < 8; ++e) { x[e] += y[e]; ss += x[e] * x[e]; }
            ss += __shfl_xor(ss, 1); ss += __shfl_xor(ss, 2); ss += __shfl_xor(ss, 4); ss += __shfl_xor(ss, 8);
            const float r = rsqrtf(ss * (1.0f / 128.0f) + EPSN);
#pragma unroll
            for (int e = 0; e < 8; ++e) o[e] = x[e] * r * g8[e] * silu_f(z[e]);
            *(vu4*)(O + (size_t)row * DM + col) = pack8(o); }
    }
}
__device__ __forceinline__ void ph_ssd_combine(const Args& a, bf16_t* Y, const bf16_t* proj, const bf16_t* Yfs) {
    const int tid = threadIdx.x, lane = tid & 63, wave = __builtin_amdgcn_readfirstlane(tid >> 6);
    const float* gn = ARG_IN(31);
    for (int row = blockIdx.x * 8 + wave; row < NTOK; row += gridDim.x * 8) {
#pragma unroll
        for (int j = 0; j < 8; ++j) { const int col = 8 * lane + 512 * j;
            float y[8], z[8], o[8];
            unpack8(*(const vu4*)(Y + (size_t)row * 4096 + col), y); unpack8(*(const vu4*)(proj + (size_t)row * SSD_LD2 + col), z);
            if (row >= 32768) { float yf[8]; unpack8(*(const vu4*)(Yfs + (size_t)(row - 32768) * 4096 + col), yf);
#pragma unroll
                for (int e = 0; e < 8; ++e) y[e] += yf[e]; }
            float ss = 0.f;
#pragma unroll
            for (int e = 0; e < 8; ++e) { y[e] *= silu_f(z[e]); ss += y[e] * y[e]; }
            ss = wave_sum(ss);
            const float r = rsqrtf(ss * (1.0f / 512.0f) + EPSN);
#pragma unroll
            for (int e = 0; e < 8; ++e) o[e] = y[e] * r;
            *(vu4*)(Y + (size_t)row * 4096 + col) = pack8(o); }
    }
}

constexpr int S5_NCH = 1280, S5_LDA = 768;
struct BatchOrder {
    int nMg, nNg, per, total, G, c;
    __device__ void init(int nMg_, int nNg_, int G_, int c_) { nMg = nMg_; nNg = nNg_; per = nMg_ * nNg_; total = 128 * per; G = G_; c = c_; }
    __device__ bool next(int i, pg8::Unit& u) const { const long L0 = (long)i * G + c; if (L0 >= total) return false;
        const int L = (int)(L0 % 8) * (total / 8) + (int)(L0 / 8);
        const int g = L / per, r = L % per;
        u.pm = g * nMg + r % nMg; u.pn = g * nNg + r / nMg; return true; }
    __device__ __forceinline__ void a_ready(const pg8::Unit&) const {}
    __device__ __forceinline__ void done(const pg8::Unit&) const {}
};
struct EpiS5E {
    static constexpr bool PERM = false, AFTER_DRAIN = false;
    float* E;
    __device__ __forceinline__ void operator()(const pg8::f32x4 (&acc)[2][2][4][2], const pg8::Unit& u, int wr, int wc, int fr, int fq) const {
        const int row0 = u.pm * 256 + wr * 64 + fr, col0 = wc * 32 + 4 * fq;
#pragma unroll
        for (int ai = 0; ai < 2; ++ai)
#pragma unroll
            for (int m = 0; m < 4; ++m) { float* rowp = E + (size_t)(row0 + ai * 128 + m * 16) * 256 + col0;
#pragma unroll
                for (int bj = 0; bj < 2; ++bj)
#pragma unroll
                    for (int n = 0; n < 2; ++n) *(pg8::f32x4*)(rowp + bj * 128 + n * 16) = acc[ai][bj][m][n]; }
    }
};
__device__ __forceinline__ float gelu_tanh_f(float y) { const float z = 1.5957691216057308f * (y + 0.044715f * y * y * y); return y * __builtin_amdgcn_rcpf(1.0f + __expf(-z)); }
struct EpiS5Y {
    static constexpr bool PERM = true, AFTER_DRAIN = false;
    bf16_t* Y;
    __device__ __forceinline__ void operator()(const pg8::f32x4 (&acc)[2][2][4][2], const pg8::Unit& u, int wr, int wc, int fr, int fq) const {
        const int g = u.pm / 5, chunk0 = (u.pm % 5) * 256 + wr * 64 + fr, n0 = (u.pn & 1) * 256 + wc * 32 + 8 * fq;
#pragma unroll
        for (int ai = 0; ai < 2; ++ai)
#pragma unroll
            for (int m = 0; m < 4; ++m) { const int chunk = chunk0 + ai * 128 + m * 16;
#pragma unroll
                for (int bj = 0; bj < 2; ++bj) { const int n = n0 + bj * 128, t = n >> 4, c0 = n & 15;
                    const pg8::f32x4 v0 = acc[ai][bj][m][0], v1 = acc[ai][bj][m][1];
                    pg8::u32x4 w; w.x = pg8::cvt_pk_bf16(gelu_tanh_f(v0[0]), gelu_tanh_f(v0[1])); w.y = pg8::cvt_pk_bf16(gelu_tanh_f(v0[2]), gelu_tanh_f(v0[3]));
                    w.z = pg8::cvt_pk_bf16(gelu_tanh_f(v1[0]), gelu_tanh_f(v1[1])); w.w = pg8::cvt_pk_bf16(gelu_tanh_f(v1[2]), gelu_tanh_f(v1[3]));
                    *(pg8::u32x4*)(Y + (size_t)(chunk * 32 + t) * DM + g * 16 + c0) = w; } }
    }
};
__device__ __forceinline__ void ph_s5_tables(const Args& a, lds_u8* lds, bf16_t* BtY, bf16_t* BtE, float* LT, int rank, int nrank) {
    LAS float* bb = (LAS float*)lds;
    LAS float* cc = bb + 4096;
    LAS float* pw = cc + 4096;
    LAS float* kc = pw + 8448;
    const int tid = threadIdx.x;
    const float* lam_re = ARG_IN(16); const float* lam_im = ARG_IN(17); const float* log_step = ARG_IN(18);
    const float* b_re = ARG_IN(19); const float* b_im = ARG_IN(20); const float* c_re = ARG_IN(21); const float* c_im = ARG_IN(22); const float* dvec = ARG_IN(23);
    for (int g = rank; g < 128; g += nrank) {
        if (tid < 128) { const int dir = tid >> 6, p = tid & 63;
            const float step = expf(log_step[dir * 128 + g]);
            const float lr = fminf(lam_re[(dir * 128 + g) * 64 + p], -1e-4f), li = lam_im[(dir * 128 + g) * 64 + p];
#pragma unroll 1
            for (int n = 0; n <= 32; ++n) { const float mag = expf(lr * step * (float)n); float sn, cs; sincosf(li * step * (float)n, &sn, &cs);
                pw[((dir * 64 + p) * 33 + n) * 2] = mag * cs; pw[((dir * 64 + p) * 33 + n) * 2 + 1] = mag * sn; }
            const float ar = pw[((dir * 64 + p) * 33 + 1) * 2], ai = pw[((dir * 64 + p) * 33 + 1) * 2 + 1];
            const float den = lr * lr + li * li, nr = ar - 1.0f, cr = (nr * lr + ai * li) / den, ci = (ai * lr - nr * li) / den;
#pragma unroll 4
            for (int c = 0; c < 16; ++c) { const float br = b_re[(g * 64 + p) * 16 + c], bi = b_im[(g * 64 + p) * 16 + c];
                bb[((dir * 64 + p) * 16 + c) * 2] = cr * br - ci * bi; bb[((dir * 64 + p) * 16 + c) * 2 + 1] = cr * bi + ci * br; }
            LT[((g * 2 + dir) * 64 + p) * 2] = pw[((dir * 64 + p) * 33 + 32) * 2]; LT[((g * 2 + dir) * 64 + p) * 2 + 1] = pw[((dir * 64 + p) * 33 + 32) * 2 + 1];
        }
        for (int i = tid; i < 2048; i += NTHR) { const int dir = i >> 10, c = (i >> 6) & 15, p = i & 63;
            cc[i * 2] = c_re[((size_t)(dir * 128 + g) * 16 + c) * 64 + p]; cc[i * 2 + 1] = c_im[((size_t)(dir * 128 + g) * 16 + c) * 64 + p]; }
        LDS_SYNC();
#pragma unroll 1
        for (int idx = tid; idx < 63 * 256; idx += NTHR) { const int dd = (idx >> 8) - 31, c = (idx >> 4) & 15, c2 = idx & 15;
            float s = 0.f;
            if (dd >= 0) {
#pragma unroll 4
                for (int p = 0; p < 64; ++p) { const vf2 cv = *(const LAS vf2*)(cc + ((0 * 16 + c) * 64 + p) * 2), pv = *(const LAS vf2*)(pw + ((0 * 64 + p) * 33 + dd) * 2), bv = *(const LAS vf2*)(bb + ((0 * 64 + p) * 16 + c2) * 2);
                    const float tr = cv.x * pv.x - cv.y * pv.y, ti = cv.x * pv.y + cv.y * pv.x; s += tr * bv.x - ti * bv.y; } }
            if (dd <= 0) {
#pragma unroll 4
                for (int p = 0; p < 64; ++p) { const vf2 cv = *(const LAS vf2*)(cc + ((1 * 16 + c) * 64 + p) * 2), pv = *(const LAS vf2*)(pw + ((1 * 64 + p) * 33 - dd) * 2), bv = *(const LAS vf2*)(bb + ((1 * 64 + p) * 16 + c2) * 2);
                    const float tr = cv.x * pv.x - cv.y * pv.y, ti = cv.x * pv.y + cv.y * pv.x; s += tr * bv.x - ti * bv.y; } }
            if (dd == 0 && c == c2) s += dvec[g * 16 + c];
            kc[idx] = s; }
        LDS_SYNC();
#pragma unroll 1
        for (int idx = tid; idx < 512 * 64; idx += NTHR) { const int n = idx >> 6, piece = idx & 63, t = n >> 4, c = n & 15, s = piece >> 1, half = piece & 1;
            const LAS float* src = kc + ((t - s + 31) * 16 + c) * 16 + half * 8; float v[8];
            const vf4 a0 = *(const LAS vf4*)src, a1 = *(const LAS vf4*)(src + 4); v[0] = a0.x; v[1] = a0.y; v[2] = a0.z; v[3] = a0.w; v[4] = a1.x; v[5] = a1.y; v[6] = a1.z; v[7] = a1.w;
            *(vu4*)(BtY + ((size_t)(g * 512 + n)) * 768 + s * 16 + half * 8) = pack8(v); }
#pragma unroll 1
        for (int idx = tid; idx < 512 * 32; idx += NTHR) { const int n = idx >> 5, pc = idx & 31, which = pc >> 3, p0 = (pc & 7) * 8, t = n >> 4, c = n & 15, dir = which >> 1, nn = dir ? 32 - t : t + 1;
            float v[8];
#pragma unroll
            for (int j = 0; j < 8; ++j) { const int p = p0 + j; const vf2 cv = *(const LAS vf2*)(cc + ((dir * 16 + c) * 64 + p) * 2), pv = *(const LAS vf2*)(pw + ((dir * 64 + p) * 33 + nn) * 2);
                v[j] = (which & 1) ? -(cv.x * pv.y + cv.y * pv.x) : (cv.x * pv.x - cv.y * pv.y); }
            *(vu4*)(BtY + ((size_t)(g * 512 + n)) * 768 + 512 + which * 64 + p0) = pack8(v); }
#pragma unroll 1
        for (int idx = tid; idx < 256 * 64; idx += NTHR) { const int n2 = idx >> 6, piece = idx & 63, dir = n2 >> 7, reim = (n2 >> 6) & 1, p = n2 & 63, s = piece >> 1, half = piece & 1, nn = dir ? s : 31 - s;
            const vf2 pv = *(const LAS vf2*)(pw + ((dir * 64 + p) * 33 + nn) * 2); float v[8];
#pragma unroll
            for (int j = 0; j < 8; ++j) { const vf2 bv = *(const LAS vf2*)(bb + ((dir * 64 + p) * 16 + half * 8 + j) * 2); v[j] = reim ? (pv.x * bv.y + pv.y * bv.x) : (pv.x * bv.x - pv.y * bv.y); }
            *(vu4*)(BtE + ((size_t)(g * 256 + n2)) * 512 + s * 16 + half * 8) = pack8(v); }
        LDS_SYNC();
    }
}
__device__ __forceinline__ void ph_s5_scan(const float* E, const float* LT, bf16_t* UG) {
    for (int id = blockIdx.x * NTHR + threadIdx.x; id < 128 * 6 * 2 * 64; id += gridDim.x * NTHR) {
        const int p = id & 63, dir = (id >> 6) & 1, rest = id >> 7, s = rest % 6, g = rest / 6;
        const int c0 = seq_start(s) >> 5, nc = seq_len(s) >> 5;
        const float lr = LT[((g * 2 + dir) * 64 + p) * 2], li = LT[((g * 2 + dir) * 64 + p) * 2 + 1];
        float xr = 0.f, xi = 0.f;
#pragma unroll 8
        for (int m = 0; m < nc; ++m) { const int chunk = dir ? c0 + nc - 1 - m : c0 + m; const size_t row = (size_t)g * S5_NCH + chunk;
            UG[row * S5_LDA + 512 + dir * 128 + p] = (bf16_t)(pg8::cvt_pk_bf16(xr, xr) & 0xffffu); UG[row * S5_LDA + 512 + dir * 128 + 64 + p] = (bf16_t)(pg8::cvt_pk_bf16(xi, xi) & 0xffffu);
            const float er = E[row * 256 + dir * 128 + p], ei = E[row * 256 + dir * 128 + 64 + p];
            const float nxr = lr * xr - li * xi + er, nxi = lr * xi + li * xr + ei; xr = nxr; xi = nxi; }
    }
}
template <class Epi>
__device__ __forceinline__ void run_gemm_s5(lds_u8* lds, const bf16_t* A, const bf16_t* Bt, int nNg, int K, int ldb, const Epi& E) {
    pg8::Gemm g{A, Bt, 128 * S5_NCH, 128 * nNg * 256, K, S5_LDA, ldb}; BatchOrder S; S.init(5, nNg, (int)gridDim.x, (int)blockIdx.x);
    pg8::gemm_phase<Epi, BatchOrder, true, true>(lds, g, S, E);
}

__device__ __forceinline__ void ph_conv_inplace(lds_u8* lds, bf16_t* XT, const float* convw, const bf16_t* halo, int norm_mode) {
    LAS bf16_t* raw = (LAS bf16_t*)lds;
    const int tid = threadIdx.x, g8 = tid & 15;
    vu4 pb0, pb1, ph = (vu4){0u, 0u, 0u, 0u};
#define CONV_FETCH(uu) do { const int tt_ = (uu) / 48, cb_ = (uu) % 48; const size_t bs_ = (((size_t)tt_ * 768 + cb_ * 16 + g8) * 64 + (tid >> 4)) * 8; \
        pb0 = *(const vu4*)(XT + bs_); pb1 = *(const vu4*)(XT + bs_ + 32 * 8); \
        if (tid < 64) { const int hr_ = tid >> 4, rt0_ = tt_ * 64, s_ = seq_of_row(rt0_), t0_ = rt0_ - seq_start(s_); ph = (vu4){0u, 0u, 0u, 0u}; \
            if (hr_ < 2) { if (t0_ > 0) ph = *(const vu4*)(halo + ((size_t)(tt_ - 1) * 4 + 2 + hr_) * 6144 + cb_ * 128 + g8 * 8); } \
            else { if (t0_ + 64 < seq_len(s_)) ph = *(const vu4*)(halo + ((size_t)(tt_ + 1) * 4 + (hr_ - 2)) * 6144 + cb_ * 128 + g8 * 8); } } } while (0)
    if ((int)blockIdx.x < 640 * 48) CONV_FETCH((int)blockIdx.x);
    for (int u = blockIdx.x; u < 640 * 48; u += gridDim.x) {
        const int tt = u / 48, cb = u % 48, cc0 = cb * 128;
        *(LAS vu4*)(raw + ((tid >> 4) + 2) * 128 + g8 * 8) = pb0; *(LAS vu4*)(raw + ((tid >> 4) + 34) * 128 + g8 * 8) = pb1;
        if (tid < 64) { const int hr = tid >> 4; *(LAS vu4*)(raw + (hr < 2 ? hr : 64 + hr) * 128 + g8 * 8) = ph; }
        if (u + (int)gridDim.x < 640 * 48) CONV_FETCH(u + (int)gridDim.x);
        float cw[5][8];
#pragma unroll
        for (int tap = 0; tap < 5; ++tap) load8f(convw + tap * 6144 + cc0 + g8 * 8, cw[tap]);
        LDS_SYNC();
        vu4 outv[2];
#pragma unroll
        for (int i = 0; i < 2; ++i) { const int r = (tid >> 4) + 32 * i; float acc[8];
#pragma unroll
            for (int j = 0; j < 8; ++j) acc[j] = 0.f;
#pragma unroll
            for (int tap = 0; tap < 5; ++tap) { float xv[8]; unpack8(*(const LAS vu4*)(raw + (r + tap) * 128 + g8 * 8), xv);
#pragma unroll
                for (int j = 0; j < 8; ++j) acc[j] += cw[tap][j] * xv[j]; }
            float ss = 0.f;
#pragma unroll
            for (int j = 0; j < 8; ++j) { acc[j] = silu_f(acc[j]); ss += acc[j] * acc[j]; }
            if (norm_mode == 1 && cb < 32) { ss += __shfl_xor(ss, 1); ss += __shfl_xor(ss, 2); ss += __shfl_xor(ss, 4); ss += __shfl_xor(ss, 8);
                const float sc = rsqrtf(ss + EPSN) * (cb < 16 ? 0.08838834764831845f : 1.0f);
#pragma unroll
                for (int j = 0; j < 8; ++j) acc[j] *= sc; }
            outv[i] = pack8(acc); }
        { const size_t bs = (((size_t)tt * 768 + cb * 16 + g8) * 64 + (tid >> 4)) * 8; *(vu4*)(XT + bs) = outv[0]; *(vu4*)(XT + bs + 32 * 8) = outv[1]; }
        LDS_SYNC();
    }
#undef CONV_FETCH
}

typedef short bf16x8_t __attribute__((ext_vector_type(8)));
typedef unsigned vu2 __attribute__((ext_vector_type(2)));
__device__ __forceinline__ bf16x8_t ldfrag(const LAS bf16_t* base, int ld, int row0, int k0, int lane) { return *(const LAS bf16x8_t*)(base + (row0 + (lane & 15)) * ld + k0 + 8 * (lane >> 4)); }
__device__ __forceinline__ void stfragT(LAS bf16_t* base, int ld, int n0, int m0, int lane, const pg8::f32x4 v) {
    vu2 w; w.x = pg8::cvt_pk_bf16(v[0], v[1]); w.y = pg8::cvt_pk_bf16(v[2], v[3]); *(LAS vu2*)(base + (n0 + (lane & 15)) * ld + m0 + 4 * (lane >> 4)) = w; }
typedef short s16x4_t __attribute__((ext_vector_type(4)));
__device__ __forceinline__ bf16x8_t trfragp(const LAS bf16_t* T, int ld, int c, int ks, int lane) {
    const int g = lane >> 4, q = (lane & 15) >> 2, p = lane & 3;
    const LAS bf16_t* a0 = T + (32 * ks + 8 * g + 2 * q) * ld + 16 * c + 4 * p;
    const s16x4_t lo = __builtin_amdgcn_ds_read_tr16_b64_v4i16((LAS s16x4_t*)a0), hi = __builtin_amdgcn_ds_read_tr16_b64_v4i16((LAS s16x4_t*)(a0 + ld));
    return (bf16x8_t){lo[0], lo[1], lo[2], lo[3], hi[0], hi[1], hi[2], hi[3]}; }
#define MFMA16(a, b, c) __builtin_amdgcn_mfma_f32_16x16x32_bf16(a, b, c, 0, 0, 0)

template <int VAR> __device__ __forceinline__ void ph_ssd_core3(const Args& a, lds_u8* lds, const bf16_t* GT, const bf16_t* XT, bf16_t* Y, bf16_t* Yfs) {
    constexpr int LDN = 136, LDJ = 72, NB = 64 * LDN, JB = 64 * LDJ, CSB = 196;
    LAS bf16_t* Cb2 = (LAS bf16_t*)lds;
    LAS bf16_t* Bb2 = Cb2 + 2 * NB;
    LAS bf16_t* xs2 = Bb2 + 2 * NB;
    LAS bf16_t* xw2 = xs2 + 2 * JB;
    LAS bf16_t* MmT = xw2 + 2 * JB;
    LAS bf16_t* Sb = MmT + JB;
    LAS bf16_t* Ys = Sb + NB;
    LAS float* cs2 = (LAS float*)(Ys + JB);
    const int tid = threadIdx.x, lane = tid & 63, wave = __builtin_amdgcn_readfirstlane(tid >> 6), lr = lane & 15, lq = lane >> 4;
    const bool prod = wave < 4; const int pw = wave & 3;
    const float* a_log = ARG_IN(28); const float* dtb = ARG_IN(29); const float* Dp = ARG_IN(30);
    for (int i = tid; i < JB / 2; i += NTHR) ((LAS unsigned*)MmT)[i] = 0u;
    for (int u = blockIdx.x; u < 512; u += gridDim.x) {
        int s, hd, dlo, dhi;
        if (u < 256) { s = u >> 6; const int r = u & 63; hd = (r & 7) * 8 + (r >> 3); dlo = 0; dhi = 2; } else { const int v = u - 256, r = v & 127, rest = r >> 3; s = 4 + (v >> 7); hd = (r & 7) * 8 + (rest & 7); dlo = rest >> 3; dhi = dlo + 1; }
        const bool split = u >= 256;
        const int grp = hd >> 3, L = seq_len(s), row0 = seq_start(s), nT = L >> 6;
#pragma unroll 1
        for (int d = dlo; d < dhi; ++d) {
            if (prod) {
                const float Aneg = -expf(a_log[d * 64 + hd]), dtbias = dtb[d * 64 + hd];
                const float Dd = d == 0 ? Dp[hd] : 0.f;
                vu4 pre[10]; bf16_t pdt;
                { const int tile = d ? nT - 1 : 0; const size_t gt = (size_t)((row0 >> 6) + tile) * 768; const int tk = d ? 63 - lane : lane; const unsigned tko = (unsigned)tk * 8u;
#pragma unroll
                    for (int k = 0; k < 10; ++k) { const int gg = pw + 4 * k; const int cg = k < 2 ? hd * 8 + gg : (k < 6 ? 512 + grp * 16 + (gg - 8) : 640 + grp * 16 + (gg - 24)); const bf16_t* pp = XT + (gt + cg) * 512; pre[k] = *(const vu4*)(pp + tko); }
                    pdt = GT[((size_t)((row0 >> 6) + tile) * 128 + d * 64 + hd) * 64 + tk]; }
#pragma unroll 1
                for (int ti = 0; ti < nT; ++ti) {
                    const int bn = ti & 1;
                    LAS bf16_t* Cbn = Cb2 + bn * NB; LAS bf16_t* Bbn = Bb2 + bn * NB; LAS bf16_t* xsn = xs2 + bn * JB; LAS bf16_t* xwn = xw2 + bn * JB; LAS float* cs = cs2 + bn * CSB;
#pragma unroll
                    for (int k = 0; k < 10; ++k) { const int gg = pw + 4 * k; const vu4 rawv = pre[k];
                        if (k < 2) *(LAS vu4*)(xsn + lane * LDJ + gg * 8) = rawv;
                        else if (k < 6) *(LAS vu4*)(Bbn + lane * LDN + (gg - 8) * 8) = rawv;
                        else *(LAS vu4*)(Cbn + lane * LDN + (gg - 24) * 8) = rawv; }
                    const float dtv = softplus_fast(bf2f(pdt) + dtbias);
                    const float cum = wave_scan_incl(dtv * Aneg);
                    const float cumlast = lane63(cum);
                    const float xsc = dtv * __expf(cumlast - cum);
                    if (pw == 0) { cs[lane] = cum; cs[64 + lane] = __expf(cum); cs[128 + lane] = dtv; if (lane == 0) cs[192] = __expf(cumlast); }
#pragma unroll
                    for (int k = 0; k < 2; ++k) { const int gg = pw + 4 * k; float xv[8]; unpack8(pre[k], xv);
#pragma unroll
                        for (int j = 0; j < 8; ++j) xv[j] *= xsc;
                        *(LAS vu4*)(xwn + lane * LDJ + gg * 8) = pack8(xv); }
                    if (VAR == 1) {
#pragma unroll
                        for (int k = 0; k < 10; ++k) asm volatile("" : "+v"(pre[k]));
                    }
                    if (VAR != 1 && ti + 1 < nT) { const int tile2 = d ? nT - 2 - ti : ti + 1; const size_t gt = (size_t)((row0 >> 6) + tile2) * 768; const int tk = d ? 63 - lane : lane; const unsigned tko = (unsigned)tk * 8u;
#pragma unroll
                        for (int k = 0; k < 10; ++k) { const int gg = pw + 4 * k; const int cg = k < 2 ? hd * 8 + gg : (k < 6 ? 512 + grp * 16 + (gg - 8) : 640 + grp * 16 + (gg - 24)); const bf16_t* pp = XT + (gt + cg) * 512; pre[k] = *(const vu4*)(pp + tko); }
                        pdt = GT[((size_t)((row0 >> 6) + tile2) * 128 + d * 64 + hd) * 64 + tk]; }
                    LDS_SYNC();
                    bf16x8_t pc[3][4], pb[3][4];
#define SSD_P2_TILE(sl) int it, jt; bool on = true; \
                        if (sl == 0) { it = pw < 2 ? 3 : 2; jt = (pw & 1) * 2; } else if (sl == 1) { it = pw == 3 ? 1 : (pw < 2 ? 3 : 2); jt = pw == 1 ? 3 : 1; } else { it = pw; jt = 0; on = pw < 2; }
#define SSD_P2_LOAD(sl) { SSD_P2_TILE(sl) if (on) { _Pragma("unroll") for (int ks = 0; ks < 4; ++ks) { pc[sl][ks] = ldfrag(Cbn, LDN, it * 16, ks * 32, lane); pb[sl][ks] = ldfrag(Bbn, LDN, jt * 16, ks * 32, lane); } } }
#define SSD_P2_COMP(sl) { SSD_P2_TILE(sl) if (on) { pg8::f32x4 acc = (pg8::f32x4){0.f, 0.f, 0.f, 0.f}; \
                            _Pragma("unroll") for (int ks = 0; ks < 4; ++ks) acc = MFMA16(pc[sl][ks], pb[sl][ks], acc); \
                            const int i0 = it * 16 + 4 * lq, j = jt * 16 + lr; const float cj = cs[j], dj = cs[128 + j]; const vf4 ci = *(const LAS vf4*)(cs + i0); \
                            acc[0] = (j <= i0 + 0) ? acc[0] * (__expf(ci.x - cj) * dj) : 0.f; acc[1] = (j <= i0 + 1) ? acc[1] * (__expf(ci.y - cj) * dj) : 0.f; \
                            acc[2] = (j <= i0 + 2) ? acc[2] * (__expf(ci.z - cj) * dj) : 0.f; acc[3] = (j <= i0 + 3) ? acc[3] * (__expf(ci.w - cj) * dj) : 0.f; \
                            if (it == jt) { acc[0] += (j == i0 + 0) ? Dd : 0.f; acc[1] += (j == i0 + 1) ? Dd : 0.f; acc[2] += (j == i0 + 2) ? Dd : 0.f; acc[3] += (j == i0 + 3) ? Dd : 0.f; } \
                            stfragT(MmT, LDJ, jt * 16, it * 16, lane, acc); } }
                    SSD_P2_LOAD(0) SSD_P2_LOAD(1)
                    asm volatile("" ::: "memory");
                    SSD_P2_COMP(0)
                    asm volatile("" ::: "memory");
                    SSD_P2_LOAD(2)
                    SSD_P2_COMP(1)
                    asm volatile("" ::: "memory");
                    SSD_P2_COMP(2)
                    LDS_SYNC();
                }
                LDS_SYNC();
                LDS_SYNC();
            } else {
                const bool addf = d == 1 && !split;
                const int it = pw;
                pg8::f32x4 st[2][4];
#pragma unroll
                for (int q = 0; q < 2; ++q)
#pragma unroll
                    for (int pt = 0; pt < 4; ++pt) st[q][pt] = (pg8::f32x4){0.f, 0.f, 0.f, 0.f};
                for (int i = tid - 256; i < NB / 2; i += 256) ((LAS unsigned*)Sb)[i] = 0u;
                vu4 pyf[2] = {(vu4){0u, 0u, 0u, 0u}, (vu4){0u, 0u, 0u, 0u}};
                if (addf) {
#pragma unroll
                    for (int r = 0; r < 2; ++r) { const int idx = tid - 256 + 256 * r, i = idx >> 3, p8 = (idx & 7) * 8; pyf[r] = *(const vu4*)(Y + (size_t)(row0 + (nT - 1) * 64 + 63 - i) * 4096 + hd * 64 + p8); } }
                LDS_SYNC();
                LDS_SYNC();
#pragma unroll 1
                for (int sc = 0; sc < nT; ++sc) {
                    const int bc = sc & 1;
                    LAS const bf16_t* Cbc = Cb2 + bc * NB; LAS const bf16_t* xsc = xs2 + bc * JB; LAS const float* cs = cs2 + bc * CSB;
                    pg8::f32x4 acc[4];
#pragma unroll
                    for (int pt = 0; pt < 4; ++pt) acc[pt] = (pg8::f32x4){0.f, 0.f, 0.f, 0.f};
                    bf16x8_t cf[4], sf[4][4], mf[2], xf[2][4];
#pragma unroll
                    for (int ks = 0; ks < 2; ++ks) { cf[ks] = ldfrag(Cbc, LDN, it * 16, ks * 32, lane);
#pragma unroll
                        for (int pt = 0; pt < 4; ++pt) sf[ks][pt] = ldfrag(Sb, LDN, pt * 16, ks * 32, lane); }
                    const float ec = cs[64 + it * 16 + lr];
                    asm volatile("" ::: "memory");
#pragma unroll
                    for (int ks = 2; ks < 4; ++ks) { cf[ks] = ldfrag(Cbc, LDN, it * 16, ks * 32, lane);
#pragma unroll
                        for (int pt = 0; pt < 4; ++pt) sf[ks][pt] = ldfrag(Sb, LDN, pt * 16, ks * 32, lane); }
#pragma unroll
                    for (int ks = 0; ks < 2; ++ks)
#pragma unroll
                        for (int pt = 0; pt < 4; ++pt) acc[pt] = MFMA16(sf[ks][pt], cf[ks], acc[pt]);
                    asm volatile("" ::: "memory");
#pragma unroll
                    for (int ks = 0; ks < 2; ++ks) if (ks == 0 || it >= 2) { mf[ks] = trfragp(MmT, LDJ, it, ks, lane);
#pragma unroll
                        for (int pt = 0; pt < 4; ++pt) xf[ks][pt] = trfragp(xsc, LDJ, pt, ks, lane); }
#pragma unroll
                    for (int ks = 2; ks < 4; ++ks)
#pragma unroll
                        for (int pt = 0; pt < 4; ++pt) acc[pt] = MFMA16(sf[ks][pt], cf[ks], acc[pt]);
                    asm volatile("" ::: "memory");
#pragma unroll
                    for (int pt = 0; pt < 4; ++pt) acc[pt] = acc[pt] * ec;
#pragma unroll
                    for (int ks = 0; ks < 2; ++ks) if (ks == 0 || it >= 2) {
#pragma unroll
                        for (int pt = 0; pt < 4; ++pt) acc[pt] = MFMA16(xf[ks][pt], mf[ks], acc[pt]); }
#pragma unroll
                    for (int pt = 0; pt < 4; ++pt) stfragT(Ys, LDJ, it * 16, pt * 16, lane, acc[pt]);
                    LDS_SYNC();
                    LAS const bf16_t* Bbc = Bb2 + bc * NB; LAS const bf16_t* xwc = xw2 + bc * JB; const float declast = cs[192];
                    const int tile = d ? nT - 1 - sc : sc, t0 = tile * 64;
                    bf16x8_t wf[2][4], bfr[2][2];
#pragma unroll
                    for (int ks = 0; ks < 2; ++ks) {
#pragma unroll
                        for (int pt = 0; pt < 4; ++pt) wf[ks][pt] = trfragp(xwc, LDJ, pt, ks, lane);
#pragma unroll
                        for (int q = 0; q < 2; ++q) bfr[ks][q] = trfragp(Bbc, LDN, 2 * pw + q, ks, lane); }
                    vu4 yv[2];
#pragma unroll
                    for (int r = 0; r < 2; ++r) { const int idx = tid - 256 + 256 * r, i = idx >> 3, p8 = (idx & 7) * 8; yv[r] = *(const LAS vu4*)(Ys + i * LDJ + p8); }
                    asm volatile("" ::: "memory");
#pragma unroll
                    for (int q = 0; q < 2; ++q)
#pragma unroll
                        for (int pt = 0; pt < 4; ++pt) st[q][pt] = st[q][pt] * declast;
#pragma unroll
                    for (int ks = 0; ks < 2; ++ks)
#pragma unroll
                        for (int q = 0; q < 2; ++q)
#pragma unroll
                            for (int pt = 0; pt < 4; ++pt) st[q][pt] = MFMA16(bfr[ks][q], wf[ks][pt], st[q][pt]);
#pragma unroll
                    for (int q = 0; q < 2; ++q)
#pragma unroll
                        for (int pt = 0; pt < 4; ++pt) stfragT(Sb, LDN, pt * 16, (2 * pw + q) * 16, lane, st[q][pt]);
                    vu4 pyn[2] = {pyf[0], pyf[1]};
                    if (VAR != 1 && addf && sc + 1 < nT) { const int tile2 = nT - 2 - sc;
#pragma unroll
                        for (int r = 0; r < 2; ++r) { const int idx = tid - 256 + 256 * r, i = idx >> 3, p8 = (idx & 7) * 8; pyn[r] = *(const vu4*)(Y + (size_t)(row0 + tile2 * 64 + 63 - i) * 4096 + hd * 64 + p8); } }
#pragma unroll
                    for (int r = 0; r < 2; ++r) { const int idx = tid - 256 + 256 * r, i = idx >> 3, p8 = (idx & 7) * 8;
                        const int orow = row0 + t0 + (d ? 63 - i : i);
                        bf16_t* dst = (split && d == 0 ? Yfs + (size_t)(orow - 32768) * 4096 : Y + (size_t)orow * 4096) + hd * 64 + p8;
                        vu4 o = yv[r];
                        if (addf) { float of[8], pf[8]; unpack8(o, of); unpack8(pyf[r], pf);
#pragma unroll
                            for (int j = 0; j < 8; ++j) of[j] += pf[j];
                            o = pack8(of); }
                        if (VAR != 1) *(vu4*)dst = o; else asm volatile("" :: "v"(o)); }
                    pyf[0] = pyn[0]; pyf[1] = pyn[1];
                    LDS_SYNC();
                }
            }
            __syncthreads();
        }
    }
}

__device__ __forceinline__ bf16x8_t dn_afrag2(const LAS bf16_t* AD, int row, int c0, int c1, int lq) {
    const vu2 lo = *(const LAS vu2*)(AD + row * 72 + 16 * c0 + 4 * lq); vu2 hi = (vu2){0u, 0u}; if (c1 >= 0) hi = *(const LAS vu2*)(AD + row * 72 + 16 * c1 + 4 * lq);
    const vu4 w = (vu4){lo.x, lo.y, hi.x, hi.y}; return __builtin_bit_cast(bf16x8_t, w); }
__device__ __forceinline__ bf16x8_t dn_bfrag2(const pg8::f32x4 x0, const pg8::f32x4 x1, bool has1) {
    vu4 w; w.x = pg8::cvt_pk_bf16(x0[0], x0[1]); w.y = pg8::cvt_pk_bf16(x0[2], x0[3]); w.z = has1 ? pg8::cvt_pk_bf16(x1[0], x1[1]) : 0u; w.w = has1 ? pg8::cvt_pk_bf16(x1[2], x1[3]) : 0u;
    return __builtin_bit_cast(bf16x8_t, w); }

#define STAGE_IDS int lane_q = lane_f, wave_q = wave_f, tid_q = tid_f; asm volatile("" : "+v"(lane_q), "+s"(wave_q), "+v"(tid_q)); const int lane = lane_q, wave = wave_q, tid = tid_q, lr = lane & 15, lq = lane >> 4; (void)tid; (void)lr; (void)lq; (void)wave;
#ifndef DN_PREFETCH
#define DN_PREFETCH 1
#endif
__device__ __forceinline__ void ph_dn_core2(const Args& a, lds_u8* lds, const bf16_t* GT, const bf16_t* XT, bf16_t* of, bf16_t* ob) {
    constexpr int LDN = 136, LDJ = 72;
    LAS bf16_t* qsb = (LAS bf16_t*)lds;
    LAS bf16_t* ksb = qsb + 64 * LDN;
    LAS bf16_t* kwT = ksb + 64 * LDN;
    LAS bf16_t* vT = kwT + 128 * LDJ;
    LAS bf16_t* Sb = vT + 128 * LDJ;
    LAS bf16_t* Pm = Sb + 128 * LDN;
    LAS bf16_t* AD = Pm + 64 * LDJ;
    LAS float* Ad = (LAS float*)(AD + 64 * LDJ);
    LAS float* Gv = Ad + 4 * 16 * 20;
    LAS float* eG = Gv + 64;
    LAS float* bet = eG + 64;
    LAS bf16_t* Os = ksb; LAS bf16_t* VnT = vT;
    const int tid = threadIdx.x, lane = tid & 63, wave = __builtin_amdgcn_readfirstlane(tid >> 6);
    const int tid_f = tid, lane_f = lane, wave_f = wave;
    const float* a_log = ARG_IN(12); const float* dtb = ARG_IN(13);
    for (int u = blockIdx.x; u < 192; u += gridDim.x) {
        int s, rr; if (u < 128) { s = u >> 5; rr = u & 31; } else { s = 4 + ((u - 128) >> 5); rr = (u - 128) & 31; }
        const int h = rr >> 1, d = rr & 1;
        const int L = seq_len(s), row0 = seq_start(s), nT = L >> 6;
        const float Aneg = -expf(a_log[d * 16 + h]), dtbias = dtb[d * 16 + h];
        pg8::f32x4 st[8];
#pragma unroll
        for (int q = 0; q < 8; ++q) st[q] = (pg8::f32x4){0.f, 0.f, 0.f, 0.f};
        for (int i = tid; i < 128 * LDN / 2; i += NTHR) ((LAS unsigned*)Sb)[i] = 0u;
        for (int i = tid; i < 64 * LDJ / 2; i += NTHR) ((LAS unsigned*)Pm)[i] = 0u;
        vu4 pq[2], pk[2], pv[2]; bf16_t pb, pa;
        { const int tile = d ? nT - 1 : 0; const size_t gt = (size_t)((row0 >> 6) + tile) * 768; const int tk = d ? 63 - lane : lane;
#pragma unroll
            for (int k = 0; k < 2; ++k) { const int cg = h * 16 + wave + 8 * k; pq[k] = *(const vu4*)(XT + ((gt + cg) * 64 + tk) * 8); pk[k] = *(const vu4*)(XT + ((gt + 256 + cg) * 64 + tk) * 8); pv[k] = *(const vu4*)(XT + ((gt + 512 + cg) * 64 + tk) * 8); }
            pb = GT[((size_t)((row0 >> 6) + tile) * 64 + d * 16 + h) * 64 + tk]; pa = GT[((size_t)((row0 >> 6) + tile) * 64 + 32 + d * 16 + h) * 64 + tk]; }
#pragma unroll 1
        for (int ti = 0; ti < nT; ++ti) {
            const int tile = d ? nT - 1 - ti : ti, t0 = tile * 64;
            float declast;
            { STAGE_IDS
            const float be = __builtin_amdgcn_rcpf(1.0f + __expf(-bf2f(pb)));
            const float G = wave_scan_incl(Aneg * softplus_fast(bf2f(pa) + dtbias));
            const float Glast = lane63(G), wgt = __expf(Glast - G); declast = __expf(Glast);
            if (wave == 0) { Gv[lane] = G; eG[lane] = __expf(G); bet[lane] = be; }
#pragma unroll
            for (int k = 0; k < 2; ++k) { const int c0 = (wave + 8 * k) * 8;
                *(LAS vu4*)(qsb + lane * LDN + c0) = pq[k];
                *(LAS vu4*)(ksb + lane * LDN + c0) = pk[k]; float kv[8]; unpack8(pk[k], kv);
#pragma unroll
                for (int j = 0; j < 8; ++j) { const float x = kv[j] * wgt; kwT[(c0 + j) * LDJ + lane] = (bf16_t)(pg8::cvt_pk_bf16(x, x) & 0xffffu); }
                const vu4 rawv = pv[k];
                vT[(c0 + 0) * LDJ + lane] = (bf16_t)(rawv.x & 0xffffu); vT[(c0 + 1) * LDJ + lane] = (bf16_t)(rawv.x >> 16); vT[(c0 + 2) * LDJ + lane] = (bf16_t)(rawv.y & 0xffffu); vT[(c0 + 3) * LDJ + lane] = (bf16_t)(rawv.y >> 16);
                vT[(c0 + 4) * LDJ + lane] = (bf16_t)(rawv.z & 0xffffu); vT[(c0 + 5) * LDJ + lane] = (bf16_t)(rawv.z >> 16); vT[(c0 + 6) * LDJ + lane] = (bf16_t)(rawv.w & 0xffffu); vT[(c0 + 7) * LDJ + lane] = (bf16_t)(rawv.w >> 16); }
#if DN_PREFETCH
            if (ti + 1 < nT) { const int tile2 = d ? nT - 2 - ti : ti + 1; const size_t gt = (size_t)((row0 >> 6) + tile2) * 768; const int tk = d ? 63 - lane : lane;
#pragma unroll
                for (int k = 0; k < 2; ++k) { const int cg = h * 16 + wave + 8 * k; pq[k] = *(const vu4*)(XT + ((gt + cg) * 64 + tk) * 8); pk[k] = *(const vu4*)(XT + ((gt + 256 + cg) * 64 + tk) * 8); pv[k] = *(const vu4*)(XT + ((gt + 512 + cg) * 64 + tk) * 8); }
                pb = GT[((size_t)((row0 >> 6) + tile2) * 64 + d * 16 + h) * 64 + tk]; pa = GT[((size_t)((row0 >> 6) + tile2) * 64 + 32 + d * 16 + h) * 64 + tk]; }
#endif
            }
            LDS_SYNC();
            { STAGE_IDS
            { bf16x8_t ja[3][4], jc[3][4]; float jgi[3], jbi[3]; vf4 jgj[3]; pg8::f32x4 jacc[3];
#define DN_JOB(jb) const int idr = wave + 8 * jb; const bool on = idr < 20; const int id = on ? idr : 19; const int kind = id >= 10 ? 1 : 0, pr = id - 10 * kind, it = pr >= 6 ? 3 : (pr >= 3 ? 2 : (pr >= 1 ? 1 : 0)), jt = pr - (it * (it + 1)) / 2; \
                const int ii = it * 16 + lr, j0 = jt * 16 + 4 * lq;
#define DN_JOB_LOAD(jb) { DN_JOB(jb) const LAS bf16_t* bsrc = kind ? qsb : ksb; \
                    _Pragma("unroll") for (int ks = 0; ks < 4; ++ks) { ja[jb][ks] = ldfrag(ksb, LDN, jt * 16, ks * 32, lane); jc[jb][ks] = ldfrag(bsrc, LDN, it * 16, ks * 32, lane); } \
                    jgi[jb] = Gv[ii]; jgj[jb] = *(const LAS vf4*)(Gv + j0); jbi[jb] = bet[ii]; }
#define DN_JOB_MM(jb) { jacc[jb] = (pg8::f32x4){0.f, 0.f, 0.f, 0.f}; \
                    _Pragma("unroll") for (int ks = 0; ks < 4; ++ks) jacc[jb] = MFMA16(ja[jb][ks], jc[jb][ks], jacc[jb]); }
#define DN_JOB_EPI(jb) { DN_JOB(jb) const pg8::f32x4 acc = jacc[jb]; const float gi = jgi[jb]; const vf4 gj = jgj[jb]; const float mul = kind ? 1.0f : jbi[jb]; const int lim = ii + kind; pg8::f32x4 o; \
                    o[0] = (j0 + 0 < lim) ? mul * acc[0] * __expf(gi - gj.x) : 0.f; o[1] = (j0 + 1 < lim) ? mul * acc[1] * __expf(gi - gj.y) : 0.f; \
                    o[2] = (j0 + 2 < lim) ? mul * acc[2] * __expf(gi - gj.z) : 0.f; o[3] = (j0 + 3 < lim) ? mul * acc[3] * __expf(gi - gj.w) : 0.f; \
                    if (on) { if (kind) stfragT(Pm, LDJ, it * 16, jt * 16, lane, o); \
                        else if (it == jt) *(LAS vf4*)(Ad + (it * 16 + lr) * 20 + 4 * lq) = (vf4){o[0], o[1], o[2], o[3]}; \
                        else stfragT(AD, LDJ, it * 16, jt * 16, lane, o); } }
                DN_JOB_LOAD(0)
                asm volatile("" ::: "memory");
                DN_JOB_MM(0) DN_JOB_LOAD(1) DN_JOB_EPI(0)
                asm volatile("" ::: "memory");
                DN_JOB_MM(1) DN_JOB_LOAD(2) DN_JOB_EPI(1)
                asm volatile("" ::: "memory");
                DN_JOB_MM(2) DN_JOB_EPI(2) }
            }
            LDS_SYNC();
            { STAGE_IDS
            if (wave == 0) { const int b = lane >> 4, j = lane & 15; float x[16];
                const LAS float* Ab = Ad + b * 16 * 20;
                vf4 ar[16][4];
#define DN_INV_LD(r) { _Pragma("unroll") for (int r4 = 0; r4 < ((r) + 3) / 4; ++r4) ar[r][r4] = *(const LAS vf4*)(Ab + (r) * 20 + r4 * 4); }
#define DN_INV_ROW(r) { float s0 = ((r) == j) ? 1.0f : 0.0f, s1 = 0.f; \
                    _Pragma("unroll") for (int r4 = 0; r4 < ((r) + 3) / 4; ++r4) { const vf4 av = ar[r][r4]; \
                        if (r4 * 4 + 0 < (r)) s0 -= av.x * x[r4 * 4 + 0]; if (r4 * 4 + 1 < (r)) s1 -= av.y * x[r4 * 4 + 1]; if (r4 * 4 + 2 < (r)) s0 -= av.z * x[r4 * 4 + 2]; if (r4 * 4 + 3 < (r)) s1 -= av.w * x[r4 * 4 + 3]; } \
                    x[r] = s0 + s1; }
                DN_INV_LD(1) DN_INV_LD(2) DN_INV_LD(3) DN_INV_LD(4) DN_INV_LD(5) DN_INV_LD(6) DN_INV_LD(7) DN_INV_LD(8)
                asm volatile("" ::: "memory");
                DN_INV_ROW(0) DN_INV_ROW(1) DN_INV_ROW(2) DN_INV_ROW(3) DN_INV_ROW(4)
                DN_INV_LD(9) DN_INV_LD(10)
                asm volatile("" ::: "memory");
                DN_INV_ROW(5) DN_INV_ROW(6) DN_INV_ROW(7) DN_INV_ROW(8)
                DN_INV_LD(11) DN_INV_LD(12)
                asm volatile("" ::: "memory");
                DN_INV_ROW(9) DN_INV_ROW(10)
                DN_INV_LD(13) DN_INV_LD(14)
                asm volatile("" ::: "memory");
                DN_INV_ROW(11) DN_INV_ROW(12)
                DN_INV_LD(15)
                asm volatile("" ::: "memory");
                DN_INV_ROW(13) DN_INV_ROW(14) DN_INV_ROW(15)
#pragma unroll
                for (int r = 0; r < 16; ++r) AD[(16 * b + r) * LDJ + 16 * b + j] = (bf16_t)(pg8::cvt_pk_bf16(x[r], x[r]) & 0xffffu); }
            }
            pg8::f32x4 ao[4], Rr[4];
            { STAGE_IDS
            { bf16x8_t sbf[4], tf[8][4]; vf4 tb4[4], te4[4]; vu2 tvr[4];
#pragma unroll
                for (int ks = 0; ks < 4; ++ks) sbf[ks] = ldfrag(Sb, LDN, wave * 16, ks * 32, lane);
#define DN_T_LOAD(t) { if ((t) < 4) { _Pragma("unroll") for (int ks = 0; ks < 4; ++ks) tf[t][ks] = ldfrag(qsb, LDN, (t) * 16, ks * 32, lane); } \
                    else { _Pragma("unroll") for (int ks = 0; ks < 4; ++ks) tf[t][ks] = ldfrag(ksb, LDN, ((t) - 4) * 16, ks * 32, lane); \
                        const int j0 = ((t) - 4) * 16 + 4 * lq; tb4[(t) & 3] = *(const LAS vf4*)(bet + j0); te4[(t) & 3] = *(const LAS vf4*)(eG + j0); tvr[(t) & 3] = *(const LAS vu2*)(vT + (wave * 16 + lr) * LDJ + j0); } }
#define DN_T_COMP(t) { pg8::f32x4 acc = (pg8::f32x4){0.f, 0.f, 0.f, 0.f}; \
                    if ((t) < 4) { _Pragma("unroll") for (int ks = 0; ks < 4; ++ks) acc = MFMA16(sbf[ks], tf[t][ks], acc); ao[(t) & 3] = acc; } \
                    else { _Pragma("unroll") for (int ks = 0; ks < 4; ++ks) acc = MFMA16(tf[t][ks], sbf[ks], acc); \
                        const vf4 b4 = tb4[(t) & 3], e4 = te4[(t) & 3]; const vu2 vr = tvr[(t) & 3]; \
                        Rr[(t) & 3][0] = b4.x * (__uint_as_float(vr.x << 16) - e4.x * acc[0]); Rr[(t) & 3][1] = b4.y * (__uint_as_float(vr.x & 0xffff0000u) - e4.y * acc[1]); \
                        Rr[(t) & 3][2] = b4.z * (__uint_as_float(vr.y << 16) - e4.z * acc[2]); Rr[(t) & 3][3] = b4.w * (__uint_as_float(vr.y & 0xffff0000u) - e4.w * acc[3]); } }
                DN_T_LOAD(0)
                asm volatile("" ::: "memory");
                DN_T_LOAD(1) DN_T_COMP(0)
                asm volatile("" ::: "memory");
                DN_T_LOAD(2) DN_T_COMP(1)
                asm volatile("" ::: "memory");
                DN_T_LOAD(3) DN_T_COMP(2)
                asm volatile("" ::: "memory");
                DN_T_LOAD(4) DN_T_COMP(3)
                asm volatile("" ::: "memory");
                DN_T_LOAD(5) DN_T_COMP(4)
                asm volatile("" ::: "memory");
                DN_T_LOAD(6) DN_T_COMP(5)
                asm volatile("" ::: "memory");
                DN_T_LOAD(7) DN_T_COMP(6)
                asm volatile("" ::: "memory");
                DN_T_COMP(7) }
            }
            LDS_SYNC();
            { STAGE_IDS
            { const pg8::f32x4 z4 = (pg8::f32x4){0.f, 0.f, 0.f, 0.f};
                const bf16x8_t f00 = dn_afrag2(AD, 0 + lr, 0, -1, lq), f10 = dn_afrag2(AD, 16 + lr, 0, -1, lq), f11 = dn_afrag2(AD, 16 + lr, 1, -1, lq), f20 = dn_afrag2(AD, 32 + lr, 0, 1, lq), f22 = dn_afrag2(AD, 32 + lr, 2, -1, lq),
                    f30 = dn_afrag2(AD, 48 + lr, 0, 1, lq), f32 = dn_afrag2(AD, 48 + lr, 2, -1, lq), f33 = dn_afrag2(AD, 48 + lr, 3, -1, lq);
                asm volatile("" ::: "memory");
                const pg8::f32x4 V0 = MFMA16(f00, dn_bfrag2(Rr[0], z4, false), z4);
                const pg8::f32x4 U1 = MFMA16(f10, dn_bfrag2(V0, z4, false), z4);
                const pg8::f32x4 V1 = MFMA16(f11, dn_bfrag2(Rr[1] - U1, z4, false), z4);
                const pg8::f32x4 U2 = MFMA16(f20, dn_bfrag2(V0, V1, true), z4);
                const pg8::f32x4 V2 = MFMA16(f22, dn_bfrag2(Rr[2] - U2, z4, false), z4);
                pg8::f32x4 U3 = MFMA16(f30, dn_bfrag2(V0, V1, true), z4);
                U3 = MFMA16(f32, dn_bfrag2(V2, z4, false), U3);
                const pg8::f32x4 V3 = MFMA16(f33, dn_bfrag2(Rr[3] - U3, z4, false), z4);
                stfragT(VnT, LDJ, wave * 16, 0, lane, V0); stfragT(VnT, LDJ, wave * 16, 16, lane, V1); stfragT(VnT, LDJ, wave * 16, 32, lane, V2); stfragT(VnT, LDJ, wave * 16, 48, lane, V3); }
            }
            LDS_SYNC();
            { STAGE_IDS
            { bf16x8_t vn[2], pm[4][2], kw[2], vv[8][2]; float eg[4];
#pragma unroll
                for (int ks = 0; ks < 2; ++ks) { vn[ks] = ldfrag(VnT, LDJ, wave * 16, ks * 32, lane); kw[ks] = ldfrag(kwT, LDJ, wave * 16, ks * 32, lane); }
#pragma unroll
                for (int it = 0; it < 4; ++it) { eg[it] = eG[it * 16 + lr]; pm[it][0] = ldfrag(Pm, LDJ, it * 16, 0, lane); if (it >= 2) pm[it][1] = ldfrag(Pm, LDJ, it * 16, 32, lane); }
#define DN_V_LOAD(vt) { vv[vt][0] = ldfrag(VnT, LDJ, (vt) * 16, 0, lane); vv[vt][1] = ldfrag(VnT, LDJ, (vt) * 16, 32, lane); }
#define DN_V_COMP(vt) { st[vt] = st[vt] * declast; st[vt] = MFMA16(kw[0], vv[vt][0], st[vt]); st[vt] = MFMA16(kw[1], vv[vt][1], st[vt]); }
                DN_V_LOAD(0) DN_V_LOAD(1)
                asm volatile("" ::: "memory");
#pragma unroll
                for (int it = 0; it < 4; ++it) { ao[it] = ao[it] * eg[it];
                    ao[it] = MFMA16(vn[0], pm[it][0], ao[it]);
                    if (it >= 2) ao[it] = MFMA16(vn[1], pm[it][1], ao[it]);
                    stfragT(Os, LDN, it * 16, wave * 16, lane, ao[it]); }
                asm volatile("" ::: "memory");
                DN_V_LOAD(2) DN_V_LOAD(3) DN_V_COMP(0) DN_V_COMP(1)
                asm volatile("" ::: "memory");
                DN_V_LOAD(4) DN_V_LOAD(5) DN_V_COMP(2) DN_V_COMP(3)
                asm volatile("" ::: "memory");
                DN_V_LOAD(6) DN_V_LOAD(7) DN_V_COMP(4) DN_V_COMP(5)
                asm volatile("" ::: "memory");
                DN_V_COMP(6) DN_V_COMP(7) }
            }
            LDS_SYNC();
            { STAGE_IDS
#pragma unroll
            for (int vt = 0; vt < 8; ++vt) stfragT(Sb, LDN, vt * 16, wave * 16, lane, st[vt]);
            { const int i = tid >> 3, v16 = (tid & 7) * 16;
                bf16_t* dst = (d ? ob : of) + (size_t)(row0 + t0 + (d ? 63 - i : i)) * DM + h * 128 + v16;
                const vu4 o0 = *(const LAS vu4*)(Os + i * LDN + v16), o1 = *(const LAS vu4*)(Os + i * LDN + v16 + 8); *(vu4*)dst = o0; *(vu4*)(dst + 8) = o1; }
            }
            LDS_SYNC();
        }
    }
}

constexpr int HY_LD = 6144;
__device__ __forceinline__ void ph_hy_prep(const Args& a, lds_u8* lds, const bf16_t* proj, bf16_t* sT) {
    LAS float* tile = (LAS float*)lds;
    const int tid = threadIdx.x;
    const float* cw = ARG_IN(35);
    for (int u = blockIdx.x; u < 640 * 8; u += gridDim.x) {
        const int tt = u >> 3, ct = u & 7, row_t0 = tt * 64, c0 = ct * 256;
        const int s = seq_of_row(row_t0), L = seq_len(s), rs = seq_start(s), t0 = row_t0 - rs;
        { const int t = tid >> 3, c8s = (tid & 7) * 8;
            vu4 r1[4][3], r2[4][3];
#pragma unroll
            for (int q = 0; q < 4; ++q)
#pragma unroll
                for (int tap = 0; tap < 3; ++tap) { const int tq = t0 + t + tap - 1; r1[q][tap] = (vu4){0u, 0u, 0u, 0u}; r2[q][tap] = (vu4){0u, 0u, 0u, 0u};
                    if (tq >= 0 && tq < L) { const bf16_t* pr = proj + (size_t)(rs + tq) * HY_LD + c0 + q * 64 + c8s; r1[q][tap] = *(const vu4*)(pr + 2048); r2[q][tap] = *(const vu4*)(pr + 4096); } }
#pragma unroll
            for (int q = 0; q < 4; ++q) { float x1[8], vv[8];
#pragma unroll
                for (int j = 0; j < 8; ++j) { x1[j] = 0.f; vv[j] = 0.f; }
#pragma unroll
                for (int tap = 0; tap < 3; ++tap) { float f1[8], f2[8], w1[8], w2[8]; unpack8(r1[q][tap], f1); unpack8(r2[q][tap], f2);
                    load8f(cw + tap * 6144 + 2048 + c0 + q * 64 + c8s, w1); load8f(cw + tap * 6144 + 4096 + c0 + q * 64 + c8s, w2);
#pragma unroll
                    for (int j = 0; j < 8; ++j) { x1[j] += w1[j] * f1[j]; vv[j] += w2[j] * f2[j]; } }
#pragma unroll
                for (int j = 0; j < 8; ++j) tile[(q * 64 + c8s + j) * 65 + t] = x1[j] * vv[j]; } }
        LDS_SYNC();
        { const int c = tid >> 1, th = (tid & 1) * 32; bf16_t* dst = sT + (size_t)rs * DM + (size_t)(c0 + c) * L + t0 + th;
#pragma unroll
            for (int k = 0; k < 4; ++k) { float o[8];
#pragma unroll
                for (int j = 0; j < 8; ++j) o[j] = tile[c * 65 + th + k * 8 + j];
                *(vu4*)(dst + k * 8) = pack8(o); } }
        LDS_SYNC();
    }
}
__device__ __forceinline__ void ph_hy_fwoT(const float* fwo, bf16_t* fwoT) {
    for (int i8 = blockIdx.x * NTHR + threadIdx.x; i8 < 4096 * 8; i8 += gridDim.x * NTHR) { const int dcol = i8 >> 3, k0 = (i8 & 7) * 8; float v[8];
#pragma unroll
        for (int j = 0; j < 8; ++j) v[j] = fwo[(size_t)(k0 + j) * 4096 + dcol];
        *(vu4*)(fwoT + (size_t)dcol * 64 + k0) = pack8(v); }
}
__device__ __forceinline__ void ph_hy_filter(const Args& a, lds_u8* lds, const bf16_t* fwoT, float* hf8, float* hb8, float* hf4, float* hb4, int rank, int nrank) {
    LAS float* hA = (LAS float*)lds;
    LAS float* hB = hA + 64 * 64;
    LAS bf16_t* hdb = (LAS bf16_t*)(hB + 64 * 64);
    LAS float* outs = (LAS float*)(lds + 49152);
    const int tid = threadIdx.x, lane = tid & 63, wave = __builtin_amdgcn_readfirstlane(tid >> 6), lr = lane & 15, lq = lane >> 4;
    const float* fw1 = ARG_IN(36); const float* fb1 = ARG_IN(37); const float* fw2 = ARG_IN(38); const float* fb2 = ARG_IN(39);
    const float* fw3 = ARG_IN(40); const float* fb3 = ARG_IN(41); const float* freq = ARG_IN(43);
    for (int u = rank; u < 192; u += nrank) {
        int L, tt; if (u < 128) { L = 8192; tt = u; } else { L = 4096; tt = u - 128; }
        const int t0 = tt * 64; const float invLm1 = 1.0f / (float)(L - 1);
#pragma unroll 1
        for (int idx = tid; idx < 64 * 33; idx += NTHR) { const int t = idx / 33, f = idx % 33, ti = t0 + t; float val;
            if (f == 0) val = (float)ti / (float)(L - 1);
            else { const int j = (f - 1) & 15; const float fr = 1e-4f + (float)j * ((15.0f - 1e-4f) / 15.0f); float rev = fr * ((float)ti / (float)L); rev -= floorf(rev);
                const float ang = 6.283185307179586f * rev; val = f <= 16 ? cosf(ang) : -sinf(ang); }
            hA[t * 64 + f] = val; }
        LDS_SYNC();
        { const int t = tid >> 3, c8 = (tid & 7) * 8; float acc[8];
            load8f(fb1 + c8, acc);
#pragma unroll 1
            for (int f = 0; f < 33; ++f) { const float z = hA[t * 64 + f]; float w[8]; load8f(fw1 + f * 64 + c8, w);
#pragma unroll
                for (int j = 0; j < 8; ++j) acc[j] += z * w[j]; }
            float fq[8]; load8f(freq + c8, fq);
#pragma unroll
            for (int j = 0; j < 8; ++j) hB[t * 64 + c8 + j] = sinf(fq[j] * acc[j]); }
        LDS_SYNC();
        { const int t = tid >> 3, c8 = (tid & 7) * 8; float acc[8];
            load8f(fb2 + c8, acc);
#pragma unroll 2
            for (int f = 0; f < 64; ++f) { const float z = hB[t * 64 + f]; float w[8]; load8f(fw2 + f * 64 + c8, w);
#pragma unroll
                for (int j = 0; j < 8; ++j) acc[j] += z * w[j]; }
            float fq[8]; load8f(freq + 64 + c8, fq);
#pragma unroll
            for (int j = 0; j < 8; ++j) hA[t * 64 + c8 + j] = sinf(fq[j] * acc[j]); }
        LDS_SYNC();
        { const int t = tid >> 3, c8 = (tid & 7) * 8; float acc[8];
            load8f(fb3 + c8, acc);
#pragma unroll 2
            for (int f = 0; f < 64; ++f) { const float z = hA[t * 64 + f]; float w[8]; load8f(fw3 + f * 64 + c8, w);
#pragma unroll
                for (int j = 0; j < 8; ++j) acc[j] += z * w[j]; }
            float fq[8], o[8]; load8f(freq + 128 + c8, fq);
#pragma unroll
            for (int j = 0; j < 8; ++j) o[j] = sinf(fq[j] * acc[j]);
            *(LAS vu4*)(hdb + t * 72 + c8) = pack8(o); }
        LDS_SYNC();
        bf16x8_t Af[4][2];
#pragma unroll
        for (int tq = 0; tq < 4; ++tq)
#pragma unroll
            for (int ks = 0; ks < 2; ++ks) Af[tq][ks] = ldfrag(hdb, 72, tq * 16, ks * 32, lane);
        const float min_decay = -3.0701134573253944f, max_decay = -15.350567286626972f;
#pragma unroll 1
        for (int dc = 0; dc < 16; ++dc) {
#pragma unroll
            for (int q = 0; q < 2; ++q) { const int dcol = dc * 256 + wave * 32 + q * 16 + lr, ch = dcol & 2047;
                const bf16x8_t B0 = *(const bf16x8_t*)(fwoT + (size_t)dcol * 64 + 8 * lq), B1 = *(const bf16x8_t*)(fwoT + (size_t)dcol * 64 + 32 + 8 * lq);
                const float delta = (min_decay + (float)ch * ((max_decay - min_decay) / 2047.0f)) * invLm1;
                const float wb = __expf(delta * (float)(t0 + 4 * lq)), r1 = __expf(delta), r2 = r1 * r1, r3 = r2 * r1, r16 = __expf(16.0f * delta);
                float wt = wb;
#pragma unroll
                for (int tq = 0; tq < 4; ++tq) { pg8::f32x4 acc = (pg8::f32x4){0.f, 0.f, 0.f, 0.f};
                    acc = MFMA16(Af[tq][0], B0, acc); acc = MFMA16(Af[tq][1], B1, acc);
                    *(LAS vf4*)(outs + (wave * 32 + q * 16 + lr) * 68 + tq * 16 + 4 * lq) = (vf4){acc[0] * wt, acc[1] * (wt * r1), acc[2] * (wt * r2), acc[3] * (wt * r3)};
                    wt *= r16; } }
            LDS_SYNC();
            { const int dl = tid >> 1, th = (tid & 1) * 32, dcol = dc * 256 + dl, dir = dcol >> 11, ch = dcol & 2047;
                float* dst = (L == 8192 ? (dir ? hb8 : hf8) : (dir ? hb4 : hf4)) + (size_t)ch * L + t0 + th;
#pragma unroll
                for (int k = 0; k < 8; ++k) *(vf4*)(dst + k * 4) = *(const LAS vf4*)(outs + dl * 68 + th + k * 4); }
            LDS_SYNC();
        }
    }
}

template <int M, int Q, bool INV, int LS>
__device__ __forceinline__ void fft_group(vf2 (&v)[1 << Q], const int bl) {
    constexpr int R = 1 << Q, s0 = M - LS - Q;
    const float invN = 1.0f / (float)(1 << M);
    const float th0 = (float)(bl << s0) * invN;
    vf2 bp[Q]; bp[0] = (vf2){__builtin_amdgcn_cosf(th0), __builtin_amdgcn_sinf(th0)};
#pragma unroll
    for (int q = 1; q < Q; ++q) { const vf2 t = bp[q - 1]; bp[q] = (vf2){t.x * t.x - t.y * t.y, 2.0f * t.x * t.y}; }
#pragma unroll
    for (int qq = 0; qq < Q; ++qq) {
        const int q = INV ? Q - 1 - qq : qq;
        const int span = R >> (q + 1);
        float bqx = bp[q].x, bqy = bp[q].y; asm volatile("" : "+v"(bqx), "+v"(bqy), "+v"(v[0].x));
#pragma unroll
        for (int rl = 0; rl < span; ++rl) {
            const float cr = (float)__builtin_cos(6.283185307179586 * (rl << q) / R), sr = (float)__builtin_sin(6.283185307179586 * (rl << q) / R);
            const float c = rl == 0 ? bqx : bqx * cr - bqy * sr, sn = rl == 0 ? bqy : bqy * cr + bqx * sr;
#pragma unroll
            for (int rh = 0; rh < R; rh += 2 * span) { const int r = rh + rl;
                if (!INV) { const vf2 x = v[r], y = v[r + span]; v[r] = (vf2){x.x + y.x, x.y + y.y}; const float dx = x.x - y.x, dy = x.y - y.y;
                    v[r + span] = (vf2){dx * c + dy * sn, dy * c - dx * sn}; }
                else { const vf2 x = v[r], y = v[r + span]; const float bx = y.x * c - y.y * sn, by = y.y * c + y.x * sn;
                    v[r] = (vf2){x.x + bx, x.y + by}; v[r + span] = (vf2){x.x - bx, x.y - by}; } }
        }
    }
}
template <int M, int Q, bool INV, int LS>
__device__ __forceinline__ void fft_pass(LAS vf2* X, const int tid_in) {
    int tid = tid_in; asm volatile("" : "+v"(tid));
    constexpr int R = 1 << Q, HR = R / 2;
    constexpr int m = M, s0 = M - LS - Q, lstride = LS, stride = 1 << LS, groups = 1 << (M - Q);
    const float invN = 1.0f / (float)(1 << m);
#pragma unroll 1
    for (int g = tid; g < groups; g += NTHR) {
        const int bl = g & (stride - 1), bh = g >> lstride, base = (bh << (lstride + Q)) + bl;
        const int pb = LS >= 4 ? base + (base >> 4) : (LS + Q >= 4 ? base + (bh << (LS + Q - 4)) : base + (base >> 4));
#define FFT_POFF(r) (LS >= 4 ? (r) * ((1 << LS) + (1 << (LS >= 4 ? LS - 4 : 0))) : (LS + Q >= 4 ? ((r) << LS) + ((r) >> (4 - LS)) : (r)))
        vf2 v[R];
#pragma unroll
        for (int r = 0; r < R; ++r) v[r] = X[pb + FFT_POFF(r)];
            fft_group<M, Q, INV, LS>(v, bl);
#pragma unroll
        for (int r = 0; r < R; ++r) X[pb + FFT_POFF(r)] = v[r];
    }
}
template <int M> __device__ __forceinline__ void fft_fwd(LAS vf2* X, const int tid) {
    fft_pass<M, 4, false, M - 4>(X, tid); __syncthreads(); fft_pass<M, 4, false, M - 8>(X, tid); __syncthreads(); fft_pass<M, 4, false, M - 12>(X, tid); __syncthreads();
    fft_pass<M, M - 12, false, 0>(X, tid); __syncthreads(); }
template <int M>
__device__ __forceinline__ void fft_conv(LAS vf2* X, const int tid_in, const vf2* FS) {
    constexpr int groups = 1 << (M - 4);
    fft_pass<M, M - 12, false, 12>(X, tid_in); __syncthreads(); fft_pass<M, 4, false, 8>(X, tid_in); __syncthreads(); fft_pass<M, 4, false, 4>(X, tid_in); __syncthreads();
    int tid = tid_in; asm volatile("" : "+v"(tid));
    vf4 fA[8];
#pragma unroll
    for (int k = 0; k < 8; ++k) fA[k] = ((const vf4*)FS)[(unsigned)(8 * tid + k)];
    { const int pb = 17 * tid;
        vf2 v[16];
#pragma unroll
        for (int r = 0; r < 16; ++r) v[r] = X[pb + r];
        fft_group<M, 4, false, 0>(v, 0);
#pragma unroll
        for (int r = 0; r < 16; ++r) { const float fx = (r & 1) ? fA[r >> 1].z : fA[r >> 1].x, fy = (r & 1) ? fA[r >> 1].w : fA[r >> 1].y; const vf2 t = v[r]; v[r] = (vf2){t.x * fx - t.y * fy, t.x * fy + t.y * fx}; }
        fft_group<M, 4, true, 0>(v, 0);
#pragma unroll
        for (int r = 0; r < 16; ++r) X[pb + r] = v[r];
        if (groups > NTHR) { const int pb2 = 17 * (tid + NTHR);
            asm volatile("" ::: "memory");
            vf4 fB[8];
#pragma unroll
            for (int k = 0; k < 8; ++k) fB[k] = ((const vf4*)FS)[(unsigned)(8 * (tid + NTHR) + k)];
#pragma unroll
            for (int r = 0; r < 16; ++r) v[r] = X[pb2 + r];
            fft_group<M, 4, false, 0>(v, 0);
#pragma unroll
            for (int r = 0; r < 16; ++r) { const float fx = (r & 1) ? fB[r >> 1].z : fB[r >> 1].x, fy = (r & 1) ? fB[r >> 1].w : fB[r >> 1].y; const vf2 t = v[r]; v[r] = (vf2){t.x * fx - t.y * fy, t.x * fy + t.y * fx}; }
            fft_group<M, 4, true, 0>(v, 0);
#pragma unroll
            for (int r = 0; r < 16; ++r) X[pb2 + r] = v[r]; } }
    __syncthreads();
    fft_pass<M, 4, true, 4>(X, tid_in); __syncthreads(); fft_pass<M, 4, true, 8>(X, tid_in); __syncthreads(); fft_pass<M, M - 12, true, 12>(X, tid_in); __syncthreads();
}

template <int M>
__device__ __forceinline__ void hy_filter_spectra(LAS vf2* X, const int tid_in, const float* hfa, const float* hba, const float* hfb, const float* hbb, vf2* FSa, vf2* FSb) {
    constexpr int N = 1 << M, L = N >> 1;
    int tid = tid_in; asm volatile("" : "+v"(tid));
#pragma unroll 16
    for (int i = tid; i < N; i += NTHR) { float va, vb; if (i < L) { va = hfa[i]; vb = hfb[i]; } else if (i == L) { va = 0.f; vb = 0.f; } else { va = hba[N - i]; vb = hbb[N - i]; } X[i + (i >> 4)] = (vf2){va, vb}; }
    __syncthreads();
    fft_fwd<M>(X, tid);
    constexpr float sc = 0.5f / (float)N;
#pragma unroll 8
    for (int p = tid; p < N; p += NTHR) { const int k = (int)(__builtin_bitreverse32((unsigned)p) >> (32 - M)), kq = (N - k) & (N - 1), q = (int)(__builtin_bitreverse32((unsigned)kq) >> (32 - M));
        const vf2 zp = X[p + (p >> 4)], zq = X[q + (q >> 4)];
        FSa[p] = (vf2){(zp.x + zq.x) * sc, (zp.y - zq.y) * sc};
        FSb[p] = (vf2){(zp.y + zq.y) * sc, (zq.x - zp.x) * sc}; }
    __syncthreads();
}
template <int M, int NPAIR>
__device__ __forceinline__ void hy_fft_pairs(LAS vf2* X, const int tid_in, bf16_t* sA, const vf2* FSa, const vf2* FSb, const float fba, const float fbb) {
    constexpr int N = 1 << M, L = N >> 1, NCH = L / 8 / NTHR;
    vu4 nin0[NCH], nin1[NCH];
#define HYP_SEQ(q_, k_) (sA + (size_t)((q_) / NPAIR) * L + (size_t)(2 * ((q_) % NPAIR) + (k_)) * L * DM)
    { int tid = tid_in; asm volatile("" : "+v"(tid));
#pragma unroll
        for (int j = 0; j < NCH; ++j) { const int c = tid + NTHR * j; nin0[j] = ((const vu4*)HYP_SEQ(0, 0))[(unsigned)c]; nin1[j] = ((const vu4*)HYP_SEQ(0, 1))[(unsigned)c]; } }
#pragma unroll 1
    for (int q = 0; q < 2 * NPAIR; ++q) {
        int tid = tid_in; asm volatile("" : "+v"(tid));
        bf16_t* s0 = HYP_SEQ(q, 0); bf16_t* s1 = HYP_SEQ(q, 1);
        const vf2* FS = q < NPAIR ? FSa : FSb; const float fbias = q < NPAIR ? fba : fbb;
        vu4 in0[NCH], in1[NCH];
#pragma unroll
        for (int j = 0; j < NCH; ++j) { in0[j] = nin0[j]; in1[j] = nin1[j]; }
#pragma unroll 8
        for (int i = L + tid; i < N; i += NTHR) X[i + (i >> 4)] = (vf2){0.f, 0.f};
#pragma unroll
        for (int j = 0; j < NCH; ++j) { const int c = tid + NTHR * j; float f0[8], f1[8]; unpack8(in0[j], f0); unpack8(in1[j], f1);
#pragma unroll
            for (int e = 0; e < 8; ++e) { const int i = c * 8 + e; X[i + (i >> 4)] = (vf2){f0[e], f1[e]}; } }
        if (q + 1 < 2 * NPAIR) {
#pragma unroll
            for (int j = 0; j < NCH; ++j) { const int c = tid + NTHR * j; nin0[j] = ((const vu4*)HYP_SEQ(q + 1, 0))[(unsigned)c]; nin1[j] = ((const vu4*)HYP_SEQ(q + 1, 1))[(unsigned)c]; } }
        __syncthreads();
        fft_conv<M>(X, tid, FS);
#pragma unroll
        for (int j = 0; j < NCH; ++j) { const int c = tid + NTHR * j; float f0[8], f1[8], o0[8], o1[8]; unpack8(in0[j], f0); unpack8(in1[j], f1);
#pragma unroll
            for (int e = 0; e < 8; ++e) { const int i = c * 8 + e; const vf2 t = X[i + (i >> 4)]; o0[e] = t.x + f0[e] * fbias; o1[e] = t.y + f1[e] * fbias; }
            ((vu4*)s0)[(unsigned)c] = pack8(o0); ((vu4*)s1)[(unsigned)c] = pack8(o1); }
        __syncthreads();
    }
}
__device__ __forceinline__ void ph_hy_fft(lds_u8* lds, bf16_t* sT, const float* hf8, const float* hb8, const float* hf4, const float* hb4, vf2* FSall, const float* fbias) {
    LAS vf2* X = (LAS vf2*)lds;
    const int tid = threadIdx.x;
    vf2* FSa = FSall + (size_t)blockIdx.x * 32768; vf2* FSb = FSa + 16384;
    for (int cp = blockIdx.x; cp < DM / 2; cp += gridDim.x) {
        const int ca = 2 * cp, cb = ca + 1; const float fba = fbias[ca], fbb = fbias[cb];
        hy_filter_spectra<14>(X, tid, hf8 + (size_t)ca * 8192, hb8 + (size_t)ca * 8192, hf8 + (size_t)cb * 8192, hb8 + (size_t)cb * 8192, FSa, FSb);
        hy_fft_pairs<14, 2>(X, tid, sT + (size_t)ca * 8192, FSa, FSb, fba, fbb);
        hy_filter_spectra<13>(X, tid, hf4 + (size_t)ca * 4096, hb4 + (size_t)ca * 4096, hf4 + (size_t)cb * 4096, hb4 + (size_t)cb * 4096, FSa, FSb);
        hy_fft_pairs<13, 1>(X, tid, sT + (size_t)32768 * DM + (size_t)ca * 4096, FSa, FSb, fba, fbb);
    }
}
__device__ __forceinline__ void ph_hy_post(const Args& a, lds_u8* lds, const bf16_t* proj, const bf16_t* sT, bf16_t* Yo) {
    LAS float* tile = (LAS float*)lds;
    const int tid = threadIdx.x;
    const float* cw = ARG_IN(35);
    for (int u = blockIdx.x; u < 640 * 8; u += gridDim.x) {
        const int tt = u >> 3, ct = u & 7, row_t0 = tt * 64, c0 = ct * 256;
        const int s = seq_of_row(row_t0), L = seq_len(s), rs = seq_start(s), t0 = row_t0 - rs;
        { const int c = tid >> 1, th = (tid & 1) * 32; const bf16_t* src = sT + (size_t)rs * DM + (size_t)(c0 + c) * L + t0 + th;
            vu4 w[4];
#pragma unroll
            for (int k = 0; k < 4; ++k) w[k] = *(const vu4*)(src + k * 8);
#pragma unroll
            for (int k = 0; k < 4; ++k) { float o[8]; unpack8(w[k], o);
#pragma unroll
                for (int j = 0; j < 8; ++j) tile[c * 65 + th + k * 8 + j] = o[j]; } }
        LDS_SYNC();
        { const int t = tid >> 3, c8s = (tid & 7) * 8;
#pragma unroll
            for (int q = 0; q < 4; ++q) { float x0[8], o[8]; const int cc = c0 + q * 64 + c8s;
#pragma unroll
                for (int j = 0; j < 8; ++j) x0[j] = 0.f;
#pragma unroll
                for (int tap = 0; tap < 3; ++tap) { const int tq = t0 + t + tap - 1;
                    if (tq >= 0 && tq < L) { float r0[8], w0[8]; unpack8(*(const vu4*)(proj + (size_t)(rs + tq) * HY_LD + cc), r0); load8f(cw + tap * 6144 + cc, w0);
#pragma unroll
                        for (int j = 0; j < 8; ++j) x0[j] += w0[j] * r0[j]; } }
#pragma unroll
                for (int j = 0; j < 8; ++j) o[j] = tile[(q * 64 + c8s + j) * 65 + t] * x0[j];
                *(vu4*)(Yo + (size_t)(row_t0 + t) * DM + cc) = pack8(o); } }
        LDS_SYNC();
    }
}

#ifndef MK_PER_PHASE
#define MK_PER_PHASE 0
#endif
constexpr int N_PHASES = 37;

template <class Epi>
__device__ __forceinline__ void run_gemm(lds_u8* lds, const bf16_t* A, const bf16_t* Bt, int N, int K, const Epi& E) {
    pg8::Gemm g{A, Bt, NTOK, N, K, K, K}; pg8::StaticOrder S; S.init(NTOK, N, (int)gridDim.x, (int)blockIdx.x);
    pg8::gemm_phase<Epi, pg8::StaticOrder, true, true>(lds, g, S, E);
}

__global__ void __launch_bounds__(512, 2) mega_fwd(const Args args) {
    extern __shared__ __attribute__((aligned(16))) unsigned char shm[];
    lds_u8* lds = (lds_u8*)shm;
    const int lo = args.ph_lo, hi = args.ph_hi;
    XcdBarrier bar; bar.bar = (unsigned*)(args.ws + WS_BAR); bar.x = 0; bar.st = nullptr;
    if (hi - lo > 1) {
        if (threadIdx.x == 0) *(LAS vu4*)(lds + LDS_BAR_OFF) = (vu4){0u, 0u, 0u, 0u};
        __syncthreads();
        bar = xcd_barrier_post((unsigned*)(args.ws + WS_BAR), (volatile LAS unsigned*)(lds + LDS_BAR_OFF));
    }
#ifdef ONLY_PHASE
#define IN(k) ((k) == ONLY_PHASE && lo <= (k) && (k) < hi)
#else
#define IN(k) (lo <= (k) && (k) < hi)
#endif
#define SEAM(k) do { if (IN((k) + 1)) xcd_barrier(bar); } while (0)
#ifndef DUPMASK
#define DUPMASK 0ull
#endif
#define DUP(k) ((DUPMASK >> (k)) & 1ull)
#define PH(k, ...) if (IN(k)) { __VA_ARGS__ if (DUP(k)) { xcd_barrier(bar); __VA_ARGS__ } SEAM(k); }
#define PHL(k, ...) if (IN(k)) { __VA_ARGS__ }
    unsigned char* ws = args.ws;
    float* X = args.out;
    bf16_t* XB = (bf16_t*)(ws + WS_ARENA + 928 * MiB);
    float* mod = (float*)(ws + WS_MOD);
    unsigned char* XO = (unsigned char*)args.out;
    bf16_t* S5BY = (bf16_t*)XO; bf16_t* S5BE = (bf16_t*)(XO + 96 * MiB); float* S5LT = (float*)(ws + 3 * MiB);
    float* HF8 = (float*)(XO + 128 * MiB); float* HB8 = (float*)(XO + 192 * MiB); float* HF4 = (float*)(XO + 256 * MiB); float* HB4 = (float*)(XO + 288 * MiB);
    bf16_t* H = (bf16_t*)(ws + WS_H); bf16_t* HO = (bf16_t*)(ws + WS_HO);
    bf16_t* Wgu = (bf16_t*)(ws + WS_W + W_GU); bf16_t* Wdn = (bf16_t*)(ws + WS_W + W_DN); bf16_t* Wmi = (bf16_t*)(ws + WS_W + W_MIN); bf16_t* Wmo = (bf16_t*)(ws + WS_W + W_MOUT);
    unsigned char* AR = ws + WS_ARENA;
    bf16_t* ACT = (bf16_t*)AR;
    const float* ng = ARG_IN(6);
#define MODL(layer, k) (mod + (size_t)(layer) * 6 * 12288 + (size_t)(k) * 2048)
#define NG(layer, k) (ng + ((layer) * 4 + (k)) * 2048)

    PH(0, ph_ada(args, lds, 0, 192, (int)blockIdx.x, (int)gridDim.x); __syncthreads();
        ph_hy_fwoT(ARG_IN(42), (bf16_t*)(ws + 2 * MiB));
        cvt_wT(ARG_IN(10), DM, 8256, Wmi, 0, lds); cvt_wT(ARG_IN(15), DM, DM, Wmo, 0, lds);)
    PH(1, ph_row<false, false>(ARG_IN(0), ARG_IN(1), nullptr, nullptr, nullptr, nullptr, NG(0, 0), MODL(0, 0), H);)
    bf16_t* DNP = (bf16_t*)AR; bf16_t* DNXT = (bf16_t*)(AR + 180 * MiB); bf16_t* DNO = (bf16_t*)(AR + 660 * MiB);
    bf16_t* DNHALO = (bf16_t*)(AR + 820 * MiB);
    PH(2, run_gemm(lds, H, Wmi, DN_LD, DM, pg8::EpiStoreTiled{DNP, DN_LD2, DNXT, DNHALO, 0, (bf16_t*)(AR + 850 * MiB), 8192, 64});
        if (blockIdx.x >= 160) { __syncthreads(); cvt_ffn_part(args, 0, lds, (int)blockIdx.x - 160, 96, nullptr, false); })
    PH(3, ph_conv_inplace(lds, DNXT, ARG_IN(11), DNHALO, 1);)
    PH(4, ph_dn_core2(args, lds, (const bf16_t*)(AR + 850 * MiB), DNXT, H, HO);
        if (blockIdx.x >= 192) { __syncthreads(); cvt_ffn_part(args, 0, lds, (int)blockIdx.x - 192, 64, nullptr, true); __syncthreads(); ph_s5_tables(args, lds, S5BY, S5BE, S5LT, (int)blockIdx.x - 192, 64); __syncthreads();
            ph_hy_filter(args, lds, (const bf16_t*)(ws + 2 * MiB), HF8, HB8, HF4, HB4, (int)blockIdx.x - 192, 64); __syncthreads(); cvt_wT(ARG_IN(26), DM, 10368, Wmi, 0, lds, (int)blockIdx.x - 192, 64); }
        else if (blockIdx.x >= 128) { __syncthreads(); ph_ada(args, lds, 192, 768, (int)blockIdx.x - 128, 64); })
    PH(5, ph_dn_combine(args, H, HO, DNP, DNO);)
    PH(6, run_gemm(lds, DNO, Wmo, DM, DM, pg8::EpiStoreT<false>{HO, DM, nullptr});)
    PH(7, ph_row<false, true>(ARG_IN(0), ARG_IN(1), (float*)XB, HO, NG(0, 1), MODL(0, 2), NG(0, 2), MODL(0, 3), H);)
    PH(8, run_gemm(lds, H, Wgu, 2 * DFF, DM, pg8::EpiSwiGLU{ACT, DFF}); if (blockIdx.x >= 128) { __syncthreads(); cvt_wT(ARG_IN(24), DM, DM, Wmo, 0, lds, (int)blockIdx.x - 128, 128); __syncthreads(); cvt_ffn_part(args, 1, lds, (int)blockIdx.x - 128, 128, AR + 856 * MiB, false); } else { __syncthreads(); cvt_ffn_part(args, 1, lds, (int)blockIdx.x, 128, AR + 856 * MiB, true); })
    PH(9, run_gemm(lds, ACT, Wdn, DM, DFF, pg8::EpiStoreT<false>{HO, DM, nullptr});)
    bf16_t* S5UG = (bf16_t*)AR; float* S5E = (float*)(AR + 368 * MiB);
    PH(10, ph_row<true, true>((const float*)XB, nullptr, (float*)XB, HO, NG(0, 3), MODL(0, 5), NG(1, 0), MODL(1, 0), nullptr, S5UG);
        )
    PH(11, run_gemm_s5(lds, S5UG, S5BE, 1, 512, 512, EpiS5E{S5E});)
    PH(12, ph_s5_scan(S5E, S5LT, S5UG);)
    PH(13, run_gemm_s5(lds, S5UG, S5BY, 2, 768, 768, EpiS5Y{H});)
    PH(14, run_gemm(lds, H, Wmo, DM, DM, pg8::EpiGLU{HO, DM, ARG_IN(25), H});)
    PH(15, ph_row<true, true>((const float*)XB, nullptr, (float*)XB, HO, NG(1, 1), MODL(1, 2), NG(1, 2), MODL(1, 3), H);)
    PH(16, run_gemm(lds, H, (const bf16_t*)(AR + 856 * MiB), 2 * DFF, DM, pg8::EpiSwiGLU{ACT, DFF}); if (blockIdx.x >= 128) { __syncthreads(); cvt_wT(ARG_IN(32), 4096, DM, Wmo, 0, lds, (int)blockIdx.x - 128, 128, ARG_IN(31)); __syncthreads(); cvt_ffn_part(args, 2, lds, (int)blockIdx.x - 128, 128, nullptr, false); } else { __syncthreads(); cvt_ffn_part(args, 2, lds, (int)blockIdx.x, 128, nullptr, true); })
    PH(17, run_gemm(lds, ACT, (const bf16_t*)(AR + 900 * MiB), DM, DFF, pg8::EpiStoreT<false>{HO, DM, nullptr});)
    PH(18, ph_row<true, true>((const float*)XB, nullptr, (float*)XB, HO, NG(1, 3), MODL(1, 5), NG(2, 0), MODL(2, 0), H);)
    bf16_t* SSP = (bf16_t*)AR; bf16_t* SSY = (bf16_t*)(ws + WS_H);
    bf16_t* HO2 = (bf16_t*)AR;
    bf16_t* SSHALO = (bf16_t*)(AR + 820 * MiB);
    bf16_t* SSXT = (bf16_t*)(AR + 340 * MiB);
    PH(19, run_gemm(lds, H, Wmi, SSD_LD, DM, pg8::EpiStoreTiled{SSP, SSD_LD2, SSXT, SSHALO, 4096, (bf16_t*)(AR + 850 * MiB), 10240, 128});)
    PH(20, ph_conv_inplace(lds, SSXT, ARG_IN(27), SSHALO, 0);)
#define SSD_ARGS (args, lds, (const bf16_t*)(AR + 850 * MiB), SSXT, SSY, (bf16_t*)(AR + 862 * MiB))
#ifdef SSD_PROBE
#define SSD_RUN { int nrep = 2; asm volatile("" : "+s"(nrep)); for (int rep = 0; rep < nrep; ++rep) { ph_ssd_core3<0> SSD_ARGS; if (rep + 1 < nrep) xcd_barrier(bar); } }
#else
#define SSD_RUN ph_ssd_core3<0> SSD_ARGS;
#endif
    PH(21, SSD_RUN)
    PH(22, ph_ssd_combine(args, SSY, SSP, (const bf16_t*)(AR + 862 * MiB));)
    PH(23, run_gemm(lds, SSY, Wmo, DM, 4096, pg8::EpiStoreT<false>{HO2, DM, nullptr});)
    PH(24, ph_row<true, true>((const float*)XB, nullptr, (float*)XB, HO2, NG(2, 1), MODL(2, 2), NG(2, 2), MODL(2, 3), H);)
    PH(25, run_gemm(lds, H, Wgu, 2 * DFF, DM, pg8::EpiSwiGLU{ACT, DFF}); if (blockIdx.x >= 128) { __syncthreads(); cvt_wT(ARG_IN(33), DM, 6144, Wmi, 0, lds, (int)blockIdx.x - 128, 128); cvt_wT(ARG_IN(45), DM, DM, Wmo, 0, lds, (int)blockIdx.x - 128, 128); __syncthreads(); cvt_ffn_part(args, 3, lds, (int)blockIdx.x - 128, 128, AR + 856 * MiB, false); } else { __syncthreads(); cvt_ffn_part(args, 3, lds, (int)blockIdx.x, 128, AR + 856 * MiB, true); })
    PH(26, run_gemm(lds, ACT, Wdn, DM, DFF, pg8::EpiStoreT<false>{HO, DM, nullptr});)
    PH(27, ph_row<true, true>((const float*)XB, nullptr, (float*)XB, HO, NG(2, 3), MODL(2, 5), NG(3, 0), MODL(3, 0), H);)
    bf16_t* HYP = (bf16_t*)AR; bf16_t* HYS = (bf16_t*)(AR + 480 * MiB);
    PH(28, run_gemm(lds, H, Wmi, HY_LD, DM, pg8::EpiStoreT<true>{HYP, HY_LD, ARG_IN(34)});)
    PH(29, ph_hy_prep(args, lds, HYP, HYS);)
    PH(30, ph_hy_fft(lds, HYS, HF8, HB8, HF4, HB4, (vf2*)(ws + WS_HO + 64 * MiB), ARG_IN(44));
        if (DUPMASK >> 63) { xcd_barrier(bar); ph_hy_prep(args, lds, HYP, HYS); xcd_barrier(bar); ph_hy_fft(lds, HYS, HF8, HB8, HF4, HB4, (vf2*)(ws + WS_HO + 64 * MiB), ARG_IN(44)); })
    PH(31, ph_hy_post(args, lds, HYP, HYS, H);)
    PH(32, run_gemm(lds, H, Wmo, DM, DM, pg8::EpiStoreT<true>{HO, DM, ARG_IN(46)});)
    PH(33, ph_row<true, true>((const float*)XB, nullptr, (float*)XB, HO, NG(3, 1), MODL(3, 2), NG(3, 2), MODL(3, 3), H);)
    PH(34, run_gemm(lds, H, (const bf16_t*)(AR + 856 * MiB), 2 * DFF, DM, pg8::EpiSwiGLU{ACT, DFF});)
    PH(35, run_gemm(lds, ACT, (const bf16_t*)(AR + 900 * MiB), DM, DFF, pg8::EpiStoreT<false>{HO, DM, nullptr});)
    PHL(36, ph_row<true, false>((const float*)XB, nullptr, X, HO, NG(3, 3), MODL(3, 5), nullptr, nullptr, nullptr);)
#undef IN
#undef SEAM
}

extern "C" void kernel_launch(void* const* d_in, const int* in_sizes, int n_in, void* d_out, int out_size, void* d_ws, size_t ws_size, hipStream_t stream) {
    static int grid = 0;
    if (grid == 0) {
        if (n_in != 47 || out_size != NTOK * DM || ws_size < WS_END) { fprintf(stderr, "kernel_launch: unexpected shapes (n_in %d, out %d, ws %zu); nothing launched\n", n_in, out_size, ws_size); grid = -1; return; }
        int dev = 0, cus = 0, per_cu = 0;
        if (hipGetDevice(&dev) != hipSuccess || hipDeviceGetAttribute(&cus, hipDeviceAttributeMultiprocessorCount, dev) != hipSuccess) { grid = -1; return; }
        if (hipFuncSetAttribute((const void*)mega_fwd, hipFuncAttributeMaxDynamicSharedMemorySize, LDS_BYTES) != hipSuccess) { fprintf(stderr, "kernel_launch: hipFuncSetAttribute failed\n"); grid = -1; return; }
        if (hipOccupancyMaxActiveBlocksPerMultiprocessor(&per_cu, (const void*)mega_fwd, NTHR, LDS_BYTES) != hipSuccess || per_cu < 1) { fprintf(stderr, "kernel_launch: occupancy query reports %d blocks per CU\n", per_cu); }
        (void)hipGetLastError();
        grid = cus;
    }
    if (grid < 0) return;
    (void)hipMemsetAsync((char*)d_ws + WS_BAR, 0, XCD_BAR_WORDS * sizeof(unsigned), stream);
    Args a{};
    for (int i = 0; i < 47; ++i) a.in[i] = (const float*)d_in[i];
    a.out = (float*)d_out; a.ws = (unsigned char*)d_ws;
#if MK_PER_PHASE
    for (int p = 0; p < N_PHASES; ++p) { a.ph_lo = p; a.ph_hi = p + 1; hipLaunchKernelGGL(mega_fwd, dim3(grid), dim3(NTHR), LDS_BYTES, stream, a); }
#else
    a.ph_lo = 0; a.ph_hi = N_PHASES;
    hipLaunchKernelGGL(mega_fwd, dim3(grid), dim3(NTHR), LDS_BYTES, stream, a);
#endif
}
```

```cpp
#define MK_PER_PHASE 0
#define DUPMASK 0ull
#include <hip/hip_runtime.h>
#include <cstdio>
#include <cstdint>
namespace pg8 {
#define PG8_LAS __attribute__((address_space(3)))
typedef unsigned short bf16_t;
typedef short bf16x8 __attribute__((ext_vector_type(8)));
typedef float f32x4 __attribute__((ext_vector_type(4)));
typedef unsigned u32x4 __attribute__((ext_vector_type(4)));
constexpr int BM = 256, BK = 64, HALF = 128, HTB = HALF * BK * 2  , STAGE_BYTES = 8 * HTB, NXCD = 8, WGM = 4;

__host__ __device__ __forceinline__ int lds_byte(int r, int c) { const int st = (r >> 4) * 2 + (c >> 5), rr = r & 15, cc = c & 31, ob = rr * 64 + cc * 2; return st * 1024 + (ob ^ (((ob >> 9) & 1) << 5)); }
__host__ __device__ __forceinline__ void stage_rc(int b, int& R, int& C) { const int st = b / 1024, sb = b % 1024, swz = sb ^ (((sb >> 9) & 1) << 5); R = (st >> 1) * 16 + swz / 64; C = (st & 1) * 32 + (swz % 64) / 2; }
__host__ __device__ __forceinline__ int perm32(int rho) { const int n = rho >> 4, i = rho & 15; return 8 * (i >> 2) + 4 * n + (i & 3); }

struct Unit { int pm, pn; };
struct Gemm { const bf16_t* A; const bf16_t* Bt; int M, N, K, lda, ldb; };

struct StaticOrder {
    int nM, nN, nwg, G, c;
    __host__ __device__ void init(int M, int N, int G_, int c_) { nM = M / BM; nN = N / BM; nwg = nM * nN; G = G_; c = c_; }
    __host__ __device__ bool next(int i, Unit& u) const {
        const long L = (long)i * G + c; if (L >= nwg) return false;
        int wgid = (int)L; { const int q = nwg / NXCD, r = nwg % NXCD, xcd = wgid % NXCD, off = wgid / NXCD; wgid = (xcd < r ? xcd * (q + 1) : r * (q + 1) + (xcd - r) * q) + off; }
        const int nig = WGM * nN, gid = wgid / nig, fm = gid * WGM, gsz = (nM - fm) < WGM ? (nM - fm) : WGM;
        u.pm = fm + ((wgid % nig) % gsz); u.pn = (wgid % nig) / gsz; return true;
    }
    __device__ __forceinline__ void a_ready(const Unit&) const {}
    __device__ __forceinline__ void done(const Unit&) const {}
};
typedef __bf16 bf16x2_cv __attribute__((ext_vector_type(2)));
typedef float f32x2_cv __attribute__((ext_vector_type(2)));
__device__ __forceinline__ unsigned cvt_pk_bf16(float lo, float hi) { const bf16x2_cv v = __builtin_convertvector((f32x2_cv){lo, hi}, bf16x2_cv); return __builtin_bit_cast(unsigned, v); }
__device__ __forceinline__ float sigmoid_f(float x) { return __builtin_amdgcn_rcpf(1.0f + __expf(-x)); }

template <bool BIAS> struct EpiStoreT {
    static constexpr bool PERM = true, AFTER_DRAIN = false;
    bf16_t* O; int ldc; const float* bias;
    __device__ __forceinline__ void operator()(const f32x4 (&acc)[2][2][4][2], const Unit& u, int wr, int wc, int fr, int fq) const {
        const int row0 = u.pm * BM + wr * 64 + fr; const int col0 = u.pn * BM + wc * 32 + 8 * fq;
        f32x4 bv[2][2];
        if (BIAS) {
#pragma unroll
            for (int bj = 0; bj < 2; ++bj)
#pragma unroll
                for (int n = 0; n < 2; ++n) bv[bj][n] = *(const f32x4*)(bias + col0 + bj * HALF + 4 * n); }
#pragma unroll
        for (int ai = 0; ai < 2; ++ai)
#pragma unroll
            for (int m = 0; m < 4; ++m) { bf16_t* rowp = O + (size_t)(row0 + ai * HALF + m * 16) * ldc + col0;
#pragma unroll
                for (int bj = 0; bj < 2; ++bj) { f32x4 v0 = acc[ai][bj][m][0], v1 = acc[ai][bj][m][1]; if (BIAS) { v0 = v0 + bv[bj][0]; v1 = v1 + bv[bj][1]; }
                    u32x4 w; w.x = cvt_pk_bf16(v0[0], v0[1]); w.y = cvt_pk_bf16(v0[2], v0[3]); w.z = cvt_pk_bf16(v1[0], v1[1]); w.w = cvt_pk_bf16(v1[2], v1[3]);
                    *(u32x4*)(rowp + bj * HALF) = w; } }
    }
};
struct EpiSwiGLU {
    static constexpr bool PERM = true, AFTER_DRAIN = false;
    bf16_t* O; int ldc;
    __device__ __forceinline__ void operator()(const f32x4 (&acc)[2][2][4][2], const Unit& u, int wr, int wc, int fr, int fq) const {
        const int row0 = u.pm * BM + wr * 64 + fr; const int col0 = u.pn * HALF + wc * 32 + 8 * fq;
#pragma unroll
        for (int ai = 0; ai < 2; ++ai)
#pragma unroll
            for (int m = 0; m < 4; ++m) { bf16_t* rowp = O + (size_t)(row0 + ai * HALF + m * 16) * ldc + col0;
                float o[8];
#pragma unroll
                for (int n = 0; n < 2; ++n)
#pragma unroll
                    for (int j = 0; j < 4; ++j) { const float g = acc[ai][0][m][n][j], up = acc[ai][1][m][n][j]; o[n * 4 + j] = g * sigmoid_f(g) * up; }
                u32x4 w; w.x = cvt_pk_bf16(o[0], o[1]); w.y = cvt_pk_bf16(o[2], o[3]); w.z = cvt_pk_bf16(o[4], o[5]); w.w = cvt_pk_bf16(o[6], o[7]);
                *(u32x4*)rowp = w; }
    }
};
struct EpiGLU {
    static constexpr bool PERM = true, AFTER_DRAIN = false;
    bf16_t* O; int ldc; const float* bias; const bf16_t* Y;
    __device__ __forceinline__ void operator()(const f32x4 (&acc)[2][2][4][2], const Unit& u, int wr, int wc, int fr, int fq) const {
        const int row0 = u.pm * BM + wr * 64 + fr; const int col0 = u.pn * BM + wc * 32 + 8 * fq;
        f32x4 bv[2][2];
#pragma unroll
        for (int bj = 0; bj < 2; ++bj)
#pragma unroll
            for (int n = 0; n < 2; ++n) bv[bj][n] = *(const f32x4*)(bias + col0 + bj * HALF + 4 * n);
#pragma unroll
        for (int ai = 0; ai < 2; ++ai)
#pragma unroll
            for (int m = 0; m < 4; ++m) { const size_t ro = (size_t)(row0 + ai * HALF + m * 16) * ldc + col0;
#pragma unroll
                for (int bj = 0; bj < 2; ++bj) { f32x4 v0 = acc[ai][bj][m][0] + bv[bj][0], v1 = acc[ai][bj][m][1] + bv[bj][1];
                    const u32x4 yw = *(const u32x4*)(Y + ro + bj * HALF);
                    float o[8];
                    o[0] = __uint_as_float(yw.x << 16) * sigmoid_f(v0[0]); o[1] = __uint_as_float(yw.x & 0xffff0000u) * sigmoid_f(v0[1]);
                    o[2] = __uint_as_float(yw.y << 16) * sigmoid_f(v0[2]); o[3] = __uint_as_float(yw.y & 0xffff0000u) * sigmoid_f(v0[3]);
                    o[4] = __uint_as_float(yw.z << 16) * sigmoid_f(v1[0]); o[5] = __uint_as_float(yw.z & 0xffff0000u) * sigmoid_f(v1[1]);
                    o[6] = __uint_as_float(yw.w << 16) * sigmoid_f(v1[2]); o[7] = __uint_as_float(yw.w & 0xffff0000u) * sigmoid_f(v1[3]);
                    u32x4 w; w.x = cvt_pk_bf16(o[0], o[1]); w.y = cvt_pk_bf16(o[2], o[3]); w.z = cvt_pk_bf16(o[4], o[5]); w.w = cvt_pk_bf16(o[6], o[7]);
                    *(u32x4*)(O + ro + bj * HALF) = w; } }
    }
};
struct EpiStoreTiled {
    static constexpr bool PERM = true, AFTER_DRAIN = false;
    bf16_t* O; int ldo; bf16_t* XT; bf16_t* halo; int c0; bf16_t* GT; int g0, gn;
    __device__ __forceinline__ void operator()(const f32x4 (&acc)[2][2][4][2], const Unit& u, int wr, int wc, int fr, int fq) const {
        const int row0 = u.pm * BM + wr * 64 + fr; const int col0 = u.pn * BM + wc * 32 + 8 * fq;
#pragma unroll
        for (int ai = 0; ai < 2; ++ai)
#pragma unroll
            for (int m = 0; m < 4; ++m) { const int row = row0 + ai * HALF + m * 16;
                const bool edge = (m == 0 && fr < 2) || (m == 3 && fr >= 14); const int slot = (m == 0) ? fr : fr - 12;
#pragma unroll
                for (int bj = 0; bj < 2; ++bj) { const f32x4 v0 = acc[ai][bj][m][0], v1 = acc[ai][bj][m][1];
                    u32x4 w; w.x = cvt_pk_bf16(v0[0], v0[1]); w.y = cvt_pk_bf16(v0[2], v0[3]); w.z = cvt_pk_bf16(v1[0], v1[1]); w.w = cvt_pk_bf16(v1[2], v1[3]);
                    const int col = col0 + bj * HALF, hc = col - c0;
                    if (hc >= 0 && hc < 6144) { *(u32x4*)(XT + (((size_t)(row >> 6) * 768 + (hc >> 3)) * 64 + (row & 63)) * 8) = w;
                        if (edge) *(u32x4*)(halo + ((size_t)(row >> 6) * 4 + slot) * 6144 + hc) = w; }
                    else { *(u32x4*)(O + (size_t)row * ldo + (hc < 0 ? col : col - 6144)) = w;
                        const int gc = col - g0;
                        if (gc >= 0 && gc < gn) { bf16_t* gp = GT + ((size_t)(row >> 6) * gn + gc) * 64 + (row & 63);
                            gp[0] = (bf16_t)(w.x & 0xffffu); gp[64] = (bf16_t)(w.x >> 16); gp[128] = (bf16_t)(w.y & 0xffffu); gp[192] = (bf16_t)(w.y >> 16);
                            gp[256] = (bf16_t)(w.z & 0xffffu); gp[320] = (bf16_t)(w.z >> 16); gp[384] = (bf16_t)(w.w & 0xffffu); gp[448] = (bf16_t)(w.w >> 16); } } } }
    }
};
template <class Epi, class Sched, bool ALIGN_EPI = false, bool SP2 = false>
__device__ __forceinline__ void gemm_phase(PG8_LAS unsigned char* lds, const Gemm g, const Sched& S, const Epi& E) {
    const int tid = threadIdx.x, wid = __builtin_amdgcn_readfirstlane(tid >> 6), lane = tid & 63, wr = wid >> 2, wc = wid & 3, fr = lane & 15, fq = lane >> 4;
    const int K = g.K, nt = K / BK;
    unsigned voffA[2], voffB[2];
#pragma unroll
    for (int i = 0; i < 2; ++i) { int R, C; stage_rc(tid * 16 + i * 8192, R, C); const int Rb = Epi::PERM ? ((R & ~31) + perm32(R & 31)) : R;
        voffA[i] = (unsigned)(R * g.lda + C) * 2u; voffB[i] = (unsigned)(Rb * g.ldb + C) * 2u; }
    const size_t kstep = (size_t)(BK * 2);
    const size_t hstepA = (size_t)HALF * g.lda * 2, hstepB = (size_t)HALF * g.ldb * 2;
    const size_t tstepA = 2 * hstepA, tstepB = 2 * hstepB;
    const unsigned ldsw = (unsigned)wid * 1024u;
    const int aoff = lds_byte(wr * 64 + fr, fq * 8), boff = lds_byte(wc * 32 + fr, fq * 8);
#define PG8_SA(b, h) (((b) * 2 + (h)) * HTB)
#define PG8_SB(b, h) ((4 + (b) * 2 + (h)) * HTB)
#define PG8_STAGE(bufoff, gbase, voff) do { _Pragma("unroll") for (int _i = 0; _i < 2; ++_i) \
        __builtin_amdgcn_global_load_lds((const unsigned*)((const char*)(gbase) + (voff)[_i]), (PG8_LAS unsigned*)(lds + (bufoff) + ldsw + _i * 8192), 16, 0, 0); } while (0)
#define PG8_LDA(dst, b, h) do { _Pragma("unroll") for (int m = 0; m < 4; ++m) _Pragma("unroll") for (int k = 0; k < 2; ++k) dst[m][k] = *(const PG8_LAS bf16x8*)(lds + PG8_SA(b, h) + aoff + m * 2048 + k * 1024); } while (0)
#define PG8_LDB(dst, b, h) do { _Pragma("unroll") for (int n = 0; n < 2; ++n) _Pragma("unroll") for (int k = 0; k < 2; ++k) dst[n][k] = *(const PG8_LAS bf16x8*)(lds + PG8_SB(b, h) + boff + n * 2048 + k * 1024); } while (0)
#define PG8_MMA(ai, bj, At, Bt) do { __builtin_amdgcn_s_setprio(1); _Pragma("unroll") for (int m = 0; m < 4; ++m) _Pragma("unroll") for (int n = 0; n < 2; ++n) _Pragma("unroll") for (int k = 0; k < 2; ++k) \
        acc[ai][bj][m][n] = __builtin_amdgcn_mfma_f32_16x16x32_bf16(Bt[n][k], At[m][k], acc[ai][bj][m][n], 0, 0, 0); __builtin_amdgcn_s_setprio(0); } while (0)
#define PG8_WAIT_V(n) asm volatile("s_waitcnt vmcnt(" #n ")" ::: "memory")
#define PG8_WAIT_L(n) asm volatile("s_waitcnt lgkmcnt(" #n ")" ::: "memory")
#define PG8_BAR __builtin_amdgcn_s_barrier()
#define PG8_SCHED __builtin_amdgcn_sched_barrier(0)
    Unit cur, nxt; int ui = 0;
    if (!S.next(0, cur)) return;
    f32x4 acc[2][2][4][2];
#pragma unroll
    for (int a = 0; a < 2; ++a)
#pragma unroll
        for (int b = 0; b < 2; ++b)
#pragma unroll
            for (int m = 0; m < 4; ++m)
#pragma unroll
                for (int n = 0; n < 2; ++n) acc[a][b][m][n] = (f32x4){0.f, 0.f, 0.f, 0.f};
    bf16x8 At[4][2], B0[2][2], B1[2][2];
    const char* cA = (const char*)g.A + (size_t)cur.pm * tstepA; const char* cB = (const char*)g.Bt + (size_t)cur.pn * tstepB;
    S.a_ready(cur);
    if constexpr (SP2) {
        PG8_STAGE(PG8_SB(0, 0), cB, voffB); PG8_STAGE(PG8_SB(0, 1), cB + hstepB, voffB); PG8_STAGE(PG8_SA(0, 0), cA, voffA); PG8_STAGE(PG8_SA(0, 1), cA + hstepA, voffA);
        if (wr == 1) PG8_BAR;
        PG8_WAIT_V(2); PG8_BAR;
        PG8_STAGE(PG8_SB(1, 0), cB + kstep, voffB); PG8_STAGE(PG8_SA(1, 0), cA + kstep, voffA); PG8_STAGE(PG8_SB(1, 1), cB + hstepB + kstep, voffB);
        PG8_WAIT_V(6); PG8_BAR;
    } else {
        PG8_STAGE(PG8_SB(0, 0), cB, voffB); PG8_STAGE(PG8_SA(0, 0), cA, voffA); PG8_STAGE(PG8_SB(0, 1), cB + hstepB, voffB); PG8_STAGE(PG8_SA(0, 1), cA + hstepA, voffA);
        if (wr == 1) PG8_BAR;
        PG8_WAIT_V(4); PG8_BAR;
        PG8_STAGE(PG8_SB(1, 0), cB + kstep, voffB); PG8_STAGE(PG8_SA(1, 0), cA + kstep, voffA); PG8_STAGE(PG8_SB(1, 1), cB + hstepB + kstep, voffB);
        PG8_WAIT_V(6); PG8_BAR;
    }
    for (;;) {
        const bool has_next = S.next(ui + 1, nxt);
        const char* nA = has_next ? (const char*)g.A + (size_t)nxt.pm * tstepA : cA; const char* nB = has_next ? (const char*)g.Bt + (size_t)nxt.pn * tstepB : cB;
        for (int t = 0; t < nt; t += 2) {
            const bool last = (t == nt - 2);
            const char* a1 = cA + (size_t)(t + 1) * kstep;
            const char* a2 = last ? nA : cA + (size_t)(t + 2) * kstep; const char* b2 = last ? nB : cB + (size_t)(t + 2) * kstep;
            const char* a3 = a2 + kstep; const char* b3 = b2 + kstep;
            if (last && has_next) S.a_ready(nxt);
            if constexpr (SP2) {
            PG8_LDB(B0, 0, 0); PG8_LDB(B1, 0, 1); PG8_SCHED; PG8_LDA(At, 0, 0); PG8_STAGE(PG8_SA(1, 1), a1 + hstepA, voffA);
            PG8_WAIT_V(8); PG8_WAIT_L(0); PG8_BAR; PG8_MMA(0, 0, At, B0); PG8_MMA(0, 1, At, B1); PG8_BAR; PG8_SCHED;
            PG8_LDA(At, 0, 1); PG8_STAGE(PG8_SB(0, 0), b2, voffB); PG8_STAGE(PG8_SB(0, 1), b2 + hstepB, voffB); PG8_STAGE(PG8_SA(0, 0), a2, voffA);
            PG8_WAIT_V(8); PG8_WAIT_L(0); PG8_BAR; PG8_MMA(1, 0, At, B0); PG8_MMA(1, 1, At, B1); PG8_BAR; PG8_SCHED;
            PG8_LDB(B0, 1, 0); PG8_LDB(B1, 1, 1); PG8_SCHED; PG8_LDA(At, 1, 0); PG8_STAGE(PG8_SA(0, 1), a2 + hstepA, voffA);
            PG8_WAIT_V(8); PG8_WAIT_L(0); PG8_BAR; PG8_MMA(0, 0, At, B0); PG8_MMA(0, 1, At, B1); PG8_BAR; PG8_SCHED;
            PG8_LDA(At, 1, 1); PG8_STAGE(PG8_SB(1, 0), b3, voffB); PG8_STAGE(PG8_SB(1, 1), b3 + hstepB, voffB); PG8_STAGE(PG8_SA(1, 0), a3, voffA);
            PG8_WAIT_V(8); PG8_WAIT_L(0); PG8_BAR; PG8_MMA(1, 0, At, B0); PG8_MMA(1, 1, At, B1); PG8_BAR; PG8_SCHED;
            } else {
            PG8_LDB(B0, 0, 0); PG8_SCHED; PG8_LDA(At, 0, 0); PG8_STAGE(PG8_SA(1, 1), a1 + hstepA, voffA);
            PG8_WAIT_L(8); PG8_BAR; PG8_WAIT_L(0); PG8_MMA(0, 0, At, B0); PG8_BAR; PG8_SCHED;
            PG8_LDB(B1, 0, 1); PG8_STAGE(PG8_SB(0, 0), b2, voffB);
            PG8_BAR; PG8_WAIT_L(0); PG8_MMA(0, 1, At, B1); PG8_BAR;
            PG8_LDA(At, 0, 1); PG8_STAGE(PG8_SA(0, 0), a2, voffA);
            PG8_BAR; PG8_WAIT_L(0); PG8_MMA(1, 0, At, B0); PG8_BAR; PG8_SCHED;
            PG8_STAGE(PG8_SB(0, 1), b2 + hstepB, voffB);
            PG8_WAIT_V(6); PG8_BAR; PG8_MMA(1, 1, At, B1); PG8_BAR;
            PG8_LDB(B0, 1, 0); PG8_SCHED; PG8_LDA(At, 1, 0); PG8_STAGE(PG8_SA(0, 1), a2 + hstepA, voffA);
            PG8_WAIT_L(8); PG8_BAR; PG8_WAIT_L(0); PG8_MMA(0, 0, At, B0); PG8_BAR; PG8_SCHED;
            PG8_LDB(B1, 1, 1); PG8_STAGE(PG8_SB(1, 0), b3, voffB);
            PG8_BAR; PG8_WAIT_L(0); PG8_MMA(0, 1, At, B1); PG8_BAR;
            PG8_LDA(At, 1, 1); PG8_STAGE(PG8_SA(1, 0), a3, voffA);
            PG8_BAR; PG8_WAIT_L(0); PG8_MMA(1, 0, At, B0); PG8_BAR; PG8_SCHED;
            PG8_STAGE(PG8_SB(1, 1), b3 + hstepB, voffB);
            PG8_WAIT_V(6); PG8_BAR; PG8_MMA(1, 1, At, B1); PG8_BAR;
            }
        }
        if constexpr (ALIGN_EPI) { if (wr == 0) PG8_BAR; }
        if constexpr (!Epi::AFTER_DRAIN) { E(acc, cur, wr, wc, fr, fq); S.done(cur); }
        if (!has_next) break;
#pragma unroll
        for (int a = 0; a < 2; ++a)
#pragma unroll
            for (int b = 0; b < 2; ++b)
#pragma unroll
                for (int m = 0; m < 4; ++m)
#pragma unroll
                    for (int n = 0; n < 2; ++n) acc[a][b][m][n] = (f32x4){0.f, 0.f, 0.f, 0.f};
        cur = nxt; cA = nA; cB = nB; ++ui;
        if constexpr (ALIGN_EPI) { if (wr == 1) PG8_BAR; }
    }
    PG8_WAIT_V(0);
    if constexpr (!ALIGN_EPI) { if (wr == 0) PG8_BAR; }
    PG8_BAR;
    if constexpr (Epi::AFTER_DRAIN) { E.fused(acc, cur, wr, wc, fr, fq, lds, wid, lane); S.done(cur); }
#undef PG8_SA
#undef PG8_SB
#undef PG8_STAGE
#undef PG8_LDA
#undef PG8_LDB
#undef PG8_MMA
#undef PG8_WAIT_V
#undef PG8_WAIT_L
#undef PG8_BAR
#undef PG8_SCHED
}
}
#define XB_TMO      128
#define XB_XCNT(j)  (256  + 64 * (j))
#define XB_XSUB(j)  (1280 + 64 * (j))
#define XB_XGEN(j)  (2304 + 64 * (j))
#define XB_TOP      3328
#define XB_TOPGEN   3392
#define XCD_BAR_WORDS 3456
#define XB_SPIN_CAP (1u << 18)
#define LAS __attribute__((address_space(3)))

__device__ __forceinline__ unsigned xb_ld(unsigned* p)              { return __hip_atomic_load(p, __ATOMIC_RELAXED, __HIP_MEMORY_SCOPE_AGENT); }
__device__ __forceinline__ unsigned xb_add(unsigned* p, unsigned v) { return __hip_atomic_fetch_add(p, v, __ATOMIC_RELAXED, __HIP_MEMORY_SCOPE_AGENT); }
__device__ __forceinline__ unsigned xb_xcc_id() { return (unsigned)__builtin_amdgcn_s_getreg((3 << 11) | 20) & 0xFu; }
#define XB_SPIN(cond, bar) do { unsigned _sp = 0; while (cond) { __builtin_amdgcn_s_sleep(1); \
    if ((++_sp & 255u) == 0u) { if (xb_ld(&(bar)[XB_TMO])) break; if (_sp > XB_SPIN_CAP) { atomicAdd(&(bar)[XB_TMO], 1u); break; } } } } while (0)

struct XcdBarrier {
    unsigned* bar; unsigned x;
    volatile LAS unsigned* st;
};

__device__ __forceinline__ XcdBarrier xcd_barrier_post(unsigned* bar, volatile LAS unsigned* st) {
    XcdBarrier b; b.bar = bar; b.x = xb_xcc_id(); b.st = st;
    if (threadIdx.x == 0) (void)xb_add(&bar[XB_XCNT(b.x)], 1u);
    return b;
}
__device__ __forceinline__ void xcd_barrier_complete(unsigned* bar, unsigned x, unsigned& nloc, unsigned& nx) {
    const unsigned G = gridDim.x * gridDim.y * gridDim.z;
    unsigned sum, cnt, mine, sp = 0u;
    for (;;) {
        sum = 0u; cnt = 0u; mine = 0u;
#pragma unroll
        for (unsigned j = 0; j < 16; ++j) { const unsigned c = xb_ld(&bar[XB_XCNT(j)]); sum += c; cnt += (c > 0u) ? 1u : 0u; mine = (j == x) ? c : mine; }
        if (sum == G) break;
        __builtin_amdgcn_s_sleep(1);
        if ((++sp & 255u) == 0u) { if (xb_ld(&bar[XB_TMO])) break; if (sp > XB_SPIN_CAP) { atomicAdd(&bar[XB_TMO], 1u); break; } }
    }
    nloc = mine > 0u ? mine : 1u; nx = cnt > 0u ? cnt : 1u;
}

__device__ __forceinline__ void xcd_barrier(const XcdBarrier& b) {
    asm volatile("s_waitcnt vmcnt(0)" ::: "memory");
    __syncthreads();
    if (threadIdx.x == 0) {
        unsigned* bar = b.bar;
        __builtin_amdgcn_s_waitcnt(0);
        unsigned nloc = b.st[0], nx = b.st[1];
        if (nloc == 0u) { xcd_barrier_complete(bar, b.x, nloc, nx); b.st[0] = nloc; b.st[1] = nx; }
        const unsigned old = xb_add(&bar[XB_XSUB(b.x)], 1u);
        const unsigned gen = old / nloc;
        if (old + 1u == (gen + 1u) * nloc) {
            __builtin_amdgcn_fence(__ATOMIC_RELEASE, "agent");
            asm volatile("s_waitcnt vmcnt(0)" ::: "memory");
            const unsigned og = xb_add(&bar[XB_TOP], 1u);
            const unsigned tg = og / nx;
            if (og + 1u == (tg + 1u) * nx) xb_add(&bar[XB_TOPGEN], 1u);
            else XB_SPIN(xb_ld(&bar[XB_TOPGEN]) == tg, bar);
            __builtin_amdgcn_fence(__ATOMIC_ACQUIRE, "agent");
            xb_add(&bar[XB_XGEN(b.x)], 1u);
            asm volatile("s_waitcnt vmcnt(0)" ::: "memory");
        } else {
            XB_SPIN(xb_ld(&bar[XB_XGEN(b.x)]) == gen, bar);
            __builtin_amdgcn_fence(__ATOMIC_ACQUIRE, "agent");
            asm volatile("s_waitcnt vmcnt(0)" ::: "memory");
        }
    }
    __syncthreads();
}


typedef pg8::bf16_t bf16_t;
typedef float vf4 __attribute__((ext_vector_type(4)));
typedef float vf2 __attribute__((ext_vector_type(2)));
typedef unsigned vu4 __attribute__((ext_vector_type(4)));
typedef LAS unsigned char lds_u8;
constexpr int DM = 2048, NTOK = 40960, DFF = 5632, NTHR = 512;
constexpr float EPSN = 1e-6f;
constexpr int LDS_BYTES = 155648;
constexpr int LDS_BAR_OFF = LDS_BYTES - 16;
constexpr size_t MiB = 1024 * 1024;
constexpr int WQ_WORD = 4096;
constexpr size_t WS_BAR = 0, WS_MOD = 65536;
constexpr size_t WS_H = 4 * MiB, WS_HO = 164 * MiB, WS_W = 324 * MiB, WS_ARENA = 448 * MiB, WS_END = 1536 * MiB;
constexpr size_t W_GU = 0, W_DN = 44 * MiB, W_MIN = 66 * MiB, W_MOUT = 107 * MiB;
constexpr int DN_LD = 8448, DN_LD2 = 2304;
constexpr int SSD_LD = 10496, SSD_LD2 = 4352;

struct Args { const float* in[47]; float* out; unsigned char* ws; int ph_lo, ph_hi; };
__device__ __forceinline__ const float* ARG_IN(int i) {
    const __attribute__((address_space(4))) unsigned char* base = (const __attribute__((address_space(4))) unsigned char*)__builtin_amdgcn_kernarg_segment_ptr();
    asm volatile("" : "+s"(base));
    return *(const float* const __attribute__((address_space(4)))*)(base + 8 * i); }

#define LDS_SYNC() do { asm volatile("s_waitcnt lgkmcnt(0)" ::: "memory"); __builtin_amdgcn_s_barrier(); asm volatile("" ::: "memory"); } while (0)
__device__ __forceinline__ int seq_of_row(int row) { return row < 32768 ? (row >> 13) : 4 + ((row - 32768) >> 12); }
__device__ __forceinline__ int seq_start(int s) { return s < 4 ? s * 8192 : 32768 + (s - 4) * 4096; }
__device__ __forceinline__ int seq_len(int s) { return s < 4 ? 8192 : 4096; }
__device__ __forceinline__ float bf2f(bf16_t b) { return __uint_as_float(((unsigned)b) << 16); }
__device__ __forceinline__ void unpack8(const vu4 w, float (&f)[8]) {
    f[0] = __uint_as_float(w.x << 16); f[1] = __uint_as_float(w.x & 0xffff0000u); f[2] = __uint_as_float(w.y << 16); f[3] = __uint_as_float(w.y & 0xffff0000u);
    f[4] = __uint_as_float(w.z << 16); f[5] = __uint_as_float(w.z & 0xffff0000u); f[6] = __uint_as_float(w.w << 16); f[7] = __uint_as_float(w.w & 0xffff0000u); }
__device__ __forceinline__ vu4 pack8(const float (&f)[8]) { vu4 w; w.x = pg8::cvt_pk_bf16(f[0], f[1]); w.y = pg8::cvt_pk_bf16(f[2], f[3]); w.z = pg8::cvt_pk_bf16(f[4], f[5]); w.w = pg8::cvt_pk_bf16(f[6], f[7]); return w; }

__device__ __forceinline__ float wave_scan_incl(float v) {
#define DPP_ADD(ctrl, rmask) v += __builtin_bit_cast(float, __builtin_amdgcn_update_dpp(0, __builtin_bit_cast(int, v), ctrl, rmask, 0xf, false))
    DPP_ADD(0x111, 0xf); DPP_ADD(0x112, 0xf); DPP_ADD(0x114, 0xf); DPP_ADD(0x118, 0xf); DPP_ADD(0x142, 0xa); DPP_ADD(0x143, 0xc);
#undef DPP_ADD
    return v; }
__device__ __forceinline__ float lane63(float v) { return __builtin_bit_cast(float, __builtin_amdgcn_readlane(__builtin_bit_cast(int, v), 63)); }
__device__ __forceinline__ float wave_sum(float v) { return lane63(wave_scan_incl(v)); }
__device__ __forceinline__ float softplus_fast(float x) { return x > 20.f ? x : __logf(1.0f + __expf(x)); }
__device__ __forceinline__ float silu_f(float x) { return x * __builtin_amdgcn_rcpf(1.0f + __expf(-x)); }
__device__ __forceinline__ float softplus_f(float x) { return x > 20.f ? x : log1pf(__expf(x)); }
__device__ __forceinline__ void load8f(const float* p, float (&f)[8]) { const vf4 a = *(const vf4*)p, b = *(const vf4*)(p + 4); f[0] = a.x; f[1] = a.y; f[2] = a.z; f[3] = a.w; f[4] = b.x; f[5] = b.y; f[6] = b.z; f[7] = b.w; }
__device__ __forceinline__ void store8f(float* p, const float (&f)[8]) { *(vf4*)p = (vf4){f[0], f[1], f[2], f[3]}; *(vf4*)(p + 4) = (vf4){f[4], f[5], f[6], f[7]}; }

__device__ __forceinline__ void ph_ada(const Args& a, lds_u8* lds, int u_lo, int u_hi, int rank, int nrank) {
    LAS float* cact = (LAS float*)lds;
    LAS float* red = cact + 6 * 2048;
    const int tid = threadIdx.x, lane = tid & 63, wave = __builtin_amdgcn_readfirstlane(tid >> 6);
    float* mod = (float*)(a.ws + WS_MOD);
    for (int i = tid; i < 6 * 2048; i += NTHR) { const int b = i >> 11, k = i & 2047; const float c = b < 4 ? ARG_IN(2)[b * 2048 + k] : ARG_IN(3)[(b - 4) * 2048 + k]; cact[i] = c / (1.0f + expf(-c)); }
    LDS_SYNC();
    for (int u = u_lo + rank; u < u_hi; u += nrank) {
        const int layer = u / 192, col0 = (u % 192) * 64;
        const float* W = ARG_IN(4) + (size_t)layer * 2048 * 12288 + col0 + lane;
        float acc[6] = {0.f, 0.f, 0.f, 0.f, 0.f, 0.f};
        const int k0 = wave * 256;
#pragma unroll 1
        for (int k = k0; k < k0 + 256; k += 16) {
            float w[16];
#pragma unroll
            for (int j = 0; j < 16; ++j) w[j] = W[(size_t)(k + j) * 12288];
#pragma unroll
            for (int j4 = 0; j4 < 4; ++j4)
#pragma unroll
                for (int b = 0; b < 6; ++b) { const vf4 c4 = *(const LAS vf4*)(cact + b * 2048 + k + 4 * j4); acc[b] += w[4 * j4] * c4.x + w[4 * j4 + 1] * c4.y + w[4 * j4 + 2] * c4.z + w[4 * j4 + 3] * c4.w; }
        }
#pragma unroll
        for (int b = 0; b < 6; ++b) red[(wave * 6 + b) * 64 + lane] = acc[b];
        LDS_SYNC();
        if (tid < 384) { const int b = tid >> 6; float s = 0.f;
#pragma unroll
            for (int w = 0; w < 8; ++w) s += red[(w * 6 + b) * 64 + lane];
            s += ARG_IN(5)[layer * 12288 + col0 + lane];
            { const int kidx = col0 >> 11, c = (col0 & 2047) + lane; const float* ng = ARG_IN(6) + (size_t)layer * 4 * 2048;
                if (kidx == 1) s = ng[0 * 2048 + c] * (1.0f + s); else if (kidx == 4) s = ng[2 * 2048 + c] * (1.0f + s); else if (kidx == 2) s *= ng[1 * 2048 + c]; else if (kidx == 5) s *= ng[3 * 2048 + c]; }
            mod[(size_t)(layer * 6 + b) * 12288 + col0 + lane] = s; }
        LDS_SYNC();
    }
}

__device__ __forceinline__ void cvt_wT(const float* W, int K, int N, bf16_t* Bt, int mode, lds_u8* lds, int rank = -1, int nrank = 0, const float* rowscale = nullptr) {
    LAS float* tile = (LAS float*)lds;
    const int tid = threadIdx.x;
    const int nkt = K >> 8, nnt = N >> 6;
    if (rank < 0) { rank = (int)blockIdx.x; nrank = (int)gridDim.x; }
    const unsigned voff = (unsigned)(tid >> 6) * (unsigned)N + (unsigned)(tid & 63);
    LAS float* tw = tile + (tid >> 6) * 65 + (tid & 63);
    float v32[32];
    if (rank < nkt * nnt) { const int kt = rank % nkt, nt = rank / nkt, k0 = kt * 256, n0 = nt * 64;
#pragma unroll
        for (int i = 0; i < 32; ++i) { const float* rowp = W + (size_t)(k0 + 8 * i) * N + n0; v32[i] = rowp[voff]; if (rowscale) v32[i] *= rowscale[k0 + 8 * i + (tid >> 6)]; } }
    for (int u = rank; u < nkt * nnt; u += nrank) {
        const int kt = u % nkt, nt = u / nkt, k0 = kt * 256, n0 = nt * 64;
#pragma unroll
        for (int i = 0; i < 32; ++i) tw[i * 8 * 65] = v32[i];
        LDS_SYNC();
        if (u + nrank < nkt * nnt) { const int u2 = u + nrank, kt2 = u2 % nkt, nt2 = u2 / nkt, k2 = kt2 * 256, n2 = nt2 * 64;
#pragma unroll
            for (int i = 0; i < 32; ++i) { const float* rowp = W + (size_t)(k2 + 8 * i) * N + n2; v32[i] = rowp[voff]; if (rowscale) v32[i] *= rowscale[k2 + 8 * i + (tid >> 6)]; } }
        { const int n = tid >> 3, kk = (tid & 7) * 8; const int nn = n0 + n; const int drow = mode == 0 ? nn : ((nn >> 7) * 256 + (nn & 127) + (mode == 2 ? 128 : 0));
#pragma unroll
            for (int q = 0; q < 4; ++q) { float v[8];
#pragma unroll
                for (int j = 0; j < 8; ++j) v[j] = tile[(q * 64 + kk + j) * 65 + n];
                *(vu4*)(Bt + (size_t)drow * K + k0 + q * 64 + kk) = pack8(v); } }
        LDS_SYNC();
    }
}
__device__ __forceinline__ void cvt_ffn(const Args& a, int layer, lds_u8* lds, int rank = -1, int nrank = 0, unsigned char* dst = nullptr) {
    bf16_t* wgu = (bf16_t*)(dst ? dst : a.ws + WS_W + W_GU); bf16_t* wdn = (bf16_t*)(dst ? dst + 44 * MiB : a.ws + WS_W + W_DN);
    cvt_wT(ARG_IN(7) + (size_t)layer * DM * DFF, DM, DFF, wgu, 1, lds, rank, nrank);
    cvt_wT(ARG_IN(8) + (size_t)layer * DM * DFF, DM, DFF, wgu, 2, lds, rank, nrank);
    cvt_wT(ARG_IN(9) + (size_t)layer * DFF * DM, DFF, DM, wdn, 0, lds, rank, nrank);
}
__device__ __forceinline__ void cvt_ffn_part(const Args& a, int layer, lds_u8* lds, int rank, int nrank, unsigned char* dst, bool down) {
    bf16_t* wgu = (bf16_t*)(dst ? dst : a.ws + WS_W + W_GU); bf16_t* wdn = (bf16_t*)(dst ? dst + 44 * MiB : a.ws + WS_W + W_DN);
    if (!down) { cvt_wT(ARG_IN(7) + (size_t)layer * DM * DFF, DM, DFF, wgu, 1, lds, rank, nrank); cvt_wT(ARG_IN(8) + (size_t)layer * DM * DFF, DM, DFF, wgu, 2, lds, rank, nrank); }
    else cvt_wT(ARG_IN(9) + (size_t)layer * DFF * DM, DFF, DM, wdn, 0, lds, rank, nrank);
}

template <bool XSRC_BF, bool XDST_BF>
__device__ __forceinline__ void ph_row(const float* __restrict__ x0, const float* __restrict__ x1, float* x_dst, const bf16_t* ho, const float* g_post, const float* mgate,
                                       const float* g_pre, const float* mpre, bf16_t* h, bf16_t* ug = nullptr) {
    const int tid = threadIdx.x, lane = tid & 63, wave = __builtin_amdgcn_readfirstlane(tid >> 6);
    const int G = gridDim.x, niter = (NTOK / 8 + G - 1) / G;
#define ROW_OF(it_) (ug ? ((blockIdx.x + G * ((it_) >> 2)) >= 1280 ? -1 : (int)(blockIdx.x + G * ((it_) >> 2)) * 32 + wave * 4 + ((it_) & 3)) : ((blockIdx.x + G * (it_)) >= NTOK / 8 ? -1 : (int)(blockIdx.x + G * (it_)) * 8 + wave))
    vu4 nxb[4], nho[4]; float nxf[4][8];
#define ROW_LOAD(r_) { const float* xr_ = (r_) < 32768 ? x0 + (size_t)(r_) * DM : x1 + (size_t)((r_) - 32768) * DM; \
        _Pragma("unroll") for (int j = 0; j < 4; ++j) { if (XSRC_BF) nxb[j] = *(const vu4*)((const bf16_t*)x0 + (size_t)(r_) * DM + 8 * lane + 512 * j); else load8f(xr_ + 8 * lane + 512 * j, nxf[j]); \
            if (ho) nho[j] = *(const vu4*)(ho + (size_t)(r_) * DM + 8 * lane + 512 * j); } }
    int rown = ROW_OF(0);
    if (rown >= 0) ROW_LOAD(rown)
    for (int it = 0; it < niter; ++it) {
        const int row = rown; if (row < 0) break;
        const int b = seq_of_row(row);
        float xv[4][8]; vu4 hraw[4];
#pragma unroll
        for (int j = 0; j < 4; ++j) { if (XSRC_BF) unpack8(nxb[j], xv[j]); else {
#pragma unroll
                for (int e = 0; e < 8; ++e) xv[j][e] = nxf[j][e]; }
            hraw[j] = nho[j]; }
        rown = it + 1 < niter ? ROW_OF(it + 1) : -1;
        if (rown >= 0) ROW_LOAD(rown)
        if (ho) {
            float hv[4][8]; float ss = 0.f;
#pragma unroll
            for (int j = 0; j < 4; ++j) { unpack8(hraw[j], hv[j]);
#pragma unroll
                for (int e = 0; e < 8; ++e) ss += hv[j][e] * hv[j][e]; }
            ss = wave_sum(ss);
            const float r1 = rsqrtf(ss * (1.0f / DM) + EPSN);
#pragma unroll
            for (int j = 0; j < 4; ++j) { float gt[8]; load8f(mgate + (size_t)b * 12288 + 8 * lane + 512 * j, gt);
#pragma unroll
                for (int e = 0; e < 8; ++e) xv[j][e] += gt[e] * (hv[j][e] * r1); }
        }
        if (x_dst) {
#pragma unroll
            for (int j = 0; j < 4; ++j) { if (XDST_BF) *(vu4*)((bf16_t*)x_dst + (size_t)row * DM + 8 * lane + 512 * j) = pack8(xv[j]); else store8f(x_dst + (size_t)row * DM + 8 * lane + 512 * j, xv[j]); }
        }
        if (h || ug) {
            float ss = 0.f;
#pragma unroll
            for (int j = 0; j < 4; ++j)
#pragma unroll
                for (int e = 0; e < 8; ++e) ss += xv[j][e] * xv[j][e];
            ss = wave_sum(ss);
            const float r2 = rsqrtf(ss * (1.0f / DM) + EPSN);
#pragma unroll
            for (int j = 0; j < 4; ++j) { float sh[8], sc[8], o[8]; load8f(mpre + (size_t)b * 12288 + 8 * lane + 512 * j, sh); load8f(mpre + (size_t)b * 12288 + 2048 + 8 * lane + 512 * j, sc);
#pragma unroll
                for (int e = 0; e < 8; ++e) o[e] = xv[j][e] * r2 * sc[e] + sh[e];
                if (ug) { const int col = 8 * lane + 512 * j; *(vu4*)(ug + ((size_t)((col >> 4) * 1280 + (row >> 5))) * 768 + (row & 31) * 16 + (col & 8)) = pack8(o); }
                else *(vu4*)(h + (size_t)row * DM + 8 * lane + 512 * j) = pack8(o); }
        }
    }
}

__device__ __forceinline__ void ph_dn_combine(const Args& a, const bf16_t* of, const bf16_t* ob, const bf16_t* proj, bf16_t* O) {
    const int tid = threadIdx.x, lane = tid & 63, wave = __builtin_amdgcn_readfirstlane(tid >> 6);
    const float* gn = ARG_IN(14);
    for (int row = blockIdx.x * 8 + wave; row < NTOK; row += gridDim.x * 8) {
#pragma unroll
        for (int j = 0; j < 4; ++j) { const int col = 8 * lane + 512 * j;
            float x[8], y[8], z[8], g8[8], o[8];
            unpack8(*(const vu4*)(of + (size_t)row * DM + col), x); unpack8(*(const vu4*)(ob + (size_t)row * DM + col), y);
            unpack8(*(const vu4*)(proj + (size_t)row * DN_LD2 + col), z); load8f(gn + (col & 127), g8);
            float ss = 0.f;
#pragma unroll
            for (int e = 0; e < 8; ++e) { x[e] += y[e]; ss += x[e] * x[e]; }
            ss += __shfl_xor(ss, 1); ss += __shfl_xor(ss, 2); ss += __shfl_xor(ss, 4); ss += __shfl_xor(ss, 8);
            const float r = rsqrtf(ss * (1.0f / 128.0f) + EPSN);
#pragma unroll
            for (int e = 0; e < 8; ++e) o[e] = x[e] * r * g8[e] * silu_f(z[e]);
            *(vu4*)(O + (size_t)row * DM + col) = pack8(o); }
    }
}
__device__ __forceinline__ void ph_ssd_combine(const Args& a, bf16_t* Y, const bf16_t* proj, const bf16_t* Yfs) {
    const int tid = threadIdx.x, lane = tid & 63, wave = __builtin_amdgcn_readfirstlane(tid >> 6);
    const float* gn = ARG_IN(31);
    for (int row = blockIdx.x * 8 + wave; row < NTOK; row += gridDim.x * 8) {
#pragma unroll
        for (int j = 0; j < 8; ++j) { const int col = 8 * lane + 512 * j;
            float y[8], z[8], o[8];
            unpack8(*(const vu4*)(Y + (size_t)row * 4096 + col), y); unpack8(*(const vu4*)(proj + (size_t)row * SSD_LD2 + col), z);
            if (row >= 32768) { float yf[8]; unpack8(*(const vu4*)(Yfs + (size_t)(row - 32768) * 4096 + col), yf);
#pragma unroll
                for (int e = 0; e < 8; ++e) y[e] += yf[e]; }
            float ss = 0.f;
#pragma unroll
            for (int e = 0; e < 8; ++e) { y[e] *= silu_f(z[e]); ss += y[e] * y[e]; }
            ss = wave_sum(ss);
            const float r = rsqrtf(ss * (1.0f / 512.0f) + EPSN);
#pragma unroll
            for (int e = 0; e < 8; ++e) o[e] = y[e] * r;
            *(vu4*)(Y + (size_t)row * 4096 + col) = pack8(o); }
    }
}

constexpr int S5_NCH = 1280, S5_LDA = 768;
struct BatchOrder {
    int nMg, nNg, per, total, G, c;
    __device__ void init(int nMg_, int nNg_, int G_, int c_) { nMg = nMg_; nNg = nNg_; per = nMg_ * nNg_; total = 128 * per; G = G_; c = c_; }
    __device__ bool next(int i, pg8::Unit& u) const { const long L0 = (long)i * G + c; if (L0 >= total) return false;
        const int L = (int)(L0 % 8) * (total / 8) + (int)(L0 / 8);
        const int g = L / per, r = L % per;
        u.pm = g * nMg + r % nMg; u.pn = g * nNg + r / nMg; return true; }
    __device__ __forceinline__ void a_ready(const pg8::Unit&) const {}
    __device__ __forceinline__ void done(const pg8::Unit&) const {}
};
struct EpiS5E {
    static constexpr bool PERM = false, AFTER_DRAIN = false;
    float* E;
    __device__ __forceinline__ void operator()(const pg8::f32x4 (&acc)[2][2][4][2], const pg8::Unit& u, int wr, int wc, int fr, int fq) const {
        const int row0 = u.pm * 256 + wr * 64 + fr, col0 = wc * 32 + 4 * fq;
#pragma unroll
        for (int ai = 0; ai < 2; ++ai)
#pragma unroll
            for (int m = 0; m < 4; ++m) { float* rowp = E + (size_t)(row0 + ai * 128 + m * 16) * 256 + col0;
#pragma unroll
                for (int bj = 0; bj < 2; ++bj)
#pragma unroll
                    for (int n = 0; n < 2; ++n) *(pg8::f32x4*)(rowp + bj * 128 + n * 16) = acc[ai][bj][m][n]; }
    }
};
__device__ __forceinline__ float gelu_tanh_f(float y) { const float z = 1.5957691216057308f * (y + 0.044715f * y * y * y); return y * __builtin_amdgcn_rcpf(1.0f + __expf(-z)); }
struct EpiS5Y {
    static constexpr bool PERM = true, AFTER_DRAIN = false;
    bf16_t* Y;
    __device__ __forceinline__ void operator()(const pg8::f32x4 (&acc)[2][2][4][2], const pg8::Unit& u, int wr, int wc, int fr, int fq) const {
        const int g = u.pm / 5, chunk0 = (u.pm % 5) * 256 + wr * 64 + fr, n0 = (u.pn & 1) * 256 + wc * 32 + 8 * fq;
#pragma unroll
        for (int ai = 0; ai < 2; ++ai)
#pragma unroll
            for (int m = 0; m < 4; ++m) { const int chunk = chunk0 + ai * 128 + m * 16;
#pragma unroll
                for (int bj = 0; bj < 2; ++bj) { const int n = n0 + bj * 128, t = n >> 4, c0 = n & 15;
                    const pg8::f32x4 v0 = acc[ai][bj][m][0], v1 = acc[ai][bj][m][1];
                    pg8::u32x4 w; w.x = pg8::cvt_pk_bf16(gelu_tanh_f(v0[0]), gelu_tanh_f(v0[1])); w.y = pg8::cvt_pk_bf16(gelu_tanh_f(v0[2]), gelu_tanh_f(v0[3]));
                    w.z = pg8::cvt_pk_bf16(gelu_tanh_f(v1[0]), gelu_tanh_f(v1[1])); w.w = pg8::cvt_pk_bf16(gelu_tanh_f(v1[2]), gelu_tanh_f(v1[3]));
                    *(pg8::u32x4*)(Y + (size_t)(chunk * 32 + t) * DM + g * 16 + c0) = w; } }
    }
};
__device__ __forceinline__ void ph_s5_tables(const Args& a, lds_u8* lds, bf16_t* BtY, bf16_t* BtE, float* LT, int rank, int nrank) {
    LAS float* bb = (LAS float*)lds;
    LAS float* cc = bb + 4096;
    LAS float* pw = cc + 4096;
    LAS float* kc = pw + 8448;
    const int tid = threadIdx.x;
    const float* lam_re = ARG_IN(16); const float* lam_im = ARG_IN(17); const float* log_step = ARG_IN(18);
    const float* b_re = ARG_IN(19); const float* b_im = ARG_IN(20); const float* c_re = ARG_IN(21); const float* c_im = ARG_IN(22); const float* dvec = ARG_IN(23);
    for (int g = rank; g < 128; g += nrank) {
        if (tid < 128) { const int dir = tid >> 6, p = tid & 63;
            const float step = expf(log_step[dir * 128 + g]);
            const float lr = fminf(lam_re[(dir * 128 + g) * 64 + p], -1e-4f), li = lam_im[(dir * 128 + g) * 64 + p];
#pragma unroll 1
            for (int n = 0; n <= 32; ++n) { const float mag = expf(lr * step * (float)n); float sn, cs; sincosf(li * step * (float)n, &sn, &cs);
                pw[((dir * 64 + p) * 33 + n) * 2] = mag * cs; pw[((dir * 64 + p) * 33 + n) * 2 + 1] = mag * sn; }
            const float ar = pw[((dir * 64 + p) * 33 + 1) * 2], ai = pw[((dir * 64 + p) * 33 + 1) * 2 + 1];
            const float den = lr * lr + li * li, nr = ar - 1.0f, cr = (nr * lr + ai * li) / den, ci = (ai * lr - nr * li) / den;
#pragma unroll 4
            for (int c = 0; c < 16; ++c) { const float br = b_re[(g * 64 + p) * 16 + c], bi = b_im[(g * 64 + p) * 16 + c];
                bb[((dir * 64 + p) * 16 + c) * 2] = cr * br - ci * bi; bb[((dir * 64 + p) * 16 + c) * 2 + 1] = cr * bi + ci * br; }
            LT[((g * 2 + dir) * 64 + p) * 2] = pw[((dir * 64 + p) * 33 + 32) * 2]; LT[((g * 2 + dir) * 64 + p) * 2 + 1] = pw[((dir * 64 + p) * 33 + 32) * 2 + 1];
        }
        for (int i = tid; i < 2048; i += NTHR) { const int dir = i >> 10, c = (i >> 6) & 15, p = i & 63;
            cc[i * 2] = c_re[((size_t)(dir * 128 + g) * 16 + c) * 64 + p]; cc[i * 2 + 1] = c_im[((size_t)(dir * 128 + g) * 16 + c) * 64 + p]; }
        LDS_SYNC();
#pragma unroll 1
        for (int idx = tid; idx < 63 * 256; idx += NTHR) { const int dd = (idx >> 8) - 31, c = (idx >> 4) & 15, c2 = idx & 15;
            float s = 0.f;
            if (dd >= 0) {
#pragma unroll 4
                for (int p = 0; p < 64; ++p) { const vf2 cv = *(const LAS vf2*)(cc + ((0 * 16 + c) * 64 + p) * 2), pv = *(const LAS vf2*)(pw + ((0 * 64 + p) * 33 + dd) * 2), bv = *(const LAS vf2*)(bb + ((0 * 64 + p) * 16 + c2) * 2);
                    const float tr = cv.x * pv.x - cv.y * pv.y, ti = cv.x * pv.y + cv.y * pv.x; s += tr * bv.x - ti * bv.y; } }
            if (dd <= 0) {
#pragma unroll 4
                for (int p = 0; p < 64; ++p) { const vf2 cv = *(const LAS vf2*)(cc + ((1 * 16 + c) * 64 + p) * 2), pv = *(const LAS vf2*)(pw + ((1 * 64 + p) * 33 - dd) * 2), bv = *(const LAS vf2*)(bb + ((1 * 64 + p) * 16 + c2) * 2);
                    const float tr = cv.x * pv.x - cv.y * pv.y, ti = cv.x * pv.y + cv.y * pv.x; s += tr * bv.x - ti * bv.y; } }
            if (dd == 0 && c == c2) s += dvec[g * 16 + c];
            kc[idx] = s; }
        LDS_SYNC();
#pragma unroll 1
        for (int idx = tid; idx < 512 * 64; idx += NTHR) { const int n = idx >> 6, piece = idx & 63, t = n >> 4, c = n & 15, s = piece >> 1, half = piece & 1;
            const LAS float* src = kc + ((t - s + 31) * 16 + c) * 16 + half * 8; float v[8];
            const vf4 a0 = *(const LAS vf4*)src, a1 = *(const LAS vf4*)(src + 4); v[0] = a0.x; v[1] = a0.y; v[2] = a0.z; v[3] = a0.w; v[4] = a1.x; v[5] = a1.y; v[6] = a1.z; v[7] = a1.w;
            *(vu4*)(BtY + ((size_t)(g * 512 + n)) * 768 + s * 16 + half * 8) = pack8(v); }
#pragma unroll 1
        for (int idx = tid; idx < 512 * 32; idx += NTHR) { const int n = idx >> 5, pc = idx & 31, which = pc >> 3, p0 = (pc & 7) * 8, t = n >> 4, c = n & 15, dir = which >> 1, nn = dir ? 32 - t : t + 1;
            float v[8];
#pragma unroll
            for (int j = 0; j < 8; ++j) { const int p = p0 + j; const vf2 cv = *(const LAS vf2*)(cc + ((dir * 16 + c) * 64 + p) * 2), pv = *(const LAS vf2*)(pw + ((dir * 64 + p) * 33 + nn) * 2);
                v[j] = (which & 1) ? -(cv.x * pv.y + cv.y * pv.x) : (cv.x * pv.x - cv.y * pv.y); }
            *(vu4*)(BtY + ((size_t)(g * 512 + n)) * 768 + 512 + which * 64 + p0) = pack8(v); }
#pragma unroll 1
        for (int idx = tid; idx < 256 * 64; idx += NTHR) { const int n2 = idx >> 6, piece = idx & 63, dir = n2 >> 7, reim = (n2 >> 6) & 1, p = n2 & 63, s = piece >> 1, half = piece & 1, nn = dir ? s : 31 - s;
            const vf2 pv = *(const LAS vf2*)(pw + ((dir * 64 + p) * 33 + nn) * 2); float v[8];
#pragma unroll
            for (int j = 0; j < 8; ++j) { const vf2 bv = *(const LAS vf2*)(bb + ((dir * 64 + p) * 16 + half * 8 + j) * 2); v[j] = reim ? (pv.x * bv.y + pv.y * bv.x) : (pv.x * bv.x - pv.y * bv.y); }
            *(vu4*)(BtE + ((size_t)(g * 256 + n2)) * 512 + s * 16 + half * 8) = pack8(v); }
        LDS_SYNC();
    }
}
__device__ __forceinline__ void ph_s5_scan(const float* E, const float* LT, bf16_t* UG) {
    for (int id = blockIdx.x * NTHR + threadIdx.x; id < 128 * 6 * 2 * 64; id += gridDim.x * NTHR) {
        const int p = id & 63, dir = (id >> 6) & 1, rest = id >> 7, s = rest % 6, g = rest / 6;
        const int c0 = seq_start(s) >> 5, nc = seq_len(s) >> 5;
        const float lr = LT[((g * 2 + dir) * 64 + p) * 2], li = LT[((g * 2 + dir) * 64 + p) * 2 + 1];
        float xr = 0.f, xi = 0.f;
#pragma unroll 8
        for (int m = 0; m < nc; ++m) { const int chunk = dir ? c0 + nc - 1 - m : c0 + m; const size_t row = (size_t)g * S5_NCH + chunk;
            UG[row * S5_LDA + 512 + dir * 128 + p] = (bf16_t)(pg8::cvt_pk_bf16(xr, xr) & 0xffffu); UG[row * S5_LDA + 512 + dir * 128 + 64 + p] = (bf16_t)(pg8::cvt_pk_bf16(xi, xi) & 0xffffu);
            const float er = E[row * 256 + dir * 128 + p], ei = E[row * 256 + dir * 128 + 64 + p];
            const float nxr = lr * xr - li * xi + er, nxi = lr * xi + li * xr + ei; xr = nxr; xi = nxi; }
    }
}
template <class Epi>
__device__ __forceinline__ void run_gemm_s5(lds_u8* lds, const bf16_t* A, const bf16_t* Bt, int nNg, int K, int ldb, const Epi& E) {
    pg8::Gemm g{A, Bt, 128 * S5_NCH, 128 * nNg * 256, K, S5_LDA, ldb}; BatchOrder S; S.init(5, nNg, (int)gridDim.x, (int)blockIdx.x);
    pg8::gemm_phase<Epi, BatchOrder, true, true>(lds, g, S, E);
}

__device__ __forceinline__ void ph_conv_inplace(lds_u8* lds, bf16_t* XT, const float* convw, const bf16_t* halo, int norm_mode) {
    LAS bf16_t* raw = (LAS bf16_t*)lds;
    const int tid = threadIdx.x, g8 = tid & 15;
    vu4 pb0, pb1, ph = (vu4){0u, 0u, 0u, 0u};
#define CONV_FETCH(uu) do { const int tt_ = (uu) / 48, cb_ = (uu) % 48; const size_t bs_ = (((size_t)tt_ * 768 + cb_ * 16 + g8) * 64 + (tid >> 4)) * 8; \
        pb0 = *(const vu4*)(XT + bs_); pb1 = *(const vu4*)(XT + bs_ + 32 * 8); \
        if (tid < 64) { const int hr_ = tid >> 4, rt0_ = tt_ * 64, s_ = seq_of_row(rt0_), t0_ = rt0_ - seq_start(s_); ph = (vu4){0u, 0u, 0u, 0u}; \
            if (hr_ < 2) { if (t0_ > 0) ph = *(const vu4*)(halo + ((size_t)(tt_ - 1) * 4 + 2 + hr_) * 6144 + cb_ * 128 + g8 * 8); } \
            else { if (t0_ + 64 < seq_len(s_)) ph = *(const vu4*)(halo + ((size_t)(tt_ + 1) * 4 + (hr_ - 2)) * 6144 + cb_ * 128 + g8 * 8); } } } while (0)
    if ((int)blockIdx.x < 640 * 48) CONV_FETCH((int)blockIdx.x);
    for (int u = blockIdx.x; u < 640 * 48; u += gridDim.x) {
        const int tt = u / 48, cb = u % 48, cc0 = cb * 128;
        *(LAS vu4*)(raw + ((tid >> 4) + 2) * 128 + g8 * 8) = pb0; *(LAS vu4*)(raw + ((tid >> 4) + 34) * 128 + g8 * 8) = pb1;
        if (tid < 64) { const int hr = tid >> 4; *(LAS vu4*)(raw + (hr < 2 ? hr : 64 + hr) * 128 + g8 * 8) = ph; }
        if (u + (int)gridDim.x < 640 * 48) CONV_FETCH(u + (int)gridDim.x);
        float cw[5][8];
#pragma unroll
        for (int tap = 0; tap < 5; ++tap) load8f(convw + tap * 6144 + cc0 + g8 * 8, cw[tap]);
        LDS_SYNC();
        vu4 outv[2];
#pragma unroll
        for (int i = 0; i < 2; ++i) { const int r = (tid >> 4) + 32 * i; float acc[8];
#pragma unroll
            for (int j = 0; j < 8; ++j) acc[j] = 0.f;
#pragma unroll
            for (int tap = 0; tap < 5; ++tap) { float xv[8]; unpack8(*(const LAS vu4*)(raw + (r + tap) * 128 + g8 * 8), xv);
#pragma unroll
                for (int j = 0; j < 8; ++j) acc[j] += cw[tap][j] * xv[j]; }
            float ss = 0.f;
#pragma unroll
            for (int j = 0; j < 8; ++j) { acc[j] = silu_f(acc[j]); ss += acc[j] * acc[j]; }
            if (norm_mode == 1 && cb < 32) { ss += __shfl_xor(ss, 1); ss += __shfl_xor(ss, 2); ss += __shfl_xor(ss, 4); ss += __shfl_xor(ss, 8);
                const float sc = rsqrtf(ss + EPSN) * (cb < 16 ? 0.08838834764831845f : 1.0f);
#pragma unroll
                for (int j = 0; j < 8; ++j) acc[j] *= sc; }
            outv[i] = pack8(acc); }
        { const size_t bs = (((size_t)tt * 768 + cb * 16 + g8) * 64 + (tid >> 4)) * 8; *(vu4*)(XT + bs) = outv[0]; *(vu4*)(XT + bs + 32 * 8) = outv[1]; }
        LDS_SYNC();
    }
#undef CONV_FETCH
}

typedef short bf16x8_t __attribute__((ext_vector_type(8)));
typedef unsigned vu2 __attribute__((ext_vector_type(2)));
__device__ __forceinline__ bf16x8_t ldfrag(const LAS bf16_t* base, int ld, int row0, int k0, int lane) { return *(const LAS bf16x8_t*)(base + (row0 + (lane & 15)) * ld + k0 + 8 * (lane >> 4)); }
__device__ __forceinline__ void stfragT(LAS bf16_t* base, int ld, int n0, int m0, int lane, const pg8::f32x4 v) {
    vu2 w; w.x = pg8::cvt_pk_bf16(v[0], v[1]); w.y = pg8::cvt_pk_bf16(v[2], v[3]); *(LAS vu2*)(base + (n0 + (lane & 15)) * ld + m0 + 4 * (lane >> 4)) = w; }
typedef short s16x4_t __attribute__((ext_vector_type(4)));
__device__ __forceinline__ bf16x8_t trfragp(const LAS bf16_t* T, int ld, int c, int ks, int lane) {
    const int g = lane >> 4, q = (lane & 15) >> 2, p = lane & 3;
    const LAS bf16_t* a0 = T + (32 * ks + 8 * g + 2 * q) * ld + 16 * c + 4 * p;
    const s16x4_t lo = __builtin_amdgcn_ds_read_tr16_b64_v4i16((LAS s16x4_t*)a0), hi = __builtin_amdgcn_ds_read_tr16_b64_v4i16((LAS s16x4_t*)(a0 + ld));
    return (bf16x8_t){lo[0], lo[1], lo[2], lo[3], hi[0], hi[1], hi[2], hi[3]}; }
#define MFMA16(a, b, c) __builtin_amdgcn_mfma_f32_16x16x32_bf16(a, b, c, 0, 0, 0)

template <int VAR> __device__ __forceinline__ void ph_ssd_core3(const Args& a, lds_u8* lds, const bf16_t* GT, const bf16_t* XT, bf16_t* Y, bf16_t* Yfs) {
    constexpr int LDN = 136, LDJ = 72, NB = 64 * LDN, JB = 64 * LDJ, CSB = 196;
    LAS bf16_t* Cb2 = (LAS bf16_t*)lds;
    LAS bf16_t* Bb2 = Cb2 + 2 * NB;
    LAS bf16_t* xs2 = Bb2 + 2 * NB;
    LAS bf16_t* xw2 = xs2 + 2 * JB;
    LAS bf16_t* MmT = xw2 + 2 * JB;
    LAS bf16_t* Sb = MmT + JB;
    LAS bf16_t* Ys = Sb + NB;
    LAS float* cs2 = (LAS float*)(Ys + JB);
    const int tid = threadIdx.x, lane = tid & 63, wave = __builtin_amdgcn_readfirstlane(tid >> 6), lr = lane & 15, lq = lane >> 4;
    const bool prod = wave < 4; const int pw = wave & 3;
    const float* a_log = ARG_IN(28); const float* dtb = ARG_IN(29); const float* Dp = ARG_IN(30);
    for (int i = tid; i < JB / 2; i += NTHR) ((LAS unsigned*)MmT)[i] = 0u;
    for (int u = blockIdx.x; u < 512; u += gridDim.x) {
        int s, hd, dlo, dhi;
        if (u < 256) { s = u >> 6; const int r = u & 63; hd = (r & 7) * 8 + (r >> 3); dlo = 0; dhi = 2; } else { const int v = u - 256, r = v & 127, rest = r >> 3; s = 4 + (v >> 7); hd = (r & 7) * 8 + (rest & 7); dlo = rest >> 3; dhi = dlo + 1; }
        const bool split = u >= 256;
        const int grp = hd >> 3, L = seq_len(s), row0 = seq_start(s), nT = L >> 6;
#pragma unroll 1
        for (int d = dlo; d < dhi; ++d) {
            if (prod) {
                const float Aneg = -expf(a_log[d * 64 + hd]), dtbias = dtb[d * 64 + hd];
                const float Dd = d == 0 ? Dp[hd] : 0.f;
                vu4 pre[10]; bf16_t pdt;
                { const int tile = d ? nT - 1 : 0; const size_t gt = (size_t)((row0 >> 6) + tile) * 768; const int tk = d ? 63 - lane : lane; const unsigned tko = (unsigned)tk * 8u;
#pragma unroll
                    for (int k = 0; k < 10; ++k) { const int gg = pw + 4 * k; const int cg = k < 2 ? hd * 8 + gg : (k < 6 ? 512 + grp * 16 + (gg - 8) : 640 + grp * 16 + (gg - 24)); const bf16_t* pp = XT + (gt + cg) * 512; pre[k] = *(const vu4*)(pp + tko); }
                    pdt = GT[((size_t)((row0 >> 6) + tile) * 128 + d * 64 + hd) * 64 + tk]; }
#pragma unroll 1
                for (int ti = 0; ti < nT; ++ti) {
                    const int bn = ti & 1;
                    LAS bf16_t* Cbn = Cb2 + bn * NB; LAS bf16_t* Bbn = Bb2 + bn * NB; LAS bf16_t* xsn = xs2 + bn * JB; LAS bf16_t* xwn = xw2 + bn * JB; LAS float* cs = cs2 + bn * CSB;
#pragma unroll
                    for (int k = 0; k < 10; ++k) { const int gg = pw + 4 * k; const vu4 rawv = pre[k];
                        if (k < 2) *(LAS vu4*)(xsn + lane * LDJ + gg * 8) = rawv;
                        else if (k < 6) *(LAS vu4*)(Bbn + lane * LDN + (gg - 8) * 8) = rawv;
                        else *(LAS vu4*)(Cbn + lane * LDN + (gg - 24) * 8) = rawv; }
                    const float dtv = softplus_fast(bf2f(pdt) + dtbias);
                    const float cum = wave_scan_incl(dtv * Aneg);
                    const float cumlast = lane63(cum);
                    const float xsc = dtv * __expf(cumlast - cum);
                    if (pw == 0) { cs[lane] = cum; cs[64 + lane] = __expf(cum); cs[128 + lane] = dtv; if (lane == 0) cs[192] = __expf(cumlast); }
#pragma unroll
                    for (int k = 0; k < 2; ++k) { const int gg = pw + 4 * k; float xv[8]; unpack8(pre[k], xv);
#pragma unroll
                        for (int j = 0; j < 8; ++j) xv[j] *= xsc;
                        *(LAS vu4*)(xwn + lane * LDJ + gg * 8) = pack8(xv); }
                    if (VAR == 1) {
#pragma unroll
                        for (int k = 0; k < 10; ++k) asm volatile("" : "+v"(pre[k]));
                    }
                    if (VAR != 1 && ti + 1 < nT) { const int tile2 = d ? nT - 2 - ti : ti + 1; const size_t gt = (size_t)((row0 >> 6) + tile2) * 768; const int tk = d ? 63 - lane : lane; const unsigned tko = (unsigned)tk * 8u;
#pragma unroll
                        for (int k = 0; k < 10; ++k) { const int gg = pw + 4 * k; const int cg = k < 2 ? hd * 8 + gg : (k < 6 ? 512 + grp * 16 + (gg - 8) : 640 + grp * 16 + (gg - 24)); const bf16_t* pp = XT + (gt + cg) * 512; pre[k] = *(const vu4*)(pp + tko); }
                        pdt = GT[((size_t)((row0 >> 6) + tile2) * 128 + d * 64 + hd) * 64 + tk]; }
                    LDS_SYNC();
                    bf16x8_t pc[3][4], pb[3][4];
#define SSD_P2_TILE(sl) int it, jt; bool on = true; \
                        if (sl == 0) { it = pw < 2 ? 3 : 2; jt = (pw & 1) * 2; } else if (sl == 1) { it = pw == 3 ? 1 : (pw < 2 ? 3 : 2); jt = pw == 1 ? 3 : 1; } else { it = pw; jt = 0; on = pw < 2; }
#define SSD_P2_LOAD(sl) { SSD_P2_TILE(sl) if (on) { _Pragma("unroll") for (int ks = 0; ks < 4; ++ks) { pc[sl][ks] = ldfrag(Cbn, LDN, it * 16, ks * 32, lane); pb[sl][ks] = ldfrag(Bbn, LDN, jt * 16, ks * 32, lane); } } }
#define SSD_P2_COMP(sl) { SSD_P2_TILE(sl) if (on) { pg8::f32x4 acc = (pg8::f32x4){0.f, 0.f, 0.f, 0.f}; \
                            _Pragma("unroll") for (int ks = 0; ks < 4; ++ks) acc = MFMA16(pc[sl][ks], pb[sl][ks], acc); \
                            const int i0 = it * 16 + 4 * lq, j = jt * 16 + lr; const float cj = cs[j], dj = cs[128 + j]; const vf4 ci = *(const LAS vf4*)(cs + i0); \
                            acc[0] = (j <= i0 + 0) ? acc[0] * (__expf(ci.x - cj) * dj) : 0.f; acc[1] = (j <= i0 + 1) ? acc[1] * (__expf(ci.y - cj) * dj) : 0.f; \
                            acc[2] = (j <= i0 + 2) ? acc[2] * (__expf(ci.z - cj) * dj) : 0.f; acc[3] = (j <= i0 + 3) ? acc[3] * (__expf(ci.w - cj) * dj) : 0.f; \
                            if (it == jt) { acc[0] += (j == i0 + 0) ? Dd : 0.f; acc[1] += (j == i0 + 1) ? Dd : 0.f; acc[2] += (j == i0 + 2) ? Dd : 0.f; acc[3] += (j == i0 + 3) ? Dd : 0.f; } \
                            stfragT(MmT, LDJ, jt * 16, it * 16, lane, acc); } }
                    SSD_P2_LOAD(0) SSD_P2_LOAD(1)
                    asm volatile("" ::: "memory");
                    SSD_P2_COMP(0)
                    asm volatile("" ::: "memory");
                    SSD_P2_LOAD(2)
                    SSD_P2_COMP(1)
                    asm volatile("" ::: "memory");
                    SSD_P2_COMP(2)
                    LDS_SYNC();
                }
                LDS_SYNC();
                LDS_SYNC();
            } else {
                const bool addf = d == 1 && !split;
                const int it = pw;
                pg8::f32x4 st[2][4];
#pragma unroll
                for (int q = 0; q < 2; ++q)
#pragma unroll
                    for (int pt = 0; pt < 4; ++pt) st[q][pt] = (pg8::f32x4){0.f, 0.f, 0.f, 0.f};
                for (int i = tid - 256; i < NB / 2; i += 256) ((LAS unsigned*)Sb)[i] = 0u;
                vu4 pyf[2] = {(vu4){0u, 0u, 0u, 0u}, (vu4){0u, 0u, 0u, 0u}};
                if (addf) {
#pragma unroll
                    for (int r = 0; r < 2; ++r) { const int idx = tid - 256 + 256 * r, i = idx >> 3, p8 = (idx & 7) * 8; pyf[r] = *(const vu4*)(Y + (size_t)(row0 + (nT - 1) * 64 + 63 - i) * 4096 + hd * 64 + p8); } }
                LDS_SYNC();
                LDS_SYNC();
#pragma unroll 1
                for (int sc = 0; sc < nT; ++sc) {
                    const int bc = sc & 1;
                    LAS const bf16_t* Cbc = Cb2 + bc * NB; LAS const bf16_t* xsc = xs2 + bc * JB; LAS const float* cs = cs2 + bc * CSB;
                    pg8::f32x4 acc[4];
#pragma unroll
                    for (int pt = 0; pt < 4; ++pt) acc[pt] = (pg8::f32x4){0.f, 0.f, 0.f, 0.f};
                    bf16x8_t cf[4], sf[4][4], mf[2], xf[2][4];
#pragma unroll
                    for (int ks = 0; ks < 2; ++ks) { cf[ks] = ldfrag(Cbc, LDN, it * 16, ks * 32, lane);
#pragma unroll
                        for (int pt = 0; pt < 4; ++pt) sf[ks][pt] = ldfrag(Sb, LDN, pt * 16, ks * 32, lane); }
                    const float ec = cs[64 + it * 16 + lr];
                    asm volatile("" ::: "memory");
#pragma unroll
                    for (int ks = 2; ks < 4; ++ks) { cf[ks] = ldfrag(Cbc, LDN, it * 16, ks * 32, lane);
#pragma unroll
                        for (int pt = 0; pt < 4; ++pt) sf[ks][pt] = ldfrag(Sb, LDN, pt * 16, ks * 32, lane); }
#pragma unroll
                    for (int ks = 0; ks < 2; ++ks)
#pragma unroll
                        for (int pt = 0; pt < 4; ++pt) acc[pt] = MFMA16(sf[ks][pt], cf[ks], acc[pt]);
                    asm volatile("" ::: "memory");
#pragma unroll
                    for (int ks = 0; ks < 2; ++ks) if (ks == 0 || it >= 2) { mf[ks] = trfragp(MmT, LDJ, it, ks, lane);
#pragma unroll
                        for (int pt = 0; pt < 4; ++pt) xf[ks][pt] = trfragp(xsc, LDJ, pt, ks, lane); }
#pragma unroll
                    for (int ks = 2; ks < 4; ++ks)
#pragma unroll
                        for (int pt = 0; pt < 4; ++pt) acc[pt] = MFMA16(sf[ks][pt], cf[ks], acc[pt]);
                    asm volatile("" ::: "memory");
#pragma unroll
                    for (int pt = 0; pt < 4; ++pt) acc[pt] = acc[pt] * ec;
#pragma unroll
                    for (int ks = 0; ks < 2; ++ks) if (ks == 0 || it >= 2) {
#pragma unroll
                        for (int pt = 0; pt < 4; ++pt) acc[pt] = MFMA16(xf[ks][pt], mf[ks], acc[pt]); }
#pragma unroll
                    for (int pt = 0; pt < 4; ++pt) stfragT(Ys, LDJ, it * 16, pt * 16, lane, acc[pt]);
                    LDS_SYNC();
                    LAS const bf16_t* Bbc = Bb2 + bc * NB; LAS const bf16_t* xwc = xw2 + bc * JB; const float declast = cs[192];
                    const int tile = d ? nT - 1 - sc : sc, t0 = tile * 64;
                    bf16x8_t wf[2][4], bfr[2][2];
#pragma unroll
                    for (int ks = 0; ks < 2; ++ks) {
#pragma unroll
                        for (int pt = 0; pt < 4; ++pt) wf[ks][pt] = trfragp(xwc, LDJ, pt, ks, lane);
#pragma unroll
                        for (int q = 0; q < 2; ++q) bfr[ks][q] = trfragp(Bbc, LDN, 2 * pw + q, ks, lane); }
                    vu4 yv[2];
#pragma unroll
                    for (int r = 0; r < 2; ++r) { const int idx = tid - 256 + 256 * r, i = idx >> 3, p8 = (idx & 7) * 8; yv[r] = *(const LAS vu4*)(Ys + i * LDJ + p8); }
                    asm volatile("" ::: "memory");
#pragma unroll
                    for (int q = 0; q < 2; ++q)
#pragma unroll
                        for (int pt = 0; pt < 4; ++pt) st[q][pt] = st[q][pt] * declast;
#pragma unroll
                    for (int ks = 0; ks < 2; ++ks)
#pragma unroll
                        for (int q = 0; q < 2; ++q)
#pragma unroll
                            for (int pt = 0; pt < 4; ++pt) st[q][pt] = MFMA16(bfr[ks][q], wf[ks][pt], st[q][pt]);
#pragma unroll
                    for (int q = 0; q < 2; ++q)
#pragma unroll
                        for (int pt = 0; pt < 4; ++pt) stfragT(Sb, LDN, pt * 16, (2 * pw + q) * 16, lane, st[q][pt]);
                    vu4 pyn[2] = {pyf[0], pyf[1]};
                    if (VAR != 1 && addf && sc + 1 < nT) { const int tile2 = nT - 2 - sc;
#pragma unroll
                        for (int r = 0; r < 2; ++r) { const int idx = tid - 256 + 256 * r, i = idx >> 3, p8 = (idx & 7) * 8; pyn[r] = *(const vu4*)(Y + (size_t)(row0 + tile2 * 64 + 63 - i) * 4096 + hd * 64 + p8); } }
#pragma unroll
                    for (int r = 0; r < 2; ++r) { const int idx = tid - 256 + 256 * r, i = idx >> 3, p8 = (idx & 7) * 8;
                        const int orow = row0 + t0 + (d ? 63 - i : i);
                        bf16_t* dst = (split && d == 0 ? Yfs + (size_t)(orow - 32768) * 4096 : Y + (size_t)orow * 4096) + hd * 64 + p8;
                        vu4 o = yv[r];
                        if (addf) { float of[8], pf[8]; unpack8(o, of); unpack8(pyf[r], pf);
#pragma unroll
                            for (int j = 0; j < 8; ++j) of[j] += pf[j];
                            o = pack8(of); }
                        if (VAR != 1) *(vu4*)dst = o; else asm volatile("" :: "v"(o)); }
                    pyf[0] = pyn[0]; pyf[1] = pyn[1];
                    LDS_SYNC();
                }
            }
            __syncthreads();
        }
    }
}

__device__ __forceinline__ bf16x8_t dn_afrag2(const LAS bf16_t* AD, int row, int c0, int c1, int lq) {
    const vu2 lo = *(const LAS vu2*)(AD + row * 72 + 16 * c0 + 4 * lq); vu2 hi = (vu2){0u, 0u}; if (c1 >= 0) hi = *(const LAS vu2*)(AD + row * 72 + 16 * c1 + 4 * lq);
    const vu4 w = (vu4){lo.x, lo.y, hi.x, hi.y}; return __builtin_bit_cast(bf16x8_t, w); }
__device__ __forceinline__ bf16x8_t dn_bfrag2(const pg8::f32x4 x0, const pg8::f32x4 x1, bool has1) {
    vu4 w; w.x = pg8::cvt_pk_bf16(x0[0], x0[1]); w.y = pg8::cvt_pk_bf16(x0[2], x0[3]); w.z = has1 ? pg8::cvt_pk_bf16(x1[0], x1[1]) : 0u; w.w = has1 ? pg8::cvt_pk_bf16(x1[2], x1[3]) : 0u;
    return __builtin_bit_cast(bf16x8_t, w); }

#define STAGE_IDS int lane_q = lane_f, wave_q = wave_f, tid_q = tid_f; asm volatile("" : "+v"(lane_q), "+s"(wave_q), "+v"(tid_q)); const int lane = lane_q, wave = wave_q, tid = tid_q, lr = lane & 15, lq = lane >> 4; (void)tid; (void)lr; (void)lq; (void)wave;
#ifndef DN_PREFETCH
#define DN_PREFETCH 1
#endif
__device__ __forceinline__ void ph_dn_core2(const Args& a, lds_u8* lds, const bf16_t* GT, const bf16_t* XT, bf16_t* of, bf16_t* ob) {
    constexpr int LDN = 136, LDJ = 72;
    LAS bf16_t* qsb = (LAS bf16_t*)lds;
    LAS bf16_t* ksb = qsb + 64 * LDN;
    LAS bf16_t* kwT = ksb + 64 * LDN;
    LAS bf16_t* vT = kwT + 128 * LDJ;
    LAS bf16_t* Sb = vT + 128 * LDJ;
    LAS bf16_t* Pm = Sb + 128 * LDN;
    LAS bf16_t* AD = Pm + 64 * LDJ;
    LAS float* Ad = (LAS float*)(AD + 64 * LDJ);
    LAS float* Gv = Ad + 4 * 16 * 20;
    LAS float* eG = Gv + 64;
    LAS float* bet = eG + 64;
    LAS bf16_t* Os = ksb; LAS bf16_t* VnT = vT;
    const int tid = threadIdx.x, lane = tid & 63, wave = __builtin_amdgcn_readfirstlane(tid >> 6);
    const int tid_f = tid, lane_f = lane, wave_f = wave;
    const float* a_log = ARG_IN(12); const float* dtb = ARG_IN(13);
    for (int u = blockIdx.x; u < 192; u += gridDim.x) {
        int s, rr; if (u < 128) { s = u >> 5; rr = u & 31; } else { s = 4 + ((u - 128) >> 5); rr = (u - 128) & 31; }
        const int h = rr >> 1, d = rr & 1;
        const int L = seq_len(s), row0 = seq_start(s), nT = L >> 6;
        const float Aneg = -expf(a_log[d * 16 + h]), dtbias = dtb[d * 16 + h];
        pg8::f32x4 st[8];
#pragma unroll
        for (int q = 0; q < 8; ++q) st[q] = (pg8::f32x4){0.f, 0.f, 0.f, 0.f};
        for (int i = tid; i < 128 * LDN / 2; i += NTHR) ((LAS unsigned*)Sb)[i] = 0u;
        for (int i = tid; i < 64 * LDJ / 2; i += NTHR) ((LAS unsigned*)Pm)[i] = 0u;
        vu4 pq[2], pk[2], pv[2]; bf16_t pb, pa;
        { const int tile = d ? nT - 1 : 0; const size_t gt = (size_t)((row0 >> 6) + tile) * 768; const int tk = d ? 63 - lane : lane;
#pragma unroll
            for (int k = 0; k < 2; ++k) { const int cg = h * 16 + wave + 8 * k; pq[k] = *(const vu4*)(XT + ((gt + cg) * 64 + tk) * 8); pk[k] = *(const vu4*)(XT + ((gt + 256 + cg) * 64 + tk) * 8); pv[k] = *(const vu4*)(XT + ((gt + 512 + cg) * 64 + tk) * 8); }
            pb = GT[((size_t)((row0 >> 6) + tile) * 64 + d * 16 + h) * 64 + tk]; pa = GT[((size_t)((row0 >> 6) + tile) * 64 + 32 + d * 16 + h) * 64 + tk]; }
#pragma unroll 1
        for (int ti = 0; ti < nT; ++ti) {
            const int tile = d ? nT - 1 - ti : ti, t0 = tile * 64;
            float declast;
            { STAGE_IDS
            const float be = __builtin_amdgcn_rcpf(1.0f + __expf(-bf2f(pb)));
            const float G = wave_scan_incl(Aneg * softplus_fast(bf2f(pa) + dtbias));
            const float Glast = lane63(G), wgt = __expf(Glast - G); declast = __expf(Glast);
            if (wave == 0) { Gv[lane] = G; eG[lane] = __expf(G); bet[lane] = be; }
#pragma unroll
            for (int k = 0; k < 2; ++k) { const int c0 = (wave + 8 * k) * 8;
                *(LAS vu4*)(qsb + lane * LDN + c0) = pq[k];
                *(LAS vu4*)(ksb + lane * LDN + c0) = pk[k]; float kv[8]; unpack8(pk[k], kv);
#pragma unroll
                for (int j = 0; j < 8; ++j) { const float x = kv[j] * wgt; kwT[(c0 + j) * LDJ + lane] = (bf16_t)(pg8::cvt_pk_bf16(x, x) & 0xffffu); }
                const vu4 rawv = pv[k];
                vT[(c0 + 0) * LDJ + lane] = (bf16_t)(rawv.x & 0xffffu); vT[(c0 + 1) * LDJ + lane] = (bf16_t)(rawv.x >> 16); vT[(c0 + 2) * LDJ + lane] = (bf16_t)(rawv.y & 0xffffu); vT[(c0 + 3) * LDJ + lane] = (bf16_t)(rawv.y >> 16);
                vT[(c0 + 4) * LDJ + lane] = (bf16_t)(rawv.z & 0xffffu); vT[(c0 + 5) * LDJ + lane] = (bf16_t)(rawv.z >> 16); vT[(c0 + 6) * LDJ + lane] = (bf16_t)(rawv.w & 0xffffu); vT[(c0 + 7) * LDJ + lane] = (bf16_t)(rawv.w >> 16); }
#if DN_PREFETCH
            if (ti + 1 < nT) { const int tile2 = d ? nT - 2 - ti : ti + 1; const size_t gt = (size_t)((row0 >> 6) + tile2) * 768; const int tk = d ? 63 - lane : lane;
#pragma unroll
                for (int k = 0; k < 2; ++k) { const int cg = h * 16 + wave + 8 * k; pq[k] = *(const vu4*)(XT + ((gt + cg) * 64 + tk) * 8); pk[k] = *(const vu4*)(XT + ((gt + 256 + cg) * 64 + tk) * 8); pv[k] = *(const vu4*)(XT + ((gt + 512 + cg) * 64 + tk) * 8); }
                pb = GT[((size_t)((row0 >> 6) + tile2) * 64 + d * 16 + h) * 64 + tk]; pa = GT[((size_t)((row0 >> 6) + tile2) * 64 + 32 + d * 16 + h) * 64 + tk]; }
#endif
            }
            LDS_SYNC();
            { STAGE_IDS
            { bf16x8_t ja[3][4], jc[3][4]; float jgi[3], jbi[3]; vf4 jgj[3]; pg8::f32x4 jacc[3];
#define DN_JOB(jb) const int idr = wave + 8 * jb; const bool on = idr < 20; const int id = on ? idr : 19; const int kind = id >= 10 ? 1 : 0, pr = id - 10 * kind, it = pr >= 6 ? 3 : (pr >= 3 ? 2 : (pr >= 1 ? 1 : 0)), jt = pr - (it * (it + 1)) / 2; \
                const int ii = it * 16 + lr, j0 = jt * 16 + 4 * lq;
#define DN_JOB_LOAD(jb) { DN_JOB(jb) const LAS bf16_t* bsrc = kind ? qsb : ksb; \
                    _Pragma("unroll") for (int ks = 0; ks < 4; ++ks) { ja[jb][ks] = ldfrag(ksb, LDN, jt * 16, ks * 32, lane); jc[jb][ks] = ldfrag(bsrc, LDN, it * 16, ks * 32, lane); } \
                    jgi[jb] = Gv[ii]; jgj[jb] = *(const LAS vf4*)(Gv + j0); jbi[jb] = bet[ii]; }
#define DN_JOB_MM(jb) { jacc[jb] = (pg8::f32x4){0.f, 0.f, 0.f, 0.f}; \
                    _Pragma("unroll") for (int ks = 0; ks < 4; ++ks) jacc[jb] = MFMA16(ja[jb][ks], jc[jb][ks], jacc[jb]); }
#define DN_JOB_EPI(jb) { DN_JOB(jb) const pg8::f32x4 acc = jacc[jb]; const float gi = jgi[jb]; const vf4 gj = jgj[jb]; const float mul = kind ? 1.0f : jbi[jb]; const int lim = ii + kind; pg8::f32x4 o; \
                    o[0] = (j0 + 0 < lim) ? mul * acc[0] * __expf(gi - gj.x) : 0.f; o[1] = (j0 + 1 < lim) ? mul * acc[1] * __expf(gi - gj.y) : 0.f; \
                    o[2] = (j0 + 2 < lim) ? mul * acc[2] * __expf(gi - gj.z) : 0.f; o[3] = (j0 + 3 < lim) ? mul * acc[3] * __expf(gi - gj.w) : 0.f; \
                    if (on) { if (kind) stfragT(Pm, LDJ, it * 16, jt * 16, lane, o); \
                        else if (it == jt) *(LAS vf4*)(Ad + (it * 16 + lr) * 20 + 4 * lq) = (vf4){o[0], o[1], o[2], o[3]}; \
                        else stfragT(AD, LDJ, it * 16, jt * 16, lane, o); } }
                DN_JOB_LOAD(0)
                asm volatile("" ::: "memory");
                DN_JOB_MM(0) DN_JOB_LOAD(1) DN_JOB_EPI(0)
                asm volatile("" ::: "memory");
                DN_JOB_MM(1) DN_JOB_LOAD(2) DN_JOB_EPI(1)
                asm volatile("" ::: "memory");
                DN_JOB_MM(2) DN_JOB_EPI(2) }
            }
            LDS_SYNC();
            { STAGE_IDS
            if (wave == 0) { const int b = lane >> 4, j = lane & 15; float x[16];
                const LAS float* Ab = Ad + b * 16 * 20;
                vf4 ar[16][4];
#define DN_INV_LD(r) { _Pragma("unroll") for (int r4 = 0; r4 < ((r) + 3) / 4; ++r4) ar[r][r4] = *(const LAS vf4*)(Ab + (r) * 20 + r4 * 4); }
#define DN_INV_ROW(r) { float s0 = ((r) == j) ? 1.0f : 0.0f, s1 = 0.f; \
                    _Pragma("unroll") for (int r4 = 0; r4 < ((r) + 3) / 4; ++r4) { const vf4 av = ar[r][r4]; \
                        if (r4 * 4 + 0 < (r)) s0 -= av.x * x[r4 * 4 + 0]; if (r4 * 4 + 1 < (r)) s1 -= av.y * x[r4 * 4 + 1]; if (r4 * 4 + 2 < (r)) s0 -= av.z * x[r4 * 4 + 2]; if (r4 * 4 + 3 < (r)) s1 -= av.w * x[r4 * 4 + 3]; } \
                    x[r] = s0 + s1; }
                DN_INV_LD(1) DN_INV_LD(2) DN_INV_LD(3) DN_INV_LD(4) DN_INV_LD(5) DN_INV_LD(6) DN_INV_LD(7) DN_INV_LD(8)
                asm volatile("" ::: "memory");
                DN_INV_ROW(0) DN_INV_ROW(1) DN_INV_ROW(2) DN_INV_ROW(3) DN_INV_ROW(4)
                DN_INV_LD(9) DN_INV_LD(10)
                asm volatile("" ::: "memory");
                DN_INV_ROW(5) DN_INV_ROW(6) DN_INV_ROW(7) DN_INV_ROW(8)
                DN_INV_LD(11) DN_INV_LD(12)
                asm volatile("" ::: "memory");
                DN_INV_ROW(9) DN_INV_ROW(10)
                DN_INV_LD(13) DN_INV_LD(14)
                asm volatile("" ::: "memory");
                DN_INV_ROW(11) DN_INV_ROW(12)
                DN_INV_LD(15)
                asm volatile("" ::: "memory");
                DN_INV_ROW(13) DN_INV_ROW(14) DN_INV_ROW(15)
#pragma unroll
                for (int r = 0; r < 16; ++r) AD[(16 * b + r) * LDJ + 16 * b + j] = (bf16_t)(pg8::cvt_pk_bf16(x[r], x[r]) & 0xffffu); }
            }
            pg8::f32x4 ao[4], Rr[4];
            { STAGE_IDS
            { bf16x8_t sbf[4], tf[8][4]; vf4 tb4[4], te4[4]; vu2 tvr[4];
#pragma unroll
                for (int ks = 0; ks < 4; ++ks) sbf[ks] = ldfrag(Sb, LDN, wave * 16, ks * 32, lane);
#define DN_T_LOAD(t) { if ((t) < 4) { _Pragma("unroll") for (int ks = 0; ks < 4; ++ks) tf[t][ks] = ldfrag(qsb, LDN, (t) * 16, ks * 32, lane); } \
                    else { _Pragma("unroll") for (int ks = 0; ks < 4; ++ks) tf[t][ks] = ldfrag(ksb, LDN, ((t) - 4) * 16, ks * 32, lane); \
                        const int j0 = ((t) - 4) * 16 + 4 * lq; tb4[(t) & 3] = *(const LAS vf4*)(bet + j0); te4[(t) & 3] = *(const LAS vf4*)(eG + j0); tvr[(t) & 3] = *(const LAS vu2*)(vT + (wave * 16 + lr) * LDJ + j0); } }
#define DN_T_COMP(t) { pg8::f32x4 acc = (pg8::f32x4){0.f, 0.f, 0.f, 0.f}; \
                    if ((t) < 4) { _Pragma("unroll") for (int ks = 0; ks < 4; ++ks) acc = MFMA16(sbf[ks], tf[t][ks], acc); ao[(t) & 3] = acc; } \
                    else { _Pragma("unroll") for (int ks = 0; ks < 4; ++ks) acc = MFMA16(tf[t][ks], sbf[ks], acc); \
                        const vf4 b4 = tb4[(t) & 3], e4 = te4[(t) & 3]; const vu2 vr = tvr[(t) & 3]; \
                        Rr[(t) & 3][0] = b4.x * (__uint_as_float(vr.x << 16) - e4.x * acc[0]); Rr[(t) & 3][1] = b4.y * (__uint_as_float(vr.x & 0xffff0000u) - e4.y * acc[1]); \
                        Rr[(t) & 3][2] = b4.z * (__uint_as_float(vr.y << 16) - e4.z * acc[2]); Rr[(t) & 3][3] = b4.w * (__uint_as_float(vr.y & 0xffff0000u) - e4.w * acc[3]); } }
                DN_T_LOAD(0)
                asm volatile("" ::: "memory");
                DN_T_LOAD(1) DN_T_COMP(0)
                asm volatile("" ::: "memory");
                DN_T_LOAD(2) DN_T_COMP(1)
                asm volatile("" ::: "memory");
                DN_T_LOAD(3) DN_T_COMP(2)
                asm volatile("" ::: "memory");
                DN_T_LOAD(4) DN_T_COMP(3)
                asm volatile("" ::: "memory");
                DN_T_LOAD(5) DN_T_COMP(4)
                asm volatile("" ::: "memory");
                DN_T_LOAD(6) DN_T_COMP(5)
                asm volatile("" ::: "memory");
                DN_T_LOAD(7) DN_T_COMP(6)
                asm volatile("" ::: "memory");
                DN_T_COMP(7) }
            }
            LDS_SYNC();
            { STAGE_IDS
            { const pg8::f32x4 z4 = (pg8::f32x4){0.f, 0.f, 0.f, 0.f};
                const bf16x8_t f00 = dn_afrag2(AD, 0 + lr, 0, -1, lq), f10 = dn_afrag2(AD, 16 + lr, 0, -1, lq), f11 = dn_afrag2(AD, 16 + lr, 1, -1, lq), f20 = dn_afrag2(AD, 32 + lr, 0, 1, lq), f22 = dn_afrag2(AD, 32 + lr, 2, -1, lq),
                    f30 = dn_afrag2(AD, 48 + lr, 0, 1, lq), f32 = dn_afrag2(AD, 48 + lr, 2, -1, lq), f33 = dn_afrag2(AD, 48 + lr, 3, -1, lq);
                asm volatile("" ::: "memory");
                const pg8::f32x4 V0 = MFMA16(f00, dn_bfrag2(Rr[0], z4, false), z4);
                const pg8::f32x4 U1 = MFMA16(f10, dn_bfrag2(V0, z4, false), z4);
                const pg8::f32x4 V1 = MFMA16(f11, dn_bfrag2(Rr[1] - U1, z4, false), z4);
                const pg8::f32x4 U2 = MFMA16(f20, dn_bfrag2(V0, V1, true), z4);
                const pg8::f32x4 V2 = MFMA16(f22, dn_bfrag2(Rr[2] - U2, z4, false), z4);
                pg8::f32x4 U3 = MFMA16(f30, dn_bfrag2(V0, V1, true), z4);
                U3 = MFMA16(f32, dn_bfrag2(V2, z4, false), U3);
                const pg8::f32x4 V3 = MFMA16(f33, dn_bfrag2(Rr[3] - U3, z4, false), z4);
                stfragT(VnT, LDJ, wave * 16, 0, lane, V0); stfragT(VnT, LDJ, wave * 16, 16, lane, V1); stfragT(VnT, LDJ, wave * 16, 32, lane, V2); stfragT(VnT, LDJ, wave * 16, 48, lane, V3); }
            }
            LDS_SYNC();
            { STAGE_IDS
            { bf16x8_t vn[2], pm[4][2], kw[2], vv[8][2]; float eg[4];
#pragma unroll
                for (int ks = 0; ks < 2; ++ks) { vn[ks] = ldfrag(VnT, LDJ, wave * 16, ks * 32, lane); kw[ks] = ldfrag(kwT, LDJ, wave * 16, ks * 32, lane); }
#pragma unroll
                for (int it = 0; it < 4; ++it) { eg[it] = eG[it * 16 + lr]; pm[it][0] = ldfrag(Pm, LDJ, it * 16, 0, lane); if (it >= 2) pm[it][1] = ldfrag(Pm, LDJ, it * 16, 32, lane); }
#define DN_V_LOAD(vt) { vv[vt][0] = ldfrag(VnT, LDJ, (vt) * 16, 0, lane); vv[vt][1] = ldfrag(VnT, LDJ, (vt) * 16, 32, lane); }
#define DN_V_COMP(vt) { st[vt] = st[vt] * declast; st[vt] = MFMA16(kw[0], vv[vt][0], st[vt]); st[vt] = MFMA16(kw[1], vv[vt][1], st[vt]); }
                DN_V_LOAD(0) DN_V_LOAD(1)
                asm volatile("" ::: "memory");
#pragma unroll
                for (int it = 0; it < 4; ++it) { ao[it] = ao[it] * eg[it];
                    ao[it] = MFMA16(vn[0], pm[it][0], ao[it]);
                    if (it >= 2) ao[it] = MFMA16(vn[1], pm[it][1], ao[it]);
                    stfragT(Os, LDN, it * 16, wave * 16, lane, ao[it]); }
                asm volatile("" ::: "memory");
                DN_V_LOAD(2) DN_V_LOAD(3) DN_V_COMP(0) DN_V_COMP(1)
                asm volatile("" ::: "memory");
                DN_V_LOAD(4) DN_V_LOAD(5) DN_V_COMP(2) DN_V_COMP(3)
                asm volatile("" ::: "memory");
                DN_V_LOAD(6) DN_V_LOAD(7) DN_V_COMP(4) DN_V_COMP(5)
                asm volatile("" ::: "memory");
                DN_V_COMP(6) DN_V_COMP(7) }
            }
            LDS_SYNC();
            { STAGE_IDS
#pragma unroll
            for (int vt = 0; vt < 8; ++vt) stfragT(Sb, LDN, vt * 16, wave * 16, lane, st[vt]);
            { const int i = tid >> 3, v16 = (tid & 7) * 16;
                bf16_t* dst = (d ? ob : of) + (size_t)(row0 + t0 + (d ? 63 - i : i)) * DM + h * 128 + v16;
                const vu4 o0 = *(const LAS vu4*)(Os + i * LDN + v16), o1 = *(const LAS vu4*)(Os + i * LDN + v16 + 8); *(vu4*)dst = o0; *(vu4*)(dst + 8) = o1; }
            }
            LDS_SYNC();
        }
    }
}

constexpr int HY_LD = 6144;
__device__ __forceinline__ void ph_hy_prep(const Args& a, lds_u8* lds, const bf16_t* proj, bf16_t* sT) {
    LAS float* tile = (LAS float*)lds;
    const int tid = threadIdx.x;
    const float* cw = ARG_IN(35);
    for (int u = blockIdx.x; u < 640 * 8; u += gridDim.x) {
        const int tt = u >> 3, ct = u & 7, row_t0 = tt * 64, c0 = ct * 256;
        const int s = seq_of_row(row_t0), L = seq_len(s), rs = seq_start(s), t0 = row_t0 - rs;
        { const int t = tid >> 3, c8s = (tid & 7) * 8;
            vu4 r1[4][3], r2[4][3];
#pragma unroll
            for (int q = 0; q < 4; ++q)
#pragma unroll
                for (int tap = 0; tap < 3; ++tap) { const int tq = t0 + t + tap - 1; r1[q][tap] = (vu4){0u, 0u, 0u, 0u}; r2[q][tap] = (vu4){0u, 0u, 0u, 0u};
                    if (tq >= 0 && tq < L) { const bf16_t* pr = proj + (size_t)(rs + tq) * HY_LD + c0 + q * 64 + c8s; r1[q][tap] = *(const vu4*)(pr + 2048); r2[q][tap] = *(const vu4*)(pr + 4096); } }
#pragma unroll
            for (int q = 0; q < 4; ++q) { float x1[8], vv[8];
#pragma unroll
                for (int j = 0; j < 8; ++j) { x1[j] = 0.f; vv[j] = 0.f; }
#pragma unroll
                for (int tap = 0; tap < 3; ++tap) { float f1[8], f2[8], w1[8], w2[8]; unpack8(r1[q][tap], f1); unpack8(r2[q][tap], f2);
                    load8f(cw + tap * 6144 + 2048 + c0 + q * 64 + c8s, w1); load8f(cw + tap * 6144 + 4096 + c0 + q * 64 + c8s, w2);
#pragma unroll
                    for (int j = 0; j < 8; ++j) { x1[j] += w1[j] * f1[j]; vv[j] += w2[j] * f2[j]; } }
#pragma unroll
                for (int j = 0; j < 8; ++j) tile[(q * 64 + c8s + j) * 65 + t] = x1[j] * vv[j]; } }
        LDS_SYNC();
        { const int c = tid >> 1, th = (tid & 1) * 32; bf16_t* dst = sT + (size_t)rs * DM + (size_t)(c0 + c) * L + t0 + th;
#pragma unroll
            for (int k = 0; k < 4; ++k) { float o[8];
#pragma unroll
                for (int j = 0; j < 8; ++j) o[j] = tile[c * 65 + th + k * 8 + j];
                *(vu4*)(dst + k * 8) = pack8(o); } }
        LDS_SYNC();
    }
}
__device__ __forceinline__ void ph_hy_fwoT(const float* fwo, bf16_t* fwoT) {
    for (int i8 = blockIdx.x * NTHR + threadIdx.x; i8 < 4096 * 8; i8 += gridDim.x * NTHR) { const int dcol = i8 >> 3, k0 = (i8 & 7) * 8; float v[8];
#pragma unroll
        for (int j = 0; j < 8; ++j) v[j] = fwo[(size_t)(k0 + j) * 4096 + dcol];
        *(vu4*)(fwoT + (size_t)dcol * 64 + k0) = pack8(v); }
}
__device__ __forceinline__ void ph_hy_filter(const Args& a, lds_u8* lds, const bf16_t* fwoT, float* hf8, float* hb8, float* hf4, float* hb4, int rank, int nrank) {
    LAS float* hA = (LAS float*)lds;
    LAS float* hB = hA + 64 * 64;
    LAS bf16_t* hdb = (LAS bf16_t*)(hB + 64 * 64);
    LAS float* outs = (LAS float*)(lds + 49152);
    const int tid = threadIdx.x, lane = tid & 63, wave = __builtin_amdgcn_readfirstlane(tid >> 6), lr = lane & 15, lq = lane >> 4;
    const float* fw1 = ARG_IN(36); const float* fb1 = ARG_IN(37); const float* fw2 = ARG_IN(38); const float* fb2 = ARG_IN(39);
    const float* fw3 = ARG_IN(40); const float* fb3 = ARG_IN(41); const float* freq = ARG_IN(43);
    for (int u = rank; u < 192; u += nrank) {
        int L, tt; if (u < 128) { L = 8192; tt = u; } else { L = 4096; tt = u - 128; }
        const int t0 = tt * 64; const float invLm1 = 1.0f / (float)(L - 1);
#pragma unroll 1
        for (int idx = tid; idx < 64 * 33; idx += NTHR) { const int t = idx / 33, f = idx % 33, ti = t0 + t; float val;
            if (f == 0) val = (float)ti / (float)(L - 1);
            else { const int j = (f - 1) & 15; const float fr = 1e-4f + (float)j * ((15.0f - 1e-4f) / 15.0f); float rev = fr * ((float)ti / (float)L); rev -= floorf(rev);
                const float ang = 6.283185307179586f * rev; val = f <= 16 ? cosf(ang) : -sinf(ang); }
            hA[t * 64 + f] = val; }
        LDS_SYNC();
        { const int t = tid >> 3, c8 = (tid & 7) * 8; float acc[8];
            load8f(fb1 + c8, acc);
#pragma unroll 1
            for (int f = 0; f < 33; ++f) { const float z = hA[t * 64 + f]; float w[8]; load8f(fw1 + f * 64 + c8, w);
#pragma unroll
                for (int j = 0; j < 8; ++j) acc[j] += z * w[j]; }
            float fq[8]; load8f(freq + c8, fq);
#pragma unroll
            for (int j = 0; j < 8; ++j) hB[t * 64 + c8 + j] = sinf(fq[j] * acc[j]); }
        LDS_SYNC();
        { const int t = tid >> 3, c8 = (tid & 7) * 8; float acc[8];
            load8f(fb2 + c8, acc);
#pragma unroll 2
            for (int f = 0; f < 64; ++f) { const float z = hB[t * 64 + f]; float w[8]; load8f(fw2 + f * 64 + c8, w);
#pragma unroll
                for (int j = 0; j < 8; ++j) acc[j] += z * w[j]; }
            float fq[8]; load8f(freq + 64 + c8, fq);
#pragma unroll
            for (int j = 0; j < 8; ++j) hA[t * 64 + c8 + j] = sinf(fq[j] * acc[j]); }
        LDS_SYNC();
        { const int t = tid >> 3, c8 = (tid & 7) * 8; float acc[8];
            load8f(fb3 + c8, acc);
#pragma unroll 2
            for (int f = 0; f < 64; ++f) { const float z = hA[t * 64 + f]; float w[8]; load8f(fw3 + f * 64 + c8, w);
#pragma unroll
                for (int j = 0; j < 8; ++j) acc[j] += z * w[j]; }
            float fq[8], o[8]; load8f(freq + 128 + c8, fq);
#pragma unroll
            for (int j = 0; j < 8; ++j) o[j] = sinf(fq[j] * acc[j]);
            *(LAS vu4*)(hdb + t * 72 + c8) = pack8(o); }
        LDS_SYNC();
        bf16x8_t Af[4][2];
#pragma unroll
        for (int tq = 0; tq < 4; ++tq)
#pragma unroll
            for (int ks = 0; ks < 2; ++ks) Af[tq][ks] = ldfrag(hdb, 72, tq * 16, ks * 32, lane);
        const float min_decay = -3.0701134573253944f, max_decay = -15.350567286626972f;
#pragma unroll 1
        for (int dc = 0; dc < 16; ++dc) {
#pragma unroll
            for (int q = 0; q < 2; ++q) { const int dcol = dc * 256 + wave * 32 + q * 16 + lr, ch = dcol & 2047;
                const bf16x8_t B0 = *(const bf16x8_t*)(fwoT + (size_t)dcol * 64 + 8 * lq), B1 = *(const bf16x8_t*)(fwoT + (size_t)dcol * 64 + 32 + 8 * lq);
                const float delta = (min_decay + (float)ch * ((max_decay - min_decay) / 2047.0f)) * invLm1;
                const float wb = __expf(delta * (float)(t0 + 4 * lq)), r1 = __expf(delta), r2 = r1 * r1, r3 = r2 * r1, r16 = __expf(16.0f * delta);
                float wt = wb;
#pragma unroll
                for (int tq = 0; tq < 4; ++tq) { pg8::f32x4 acc = (pg8::f32x4){0.f, 0.f, 0.f, 0.f};
                    acc = MFMA16(Af[tq][0], B0, acc); acc = MFMA16(Af[tq][1], B1, acc);
                    *(LAS vf4*)(outs + (wave * 32 + q * 16 + lr) * 68 + tq * 16 + 4 * lq) = (vf4){acc[0] * wt, acc[1] * (wt * r1), acc[2] * (wt * r2), acc[3] * (wt * r3)};
                    wt *= r16; } }
            LDS_SYNC();
            { const int dl = tid >> 1, th = (tid & 1) * 32, dcol = dc * 256 + dl, dir = dcol >> 11, ch = dcol & 2047;
                float* dst = (L == 8192 ? (dir ? hb8 : hf8) : (dir ? hb4 : hf4)) + (size_t)ch * L + t0 + th;
#pragma unroll
                for (int k = 0; k < 8; ++k) *(vf4*)(dst + k * 4) = *(const LAS vf4*)(outs + dl * 68 + th + k * 4); }
            LDS_SYNC();
        }
    }
}

template <int M, int Q, bool INV, int LS>
__device__ __forceinline__ void fft_group(vf2 (&v)[1 << Q], const int bl) {
    constexpr int R = 1 << Q, s0 = M - LS - Q;
    const float invN = 1.0f / (float)(1 << M);
    const float th0 = (float)(bl << s0) * invN;
    vf2 bp[Q]; bp[0] = (vf2){__builtin_amdgcn_cosf(th0), __builtin_amdgcn_sinf(th0)};
#pragma unroll
    for (int q = 1; q < Q; ++q) { const vf2 t = bp[q - 1]; bp[q] = (vf2){t.x * t.x - t.y * t.y, 2.0f * t.x * t.y}; }
#pragma unroll
    for (int qq = 0; qq < Q; ++qq) {
        const int q = INV ? Q - 1 - qq : qq;
        const int span = R >> (q + 1);
        float bqx = bp[q].x, bqy = bp[q].y; asm volatile("" : "+v"(bqx), "+v"(bqy), "+v"(v[0].x));
#pragma unroll
        for (int rl = 0; rl < span; ++rl) {
            const float cr = (float)__builtin_cos(6.283185307179586 * (rl << q) / R), sr = (float)__builtin_sin(6.283185307179586 * (rl << q) / R);
            const float c = rl == 0 ? bqx : bqx * cr - bqy * sr, sn = rl == 0 ? bqy : bqy * cr + bqx * sr;
#pragma unroll
            for (int rh = 0; rh < R; rh += 2 * span) { const int r = rh + rl;
                if (!INV) { const vf2 x = v[r], y = v[r + span]; v[r] = (vf2){x.x + y.x, x.y + y.y}; const float dx = x.x - y.x, dy = x.y - y.y;
                    v[r + span] = (vf2){dx * c + dy * sn, dy * c - dx * sn}; }
                else { const vf2 x = v[r], y = v[r + span]; const float bx = y.x * c - y.y * sn, by = y.y * c + y.x * sn;
                    v[r] = (vf2){x.x + bx, x.y + by}; v[r + span] = (vf2){x.x - bx, x.y - by}; } }
        }
    }
}
template <int M, int Q, bool INV, int LS>
__device__ __forceinline__ void fft_pass(LAS vf2* X, const int tid_in) {
    int tid = tid_in; asm volatile("" : "+v"(tid));
    constexpr int R = 1 << Q, HR = R / 2;
    constexpr int m = M, s0 = M - LS - Q, lstride = LS, stride = 1 << LS, groups = 1 << (M - Q);
    const float invN = 1.0f / (float)(1 << m);
#pragma unroll 1
    for (int g = tid; g < groups; g += NTHR) {
        const int bl = g & (stride - 1), bh = g >> lstride, base = (bh << (lstride + Q)) + bl;
        const int pb = LS >= 4 ? base + (base >> 4) : (LS + Q >= 4 ? base + (bh << (LS + Q - 4)) : base + (base >> 4));
#define FFT_POFF(r) (LS >= 4 ? (r) * ((1 << LS) + (1 << (LS >= 4 ? LS - 4 : 0))) : (LS + Q >= 4 ? ((r) << LS) + ((r) >> (4 - LS)) : (r)))
        vf2 v[R];
#pragma unroll
        for (int r = 0; r < R; ++r) v[r] = X[pb + FFT_POFF(r)];
            fft_group<M, Q, INV, LS>(v, bl);
#pragma unroll
        for (int r = 0; r < R; ++r) X[pb + FFT_POFF(r)] = v[r];
    }
}
template <int M> __device__ __forceinline__ void fft_fwd(LAS vf2* X, const int tid) {
    fft_pass<M, 4, false, M - 4>(X, tid); __syncthreads(); fft_pass<M, 4, false, M - 8>(X, tid); __syncthreads(); fft_pass<M, 4, false, M - 12>(X, tid); __syncthreads();
    fft_pass<M, M - 12, false, 0>(X, tid); __syncthreads(); }
template <int M>
__device__ __forceinline__ void fft_conv(LAS vf2* X, const int tid_in, const vf2* FS) {
    constexpr int groups = 1 << (M - 4);
    fft_pass<M, M - 12, false, 12>(X, tid_in); __syncthreads(); fft_pass<M, 4, false, 8>(X, tid_in); __syncthreads(); fft_pass<M, 4, false, 4>(X, tid_in); __syncthreads();
    int tid = tid_in; asm volatile("" : "+v"(tid));
    vf4 fA[8];
#pragma unroll
    for (int k = 0; k < 8; ++k) fA[k] = ((const vf4*)FS)[(unsigned)(8 * tid + k)];
    { const int pb = 17 * tid;
        vf2 v[16];
#pragma unroll
        for (int r = 0; r < 16; ++r) v[r] = X[pb + r];
        fft_group<M, 4, false, 0>(v, 0);
#pragma unroll
        for (int r = 0; r < 16; ++r) { const float fx = (r & 1) ? fA[r >> 1].z : fA[r >> 1].x, fy = (r & 1) ? fA[r >> 1].w : fA[r >> 1].y; const vf2 t = v[r]; v[r] = (vf2){t.x * fx - t.y * fy, t.x * fy + t.y * fx}; }
        fft_group<M, 4, true, 0>(v, 0);
#pragma unroll
        for (int r = 0; r < 16; ++r) X[pb + r] = v[r];
        if (groups > NTHR) { const int pb2 = 17 * (tid + NTHR);
            asm volatile("" ::: "memory");
            vf4 fB[8];
#pragma unroll
            for (int k = 0; k < 8; ++k) fB[k] = ((const vf4*)FS)[(unsigned)(8 * (tid + NTHR) + k)];
#pragma unroll
            for (int r = 0; r < 16; ++r) v[r] = X[pb2 + r];
            fft_group<M, 4, false, 0>(v, 0);
#pragma unroll
            for (int r = 0; r < 16; ++r) { const float fx = (r & 1) ? fB[r >> 1].z : fB[r >> 1].x, fy = (r & 1) ? fB[r >> 1].w : fB[r >> 1].y; const vf2 t = v[r]; v[r] = (vf2){t.x * fx - t.y * fy, t.x * fy + t.y * fx}; }
            fft_group<M, 4, true, 0>(v, 0);
#pragma unroll
            for (int r = 0; r < 16; ++r) X[pb2 + r] = v[r]; } }
    __syncthreads();
    fft_pass<M, 4, true, 4>(X, tid_in); __syncthreads(); fft_pass<M, 4, true, 8>(X, tid_in); __syncthreads(); fft_pass<M, M - 12, true, 12>(X, tid_in); __syncthreads();
}

template <int M>
__device__ __forceinline__ void hy_filter_spectra(LAS vf2* X, const int tid_in, const float* hfa, const float* hba, const float* hfb, const float* hbb, vf2* FSa, vf2* FSb) {
    constexpr int N = 1 << M, L = N >> 1;
    int tid = tid_in; asm volatile("" : "+v"(tid));
    { float va[N / NTHR], vb[N / NTHR];
#pragma unroll
        for (int j = 0; j < N / NTHR; ++j) { const int i = tid + NTHR * j; if (i < L) { va[j] = hfa[i]; vb[j] = hfb[i]; } else if (i == L) { va[j] = 0.f; vb[j] = 0.f; } else { va[j] = hba[N - i]; vb[j] = hbb[N - i]; } }
#pragma unroll
        for (int j = 0; j < N / NTHR; ++j) { const int i = tid + NTHR * j; X[i + (i >> 4)] = (vf2){va[j], vb[j]}; } }
    __syncthreads();
    fft_fwd<M>(X, tid);
    constexpr float sc = 0.5f / (float)N;
#pragma unroll 8
    for (int p = tid; p < N; p += NTHR) { const int k = (int)(__builtin_bitreverse32((unsigned)p) >> (32 - M)), kq = (N - k) & (N - 1), q = (int)(__builtin_bitreverse32((unsigned)kq) >> (32 - M));
        const vf2 zp = X[p + (p >> 4)], zq = X[q + (q >> 4)];
        FSa[p] = (vf2){(zp.x + zq.x) * sc, (zp.y - zq.y) * sc};
        FSb[p] = (vf2){(zp.y + zq.y) * sc, (zq.x - zp.x) * sc}; }
    __syncthreads();
}
template <int M, int NPAIR>
__device__ __forceinline__ void hy_fft_pairs(LAS vf2* X, const int tid_in, bf16_t* sA, const vf2* FSa, const vf2* FSb, const float fba, const float fbb) {
    constexpr int N = 1 << M, L = N >> 1, NCH = L / 8 / NTHR;
    vu4 nin0[NCH], nin1[NCH];
#define HYP_SEQ(q_, k_) (sA + (size_t)((q_) / NPAIR) * L + (size_t)(2 * ((q_) % NPAIR) + (k_)) * L * DM)
    { int tid = tid_in; asm volatile("" : "+v"(tid));
#pragma unroll
        for (int j = 0; j < NCH; ++j) { const int c = tid + NTHR * j; nin0[j] = ((const vu4*)HYP_SEQ(0, 0))[(unsigned)c]; nin1[j] = ((const vu4*)HYP_SEQ(0, 1))[(unsigned)c]; } }
#pragma unroll 1
    for (int q = 0; q < 2 * NPAIR; ++q) {
        int tid = tid_in; asm volatile("" : "+v"(tid));
        bf16_t* s0 = HYP_SEQ(q, 0); bf16_t* s1 = HYP_SEQ(q, 1);
        const vf2* FS = q < NPAIR ? FSa : FSb; const float fbias = q < NPAIR ? fba : fbb;
        vu4 in0[NCH], in1[NCH];
#pragma unroll
        for (int j = 0; j < NCH; ++j) { in0[j] = nin0[j]; in1[j] = nin1[j]; }
#pragma unroll 8
        for (int i = L + tid; i < N; i += NTHR) X[i + (i >> 4)] = (vf2){0.f, 0.f};
#pragma unroll
        for (int j = 0; j < NCH; ++j) { const int c = tid + NTHR * j; float f0[8], f1[8]; unpack8(in0[j], f0); unpack8(in1[j], f1);
#pragma unroll
            for (int e = 0; e < 8; ++e) { const int i = c * 8 + e; X[i + (i >> 4)] = (vf2){f0[e], f1[e]}; } }
        if (q + 1 < 2 * NPAIR) {
#pragma unroll
            for (int j = 0; j < NCH; ++j) { const int c = tid + NTHR * j; nin0[j] = ((const vu4*)HYP_SEQ(q + 1, 0))[(unsigned)c]; nin1[j] = ((const vu4*)HYP_SEQ(q + 1, 1))[(unsigned)c]; } }
        __syncthreads();
        fft_conv<M>(X, tid, FS);
#pragma unroll
        for (int j = 0; j < NCH; ++j) { const int c = tid + NTHR * j; float f0[8], f1[8], o0[8], o1[8]; unpack8(in0[j], f0); unpack8(in1[j], f1);
#pragma unroll
            for (int e = 0; e < 8; ++e) { const int i = c * 8 + e; const vf2 t = X[i + (i >> 4)]; o0[e] = t.x + f0[e] * fbias; o1[e] = t.y + f1[e] * fbias; }
            ((vu4*)s0)[(unsigned)c] = pack8(o0); ((vu4*)s1)[(unsigned)c] = pack8(o1); }
        __syncthreads();
    }
}
__device__ __forceinline__ void ph_hy_fft(lds_u8* lds, bf16_t* sT, const float* hf8, const float* hb8, const float* hf4, const float* hb4, vf2* FSall, const float* fbias) {
    LAS vf2* X = (LAS vf2*)lds;
    const int tid = threadIdx.x;
    vf2* FSa = FSall + (size_t)blockIdx.x * 32768; vf2* FSb = FSa + 16384;
    for (int cp = blockIdx.x; cp < DM / 2; cp += gridDim.x) {
        const int ca = 2 * cp, cb = ca + 1; const float fba = fbias[ca], fbb = fbias[cb];
        hy_filter_spectra<14>(X, tid, hf8 + (size_t)ca * 8192, hb8 + (size_t)ca * 8192, hf8 + (size_t)cb * 8192, hb8 + (size_t)cb * 8192, FSa, FSb);
        hy_fft_pairs<14, 2>(X, tid, sT + (size_t)ca * 8192, FSa, FSb, fba, fbb);
        hy_filter_spectra<13>(X, tid, hf4 + (size_t)ca * 4096, hb4 + (size_t)ca * 4096, hf4 + (size_t)cb * 4096, hb4 + (size_t)cb * 4096, FSa, FSb);
        hy_fft_pairs<13, 1>(X, tid, sT + (size_t)32768 * DM + (size_t)ca * 4096, FSa, FSb, fba, fbb);
    }
}
__device__ __forceinline__ void ph_hy_post(const Args& a, lds_u8* lds, const bf16_t* proj, const bf16_t* sT, bf16_t* Yo) {
    LAS float* tile = (LAS float*)lds;
    const int tid = threadIdx.x;
    const float* cw = ARG_IN(35);
    for (int u = blockIdx.x; u < 640 * 8; u += gridDim.x) {
        const int tt = u >> 3, ct = u & 7, row_t0 = tt * 64, c0 = ct * 256;
        const int s = seq_of_row(row_t0), L = seq_len(s), rs = seq_start(s), t0 = row_t0 - rs;
        { const int c = tid >> 1, th = (tid & 1) * 32; const bf16_t* src = sT + (size_t)rs * DM + (size_t)(c0 + c) * L + t0 + th;
            vu4 w[4];
#pragma unroll
            for (int k = 0; k < 4; ++k) w[k] = *(const vu4*)(src + k * 8);
#pragma unroll
            for (int k = 0; k < 4; ++k) { float o[8]; unpack8(w[k], o);
#pragma unroll
                for (int j = 0; j < 8; ++j) tile[c * 65 + th + k * 8 + j] = o[j]; } }
        LDS_SYNC();
        { const int t = tid >> 3, c8s = (tid & 7) * 8;
#pragma unroll
            for (int q = 0; q < 4; ++q) { float x0[8], o[8]; const int cc = c0 + q * 64 + c8s;
#pragma unroll
                for (int j = 0; j < 8; ++j) x0[j] = 0.f;
#pragma unroll
                for (int tap = 0; tap < 3; ++tap) { const int tq = t0 + t + tap - 1;
                    if (tq >= 0 && tq < L) { float r0[8], w0[8]; unpack8(*(const vu4*)(proj + (size_t)(rs + tq) * HY_LD + cc), r0); load8f(cw + tap * 6144 + cc, w0);
#pragma unroll
                        for (int j = 0; j < 8; ++j) x0[j] += w0[j] * r0[j]; } }
#pragma unroll
                for (int j = 0; j < 8; ++j) o[j] = tile[(q * 64 + c8s + j) * 65 + t] * x0[j];
                *(vu4*)(Yo + (size_t)(row_t0 + t) * DM + cc) = pack8(o); } }
        LDS_SYNC();
    }
}

#ifndef MK_PER_PHASE
#define MK_PER_PHASE 0
#endif
constexpr int N_PHASES = 37;

template <class Epi>
__device__ __forceinline__ void run_gemm(lds_u8* lds, const bf16_t* A, const bf16_t* Bt, int N, int K, const Epi& E) {
    pg8::Gemm g{A, Bt, NTOK, N, K, K, K}; pg8::StaticOrder S; S.init(NTOK, N, (int)gridDim.x, (int)blockIdx.x);
    pg8::gemm_phase<Epi, pg8::StaticOrder, true, true>(lds, g, S, E);
}

__global__ void __launch_bounds__(512, 2) mega_fwd(const Args args) {
    extern __shared__ __attribute__((aligned(16))) unsigned char shm[];
    lds_u8* lds = (lds_u8*)shm;
    const int lo = args.ph_lo, hi = args.ph_hi;
    XcdBarrier bar; bar.bar = (unsigned*)(args.ws + WS_BAR); bar.x = 0; bar.st = nullptr;
    if (hi - lo > 1) {
        if (threadIdx.x == 0) *(LAS vu4*)(lds + LDS_BAR_OFF) = (vu4){0u, 0u, 0u, 0u};
        __syncthreads();
        bar = xcd_barrier_post((unsigned*)(args.ws + WS_BAR), (volatile LAS unsigned*)(lds + LDS_BAR_OFF));
    }
#ifdef ONLY_PHASE
#define IN(k) ((k) == ONLY_PHASE && lo <= (k) && (k) < hi)
#else
#define IN(k) (lo <= (k) && (k) < hi)
#endif
#define SEAM(k) do { if (IN((k) + 1)) xcd_barrier(bar); } while (0)
#ifndef DUPMASK
#define DUPMASK 0ull
#endif
#define DUP(k) ((DUPMASK >> (k)) & 1ull)
#define PH(k, ...) if (IN(k)) { __VA_ARGS__ if (DUP(k)) { xcd_barrier(bar); __VA_ARGS__ } SEAM(k); }
#define PHL(k, ...) if (IN(k)) { __VA_ARGS__ }
    unsigned char* ws = args.ws;
    float* X = args.out;
    bf16_t* XB = (bf16_t*)(ws + WS_ARENA + 928 * MiB);
    float* mod = (float*)(ws + WS_MOD);
    unsigned char* XO = (unsigned char*)args.out;
    bf16_t* S5BY = (bf16_t*)XO; bf16_t* S5BE = (bf16_t*)(XO + 96 * MiB); float* S5LT = (float*)(ws + 3 * MiB);
    float* HF8 = (float*)(XO + 128 * MiB); float* HB8 = (float*)(XO + 192 * MiB); float* HF4 = (float*)(XO + 256 * MiB); float* HB4 = (float*)(XO + 288 * MiB);
    bf16_t* H = (bf16_t*)(ws + WS_H); bf16_t* HO = (bf16_t*)(ws + WS_HO);
    bf16_t* Wgu = (bf16_t*)(ws + WS_W + W_GU); bf16_t* Wdn = (bf16_t*)(ws + WS_W + W_DN); bf16_t* Wmi = (bf16_t*)(ws + WS_W + W_MIN); bf16_t* Wmo = (bf16_t*)(ws + WS_W + W_MOUT);
    unsigned char* AR = ws + WS_ARENA;
    bf16_t* ACT = (bf16_t*)AR;
    const float* ng = ARG_IN(6);
#define MODL(layer, k) (mod + (size_t)(layer) * 6 * 12288 + (size_t)(k) * 2048)
#define NG(layer, k) (ng + ((layer) * 4 + (k)) * 2048)

    PH(0, ph_ada(args, lds, 0, 192, (int)blockIdx.x, (int)gridDim.x); __syncthreads();
        ph_hy_fwoT(ARG_IN(42), (bf16_t*)(ws + 2 * MiB));
        cvt_wT(ARG_IN(10), DM, 8256, Wmi, 0, lds); cvt_wT(ARG_IN(15), DM, DM, Wmo, 0, lds);)
    PH(1, ph_row<false, false>(ARG_IN(0), ARG_IN(1), nullptr, nullptr, nullptr, nullptr, NG(0, 0), MODL(0, 0), H);)
    bf16_t* DNP = (bf16_t*)AR; bf16_t* DNXT = (bf16_t*)(AR + 180 * MiB); bf16_t* DNO = (bf16_t*)(AR + 660 * MiB);
    bf16_t* DNHALO = (bf16_t*)(AR + 820 * MiB);
    PH(2, run_gemm(lds, H, Wmi, DN_LD, DM, pg8::EpiStoreTiled{DNP, DN_LD2, DNXT, DNHALO, 0, (bf16_t*)(AR + 850 * MiB), 8192, 64});
        if (blockIdx.x >= 160) { __syncthreads(); cvt_ffn_part(args, 0, lds, (int)blockIdx.x - 160, 96, nullptr, false); })
    PH(3, ph_conv_inplace(lds, DNXT, ARG_IN(11), DNHALO, 1);)
    PH(4, ph_dn_core2(args, lds, (const bf16_t*)(AR + 850 * MiB), DNXT, H, HO);
        if (blockIdx.x >= 192) { __syncthreads(); cvt_ffn_part(args, 0, lds, (int)blockIdx.x - 192, 64, nullptr, true); __syncthreads(); ph_s5_tables(args, lds, S5BY, S5BE, S5LT, (int)blockIdx.x - 192, 64); __syncthreads();
            ph_hy_filter(args, lds, (const bf16_t*)(ws + 2 * MiB), HF8, HB8, HF4, HB4, (int)blockIdx.x - 192, 64); __syncthreads(); cvt_wT(ARG_IN(26), DM, 10368, Wmi, 0, lds, (int)blockIdx.x - 192, 64); }
        else if (blockIdx.x >= 128) { __syncthreads(); ph_ada(args, lds, 192, 768, (int)blockIdx.x - 128, 64); })
    PH(5, ph_dn_combine(args, H, HO, DNP, DNO);)
    PH(6, run_gemm(lds, DNO, Wmo, DM, DM, pg8::EpiStoreT<false>{HO, DM, nullptr});)
    PH(7, ph_row<false, true>(ARG_IN(0), ARG_IN(1), (float*)XB, HO, NG(0, 1), MODL(0, 2), NG(0, 2), MODL(0, 3), H);)
    PH(8, run_gemm(lds, H, Wgu, 2 * DFF, DM, pg8::EpiSwiGLU{ACT, DFF}); if (blockIdx.x >= 128) { __syncthreads(); cvt_wT(ARG_IN(24), DM, DM, Wmo, 0, lds, (int)blockIdx.x - 128, 128); __syncthreads(); cvt_ffn_part(args, 1, lds, (int)blockIdx.x - 128, 128, AR + 856 * MiB, false); } else { __syncthreads(); cvt_ffn_part(args, 1, lds, (int)blockIdx.x, 128, AR + 856 * MiB, true); })
    PH(9, run_gemm(lds, ACT, Wdn, DM, DFF, pg8::EpiStoreT<false>{HO, DM, nullptr});)
    bf16_t* S5UG = (bf16_t*)AR; float* S5E = (float*)(AR + 368 * MiB);
    PH(10, ph_row<true, true>((const float*)XB, nullptr, (float*)XB, HO, NG(0, 3), MODL(0, 5), NG(1, 0), MODL(1, 0), nullptr, S5UG);
        )
    PH(11, run_gemm_s5(lds, S5UG, S5BE, 1, 512, 512, EpiS5E{S5E});)
    PH(12, ph_s5_scan(S5E, S5LT, S5UG);)
    PH(13, run_gemm_s5(lds, S5UG, S5BY, 2, 768, 768, EpiS5Y{H});)
    PH(14, run_gemm(lds, H, Wmo, DM, DM, pg8::EpiGLU{HO, DM, ARG_IN(25), H});)
    PH(15, ph_row<true, true>((const float*)XB, nullptr, (float*)XB, HO, NG(1, 1), MODL(1, 2), NG(1, 2), MODL(1, 3), H);)
    PH(16, run_gemm(lds, H, (const bf16_t*)(AR + 856 * MiB), 2 * DFF, DM, pg8::EpiSwiGLU{ACT, DFF}); if (blockIdx.x >= 128) { __syncthreads(); cvt_wT(ARG_IN(32), 4096, DM, Wmo, 0, lds, (int)blockIdx.x - 128, 128, ARG_IN(31)); __syncthreads(); cvt_ffn_part(args, 2, lds, (int)blockIdx.x - 128, 128, nullptr, false); } else { __syncthreads(); cvt_ffn_part(args, 2, lds, (int)blockIdx.x, 128, nullptr, true); })
    PH(17, run_gemm(lds, ACT, (const bf16_t*)(AR + 900 * MiB), DM, DFF, pg8::EpiStoreT<false>{HO, DM, nullptr});)
    PH(18, ph_row<true, true>((const float*)XB, nullptr, (float*)XB, HO, NG(1, 3), MODL(1, 5), NG(2, 0), MODL(2, 0), H);)
    bf16_t* SSP = (bf16_t*)AR; bf16_t* SSY = (bf16_t*)(ws + WS_H);
    bf16_t* HO2 = (bf16_t*)AR;
    bf16_t* SSHALO = (bf16_t*)(AR + 820 * MiB);
    bf16_t* SSXT = (bf16_t*)(AR + 340 * MiB);
    PH(19, run_gemm(lds, H, Wmi, SSD_LD, DM, pg8::EpiStoreTiled{SSP, SSD_LD2, SSXT, SSHALO, 4096, (bf16_t*)(AR + 850 * MiB), 10240, 128});)
    PH(20, ph_conv_inplace(lds, SSXT, ARG_IN(27), SSHALO, 0);)
#define SSD_ARGS (args, lds, (const bf16_t*)(AR + 850 * MiB), SSXT, SSY, (bf16_t*)(AR + 862 * MiB))
#ifdef SSD_PROBE
#define SSD_RUN { int nrep = 2; asm volatile("" : "+s"(nrep)); for (int rep = 0; rep < nrep; ++rep) { ph_ssd_core3<0> SSD_ARGS; if (rep + 1 < nrep) xcd_barrier(bar); } }
#else
#define SSD_RUN ph_ssd_core3<0> SSD_ARGS;
#endif
    PH(21, SSD_RUN)
    PH(22, ph_ssd_combine(args, SSY, SSP, (const bf16_t*)(AR + 862 * MiB));)
    PH(23, run_gemm(lds, SSY, Wmo, DM, 4096, pg8::EpiStoreT<false>{HO2, DM, nullptr});)
    PH(24, ph_row<true, true>((const float*)XB, nullptr, (float*)XB, HO2, NG(2, 1), MODL(2, 2), NG(2, 2), MODL(2, 3), H);)
    PH(25, run_gemm(lds, H, Wgu, 2 * DFF, DM, pg8::EpiSwiGLU{ACT, DFF}); if (blockIdx.x >= 128) { __syncthreads(); cvt_wT(ARG_IN(33), DM, 6144, Wmi, 0, lds, (int)blockIdx.x - 128, 128); cvt_wT(ARG_IN(45), DM, DM, Wmo, 0, lds, (int)blockIdx.x - 128, 128); __syncthreads(); cvt_ffn_part(args, 3, lds, (int)blockIdx.x - 128, 128, AR + 856 * MiB, false); } else { __syncthreads(); cvt_ffn_part(args, 3, lds, (int)blockIdx.x, 128, AR + 856 * MiB, true); })
    PH(26, run_gemm(lds, ACT, Wdn, DM, DFF, pg8::EpiStoreT<false>{HO, DM, nullptr});)
    PH(27, ph_row<true, true>((const float*)XB, nullptr, (float*)XB, HO, NG(2, 3), MODL(2, 5), NG(3, 0), MODL(3, 0), H);)
    bf16_t* HYP = (bf16_t*)AR; bf16_t* HYS = (bf16_t*)(AR + 480 * MiB);
    PH(28, run_gemm(lds, H, Wmi, HY_LD, DM, pg8::EpiStoreT<true>{HYP, HY_LD, ARG_IN(34)});)
    PH(29, ph_hy_prep(args, lds, HYP, HYS);)
    PH(30, ph_hy_fft(lds, HYS, HF8, HB8, HF4, HB4, (vf2*)(ws + WS_HO + 64 * MiB), ARG_IN(44));
        if (DUPMASK >> 63) { xcd_barrier(bar); ph_hy_prep(args, lds, HYP, HYS); xcd_barrier(bar); ph_hy_fft(lds, HYS, HF8, HB8, HF4, HB4, (vf2*)(ws + WS_HO + 64 * MiB), ARG_IN(44)); })
    PH(31, ph_hy_post(args, lds, HYP, HYS, H);)
    PH(32, run_gemm(lds, H, Wmo, DM, DM, pg8::EpiStoreT<true>{HO, DM, ARG_IN(46)});)
    PH(33, ph_row<true, true>((const float*)XB, nullptr, (float*)XB, HO, NG(3, 1), MODL(3, 2), NG(3, 2), MODL(3, 3), H);)
    PH(34, run_gemm(lds, H, (const bf16_t*)(AR + 856 * MiB), 2 * DFF, DM, pg8::EpiSwiGLU{ACT, DFF});)
    PH(35, run_gemm(lds, ACT, (const bf16_t*)(AR + 900 * MiB), DM, DFF, pg8::EpiStoreT<false>{HO, DM, nullptr});)
    PHL(36, ph_row<true, false>((const float*)XB, nullptr, X, HO, NG(3, 3), MODL(3, 5), nullptr, nullptr, nullptr);)
#undef IN
#undef SEAM
}

extern "C" void kernel_launch(void* const* d_in, const int* in_sizes, int n_in, void* d_out, int out_size, void* d_ws, size_t ws_size, hipStream_t stream) {
    static int grid = 0;
    if (grid == 0) {
        if (n_in != 47 || out_size != NTOK * DM || ws_size < WS_END) { fprintf(stderr, "kernel_launch: unexpected shapes (n_in %d, out %d, ws %zu); nothing launched\n", n_in, out_size, ws_size); grid = -1; return; }
        int dev = 0, cus = 0, per_cu = 0;
        if (hipGetDevice(&dev) != hipSuccess || hipDeviceGetAttribute(&cus, hipDeviceAttributeMultiprocessorCount, dev) != hipSuccess) { grid = -1; return; }
        if (hipFuncSetAttribute((const void*)mega_fwd, hipFuncAttributeMaxDynamicSharedMemorySize, LDS_BYTES) != hipSuccess) { fprintf(stderr, "kernel_launch: hipFuncSetAttribute failed\n"); grid = -1; return; }
        if (hipOccupancyMaxActiveBlocksPerMultiprocessor(&per_cu, (const void*)mega_fwd, NTHR, LDS_BYTES) != hipSuccess || per_cu < 1) { fprintf(stderr, "kernel_launch: occupancy query reports %d blocks per CU\n", per_cu); }
        (void)hipGetLastError();
        grid = cus;
    }
    if (grid < 0) return;
    (void)hipMemsetAsync((char*)d_ws + WS_BAR, 0, XCD_BAR_WORDS * sizeof(unsigned), stream);
    Args a{};
    for (int i = 0; i < 47; ++i) a.in[i] = (const float*)d_in[i];
    a.out = (float*)d_out; a.ws = (unsigned char*)d_ws;
#if MK_PER_PHASE
    for (int p = 0; p < N_PHASES; ++p) { a.ph_lo = p; a.ph_hi = p + 1; hipLaunchKernelGGL(mega_fwd, dim3(grid), dim3(NTHR), LDS_BYTES, stream, a); }
#else
    a.ph_lo = 0; a.ph_hi = N_PHASES;
    hipLaunchKernelGGL(mega_fwd, dim3(grid), dim3(NTHR), LDS_BYTES, stream, a);
#endif
}
```

```cpp
#define MK_PER_PHASE 0
#define DUPMASK 0ull
#include <hip/hip_runtime.h>
#include <cstdio>
#include <cstdint>
namespace pg8 {
#define PG8_LAS __attribute__((address_space(3)))
typedef unsigned short bf16_t;
typedef short bf16x8 __attribute__((ext_vector_type(8)));
typedef float f32x4 __attribute__((ext_vector_type(4)));
typedef unsigned u32x4 __attribute__((ext_vector_type(4)));
constexpr int BM = 256, BK = 64, HALF = 128, HTB = HALF * BK * 2  , STAGE_BYTES = 8 * HTB, NXCD = 8, WGM = 4;

__host__ __device__ __forceinline__ int lds_byte(int r, int c) { const int st = (r >> 4) * 2 + (c >> 5), rr = r & 15, cc = c & 31, ob = rr * 64 + cc * 2; return st * 1024 + (ob ^ (((ob >> 9) & 1) << 5)); }
__host__ __device__ __forceinline__ void stage_rc(int b, int& R, int& C) { const int st = b / 1024, sb = b % 1024, swz = sb ^ (((sb >> 9) & 1) << 5); R = (st >> 1) * 16 + swz / 64; C = (st & 1) * 32 + (swz % 64) / 2; }
__host__ __device__ __forceinline__ int perm32(int rho) { const int n = rho >> 4, i = rho & 15; return 8 * (i >> 2) + 4 * n + (i & 3); }

struct Unit { int pm, pn; };
struct Gemm { const bf16_t* A; const bf16_t* Bt; int M, N, K, lda, ldb; };

struct StaticOrder {
    int nM, nN, nwg, G, c;
    __host__ __device__ void init(int M, int N, int G_, int c_) { nM = M / BM; nN = N / BM; nwg = nM * nN; G = G_; c = c_; }
    __host__ __device__ bool next(int i, Unit& u) const {
        const long L = (long)i * G + c; if (L >= nwg) return false;
        int wgid = (int)L; { const int q = nwg / NXCD, r = nwg % NXCD, xcd = wgid % NXCD, off = wgid / NXCD; wgid = (xcd < r ? xcd * (q + 1) : r * (q + 1) + (xcd - r) * q) + off; }
        const int nig = WGM * nN, gid = wgid / nig, fm = gid * WGM, gsz = (nM - fm) < WGM ? (nM - fm) : WGM;
        u.pm = fm + ((wgid % nig) % gsz); u.pn = (wgid % nig) / gsz; return true;
    }
    __device__ __forceinline__ void a_ready(const Unit&) const {}
    __device__ __forceinline__ void done(const Unit&) const {}
};
typedef __bf16 bf16x2_cv __attribute__((ext_vector_type(2)));
typedef float f32x2_cv __attribute__((ext_vector_type(2)));
__device__ __forceinline__ unsigned cvt_pk_bf16(float lo, float hi) { const bf16x2_cv v = __builtin_convertvector((f32x2_cv){lo, hi}, bf16x2_cv); return __builtin_bit_cast(unsigned, v); }
__device__ __forceinline__ float sigmoid_f(float x) { return __builtin_amdgcn_rcpf(1.0f + __expf(-x)); }

template <bool BIAS> struct EpiStoreT {
    static constexpr bool PERM = true, AFTER_DRAIN = false;
    bf16_t* O; int ldc; const float* bias;
    __device__ __forceinline__ void operator()(const f32x4 (&acc)[2][2][4][2], const Unit& u, int wr, int wc, int fr, int fq) const {
        const int row0 = u.pm * BM + wr * 64 + fr; const int col0 = u.pn * BM + wc * 32 + 8 * fq;
        f32x4 bv[2][2];
        if (BIAS) {
#pragma unroll
            for (int bj = 0; bj < 2; ++bj)
#pragma unroll
                for (int n = 0; n < 2; ++n) bv[bj][n] = *(const f32x4*)(bias + col0 + bj * HALF + 4 * n); }
#pragma unroll
        for (int ai = 0; ai < 2; ++ai)
#pragma unroll
            for (int m = 0; m < 4; ++m) { bf16_t* rowp = O + (size_t)(row0 + ai * HALF + m * 16) * ldc + col0;
#pragma unroll
                for (int bj = 0; bj < 2; ++bj) { f32x4 v0 = acc[ai][bj][m][0], v1 = acc[ai][bj][m][1]; if (BIAS) { v0 = v0 + bv[bj][0]; v1 = v1 + bv[bj][1]; }
                    u32x4 w; w.x = cvt_pk_bf16(v0[0], v0[1]); w.y = cvt_pk_bf16(v0[2], v0[3]); w.z = cvt_pk_bf16(v1[0], v1[1]); w.w = cvt_pk_bf16(v1[2], v1[3]);
                    *(u32x4*)(rowp + bj * HALF) = w; } }
    }
};
struct EpiSwiGLU {
    static constexpr bool PERM = true, AFTER_DRAIN = false;
    bf16_t* O; int ldc;
    __device__ __forceinline__ void operator()(const f32x4 (&acc)[2][2][4][2], const Unit& u, int wr, int wc, int fr, int fq) const {
        const int row0 = u.pm * BM + wr * 64 + fr; const int col0 = u.pn * HALF + wc * 32 + 8 * fq;
#pragma unroll
        for (int ai = 0; ai < 2; ++ai)
#pragma unroll
            for (int m = 0; m < 4; ++m) { bf16_t* rowp = O + (size_t)(row0 + ai * HALF + m * 16) * ldc + col0;
                float o[8];
#pragma unroll
                for (int n = 0; n < 2; ++n)
#pragma unroll
                    for (int j = 0; j < 4; ++j) { const float g = acc[ai][0][m][n][j], up = acc[ai][1][m][n][j]; o[n * 4 + j] = g * sigmoid_f(g) * up; }
                u32x4 w; w.x = cvt_pk_bf16(o[0], o[1]); w.y = cvt_pk_bf16(o[2], o[3]); w.z = cvt_pk_bf16(o[4], o[5]); w.w = cvt_pk_bf16(o[6], o[7]);
                *(u32x4*)rowp = w; }
    }
};
struct EpiGLU {
    static constexpr bool PERM = true, AFTER_DRAIN = false;
    bf16_t* O; int ldc; const float* bias; const bf16_t* Y;
    __device__ __forceinline__ void operator()(const f32x4 (&acc)[2][2][4][2], const Unit& u, int wr, int wc, int fr, int fq) const {
        const int row0 = u.pm * BM + wr * 64 + fr; const int col0 = u.pn * BM + wc * 32 + 8 * fq;
        f32x4 bv[2][2];
#pragma unroll
        for (int bj = 0; bj < 2; ++bj)
#pragma unroll
            for (int n = 0; n < 2; ++n) bv[bj][n] = *(const f32x4*)(bias + col0 + bj * HALF + 4 * n);
#pragma unroll
        for (int ai = 0; ai < 2; ++ai)
#pragma unroll
            for (int m = 0; m < 4; ++m) { const size_t ro = (size_t)(row0 + ai * HALF + m * 16) * ldc + col0;
#pragma unroll
                for (int bj = 0; bj < 2; ++bj) { f32x4 v0 = acc[ai][bj][m][0] + bv[bj][0], v1 = acc[ai][bj][m][1] + bv[bj][1];
                    const u32x4 yw = *(const u32x4*)(Y + ro + bj * HALF);
                    float o[8];
                    o[0] = __uint_as_float(yw.x << 16) * sigmoid_f(v0[0]); o[1] = __uint_as_float(yw.x & 0xffff0000u) * sigmoid_f(v0[1]);
                    o[2] = __uint_as_float(yw.y << 16) * sigmoid_f(v0[2]); o[3] = __uint_as_float(yw.y & 0xffff0000u) * sigmoid_f(v0[3]);
                    o[4] = __uint_as_float(yw.z << 16) * sigmoid_f(v1[0]); o[5] = __uint_as_float(yw.z & 0xffff0000u) * sigmoid_f(v1[1]);
                    o[6] = __uint_as_float(yw.w << 16) * sigmoid_f(v1[2]); o[7] = __uint_as_float(yw.w & 0xffff0000u) * sigmoid_f(v1[3]);
                    u32x4 w; w.x = cvt_pk_bf16(o[0], o[1]); w.y = cvt_pk_bf16(o[2], o[3]); w.z = cvt_pk_bf16(o[4], o[5]); w.w = cvt_pk_bf16(o[6], o[7]);
                    *(u32x4*)(O + ro + bj * HALF) = w; } }
    }
};
struct EpiStoreTiled {
    static constexpr bool PERM = true, AFTER_DRAIN = false;
    bf16_t* O; int ldo; bf16_t* XT; bf16_t* halo; int c0; bf16_t* GT; int g0, gn;
    __device__ __forceinline__ void operator()(const f32x4 (&acc)[2][2][4][2], const Unit& u, int wr, int wc, int fr, int fq) const {
        const int row0 = u.pm * BM + wr * 64 + fr; const int col0 = u.pn * BM + wc * 32 + 8 * fq;
#pragma unroll
        for (int ai = 0; ai < 2; ++ai)
#pragma unroll
            for (int m = 0; m < 4; ++m) { const int row = row0 + ai * HALF + m * 16;
                const bool edge = (m == 0 && fr < 2) || (m == 3 && fr >= 14); const int slot = (m == 0) ? fr : fr - 12;
#pragma unroll
                for (int bj = 0; bj < 2; ++bj) { const f32x4 v0 = acc[ai][bj][m][0], v1 = acc[ai][bj][m][1];
                    u32x4 w; w.x = cvt_pk_bf16(v0[0], v0[1]); w.y = cvt_pk_bf16(v0[2], v0[3]); w.z = cvt_pk_bf16(v1[0], v1[1]); w.w = cvt_pk_bf16(v1[2], v1[3]);
                    const int col = col0 + bj * HALF, hc = col - c0;
                    if (hc >= 0 && hc < 6144) { *(u32x4*)(XT + (((size_t)(row >> 6) * 768 + (hc >> 3)) * 64 + (row & 63)) * 8) = w;
                        if (edge) *(u32x4*)(halo + ((size_t)(row >> 6) * 4 + slot) * 6144 + hc) = w; }
                    else { *(u32x4*)(O + (size_t)row * ldo + (hc < 0 ? col : col - 6144)) = w;
                        const int gc = col - g0;
                        if (gc >= 0 && gc < gn) { bf16_t* gp = GT + ((size_t)(row >> 6) * gn + gc) * 64 + (row & 63);
                            gp[0] = (bf16_t)(w.x & 0xffffu); gp[64] = (bf16_t)(w.x >> 16); gp[128] = (bf16_t)(w.y & 0xffffu); gp[192] = (bf16_t)(w.y >> 16);
                            gp[256] = (bf16_t)(w.z & 0xffffu); gp[320] = (bf16_t)(w.z >> 16); gp[384] = (bf16_t)(w.w & 0xffffu); gp[448] = (bf16_t)(w.w >> 16); } } } }
    }
};
template <class Epi, class Sched, bool ALIGN_EPI = false, bool SP2 = false>
__device__ __forceinline__ void gemm_phase(PG8_LAS unsigned char* lds, const Gemm g, const Sched& S, const Epi& E) {
    const int tid = threadIdx.x, wid = __builtin_amdgcn_readfirstlane(tid >> 6), lane = tid & 63, wr = wid >> 2, wc = wid & 3, fr = lane & 15, fq = lane >> 4;
    const int K = g.K, nt = K / BK;
    unsigned voffA[2], voffB[2];
#pragma unroll
    for (int i = 0; i < 2; ++i) { int R, C; stage_rc(tid * 16 + i * 8192, R, C); const int Rb = Epi::PERM ? ((R & ~31) + perm32(R & 31)) : R;
        voffA[i] = (unsigned)(R * g.lda + C) * 2u; voffB[i] = (unsigned)(Rb * g.ldb + C) * 2u; }
    const size_t kstep = (size_t)(BK * 2);
    const size_t hstepA = (size_t)HALF * g.lda * 2, hstepB = (size_t)HALF * g.ldb * 2;
    const size_t tstepA = 2 * hstepA, tstepB = 2 * hstepB;
    const unsigned ldsw = (unsigned)wid * 1024u;
    const int aoff = lds_byte(wr * 64 + fr, fq * 8), boff = lds_byte(wc * 32 + fr, fq * 8);
#define PG8_SA(b, h) (((b) * 2 + (h)) * HTB)
#define PG8_SB(b, h) ((4 + (b) * 2 + (h)) * HTB)
#define PG8_STAGE(bufoff, gbase, voff) do { _Pragma("unroll") for (int _i = 0; _i < 2; ++_i) \
        __builtin_amdgcn_global_load_lds((const unsigned*)((const char*)(gbase) + (voff)[_i]), (PG8_LAS unsigned*)(lds + (bufoff) + ldsw + _i * 8192), 16, 0, 0); } while (0)
#define PG8_LDA(dst, b, h) do { _Pragma("unroll") for (int m = 0; m < 4; ++m) _Pragma("unroll") for (int k = 0; k < 2; ++k) dst[m][k] = *(const PG8_LAS bf16x8*)(lds + PG8_SA(b, h) + aoff + m * 2048 + k * 1024); } while (0)
#define PG8_LDB(dst, b, h) do { _Pragma("unroll") for (int n = 0; n < 2; ++n) _Pragma("unroll") for (int k = 0; k < 2; ++k) dst[n][k] = *(const PG8_LAS bf16x8*)(lds + PG8_SB(b, h) + boff + n * 2048 + k * 1024); } while (0)
#define PG8_MMA(ai, bj, At, Bt) do { __builtin_amdgcn_s_setprio(1); _Pragma("unroll") for (int m = 0; m < 4; ++m) _Pragma("unroll") for (int n = 0; n < 2; ++n) _Pragma("unroll") for (int k = 0; k < 2; ++k) \
        acc[ai][bj][m][n] = __builtin_amdgcn_mfma_f32_16x16x32_bf16(Bt[n][k], At[m][k], acc[ai][bj][m][n], 0, 0, 0); __builtin_amdgcn_s_setprio(0); } while (0)
#define PG8_WAIT_V(n) asm volatile("s_waitcnt vmcnt(" #n ")" ::: "memory")
#define PG8_WAIT_L(n) asm volatile("s_waitcnt lgkmcnt(" #n ")" ::: "memory")
#define PG8_BAR __builtin_amdgcn_s_barrier()
#define PG8_SCHED __builtin_amdgcn_sched_barrier(0)
    Unit cur, nxt; int ui = 0;
    if (!S.next(0, cur)) return;
    f32x4 acc[2][2][4][2];
#pragma unroll
    for (int a = 0; a < 2; ++a)
#pragma unroll
        for (int b = 0; b < 2; ++b)
#pragma unroll
            for (int m = 0; m < 4; ++m)
#pragma unroll
                for (int n = 0; n < 2; ++n) acc[a][b][m][n] = (f32x4){0.f, 0.f, 0.f, 0.f};
    bf16x8 At[4][2], B0[2][2], B1[2][2];
    const char* cA = (const char*)g.A + (size_t)cur.pm * tstepA; const char* cB = (const char*)g.Bt + (size_t)cur.pn * tstepB;
    S.a_ready(cur);
    if constexpr (SP2) {
        PG8_STAGE(PG8_SB(0, 0), cB, voffB); PG8_STAGE(PG8_SB(0, 1), cB + hstepB, voffB); PG8_STAGE(PG8_SA(0, 0), cA, voffA); PG8_STAGE(PG8_SA(0, 1), cA + hstepA, voffA);
        if (wr == 1) PG8_BAR;
        PG8_WAIT_V(2); PG8_BAR;
        PG8_STAGE(PG8_SB(1, 0), cB + kstep, voffB); PG8_STAGE(PG8_SA(1, 0), cA + kstep, voffA); PG8_STAGE(PG8_SB(1, 1), cB + hstepB + kstep, voffB);
        PG8_WAIT_V(6); PG8_BAR;
    } else {
        PG8_STAGE(PG8_SB(0, 0), cB, voffB); PG8_STAGE(PG8_SA(0, 0), cA, voffA); PG8_STAGE(PG8_SB(0, 1), cB + hstepB, voffB); PG8_STAGE(PG8_SA(0, 1), cA + hstepA, voffA);
        if (wr == 1) PG8_BAR;
        PG8_WAIT_V(4); PG8_BAR;
        PG8_STAGE(PG8_SB(1, 0), cB + kstep, voffB); PG8_STAGE(PG8_SA(1, 0), cA + kstep, voffA); PG8_STAGE(PG8_SB(1, 1), cB + hstepB + kstep, voffB);
        PG8_WAIT_V(6); PG8_BAR;
    }
    for (;;) {
        const bool has_next = S.next(ui + 1, nxt);
        const char* nA = has_next ? (const char*)g.A + (size_t)nxt.pm * tstepA : cA; const char* nB = has_next ? (const char*)g.Bt + (size_t)nxt.pn * tstepB : cB;
        for (int t = 0; t < nt; t += 2) {
            const bool last = (t == nt - 2);
            const char* a1 = cA + (size_t)(t + 1) * kstep;
            const char* a2 = last ? nA : cA + (size_t)(t + 2) * kstep; const char* b2 = last ? nB : cB + (size_t)(t + 2) * kstep;
            const char* a3 = a2 + kstep; const char* b3 = b2 + kstep;
            if (last && has_next) S.a_ready(nxt);
            if constexpr (SP2) {
            PG8_LDB(B0, 0, 0); PG8_LDB(B1, 0, 1); PG8_SCHED; PG8_LDA(At, 0, 0); PG8_STAGE(PG8_SA(1, 1), a1 + hstepA, voffA);
            PG8_WAIT_V(8); PG8_WAIT_L(0); PG8_BAR; PG8_MMA(0, 0, At, B0); PG8_MMA(0, 1, At, B1); PG8_BAR; PG8_SCHED;
            PG8_LDA(At, 0, 1); PG8_STAGE(PG8_SB(0, 0), b2, voffB); PG8_STAGE(PG8_SB(0, 1), b2 + hstepB, voffB); PG8_STAGE(PG8_SA(0, 0), a2, voffA);
            PG8_WAIT_V(8); PG8_WAIT_L(0); PG8_BAR; PG8_MMA(1, 0, At, B0); PG8_MMA(1, 1, At, B1); PG8_BAR; PG8_SCHED;
            PG8_LDB(B0, 1, 0); PG8_LDB(B1, 1, 1); PG8_SCHED; PG8_LDA(At, 1, 0); PG8_STAGE(PG8_SA(0, 1), a2 + hstepA, voffA);
            PG8_WAIT_V(8); PG8_WAIT_L(0); PG8_BAR; PG8_MMA(0, 0, At, B0); PG8_MMA(0, 1, At, B1); PG8_BAR; PG8_SCHED;
            PG8_LDA(At, 1, 1); PG8_STAGE(PG8_SB(1, 0), b3, voffB); PG8_STAGE(PG8_SB(1, 1), b3 + hstepB, voffB); PG8_STAGE(PG8_SA(1, 0), a3, voffA);
            PG8_WAIT_V(8); PG8_WAIT_L(0); PG8_BAR; PG8_MMA(1, 0, At, B0); PG8_MMA(1, 1, At, B1); PG8_BAR; PG8_SCHED;
            } else {
            PG8_LDB(B0, 0, 0); PG8_SCHED; PG8_LDA(At, 0, 0); PG8_STAGE(PG8_SA(1, 1), a1 + hstepA, voffA);
            PG8_WAIT_L(8); PG8_BAR; PG8_WAIT_L(0); PG8_MMA(0, 0, At, B0); PG8_BAR; PG8_SCHED;
            PG8_LDB(B1, 0, 1); PG8_STAGE(PG8_SB(0, 0), b2, voffB);
            PG8_BAR; PG8_WAIT_L(0); PG8_MMA(0, 1, At, B1); PG8_BAR;
            PG8_LDA(At, 0, 1); PG8_STAGE(PG8_SA(0, 0), a2, voffA);
            PG8_BAR; PG8_WAIT_L(0); PG8_MMA(1, 0, At, B0); PG8_BAR; PG8_SCHED;
            PG8_STAGE(PG8_SB(0, 1), b2 + hstepB, voffB);
            PG8_WAIT_V(6); PG8_BAR; PG8_MMA(1, 1, At, B1); PG8_BAR;
            PG8_LDB(B0, 1, 0); PG8_SCHED; PG8_LDA(At, 1, 0); PG8_STAGE(PG8_SA(0, 1), a2 + hstepA, voffA);
            PG8_WAIT_L(8); PG8_BAR; PG8_WAIT_L(0); PG8_MMA(0, 0, At, B0); PG8_BAR; PG8_SCHED;
            PG8_LDB(B1, 1, 1); PG8_STAGE(PG8_SB(1, 0), b3, voffB);
            PG8_BAR; PG8_WAIT_L(0); PG8_MMA(0, 1, At, B1); PG8_BAR;
            PG8_LDA(At, 1, 1); PG8_STAGE(PG8_SA(1, 0), a3, voffA);
            PG8_BAR; PG8_WAIT_L(0); PG8_MMA(1, 0, At, B0); PG8_BAR; PG8_SCHED;
            PG8_STAGE(PG8_SB(1, 1), b3 + hstepB, voffB);
            PG8_WAIT_V(6); PG8_BAR; PG8_MMA(1, 1, At, B1); PG8_BAR;
            }
        }
        if constexpr (ALIGN_EPI) { if (wr == 0) PG8_BAR; }
        if constexpr (!Epi::AFTER_DRAIN) { E(acc, cur, wr, wc, fr, fq); S.done(cur); }
        if (!has_next) break;
#pragma unroll
        for (int a = 0; a < 2; ++a)
#pragma unroll
            for (int b = 0; b < 2; ++b)
#pragma unroll
                for (int m = 0; m < 4; ++m)
#pragma unroll
                    for (int n = 0; n < 2; ++n) acc[a][b][m][n] = (f32x4){0.f, 0.f, 0.f, 0.f};
        cur = nxt; cA = nA; cB = nB; ++ui;
        if constexpr (ALIGN_EPI) { if (wr == 1) PG8_BAR; }
    }
    PG8_WAIT_V(0);
    if constexpr (!ALIGN_EPI) { if (wr == 0) PG8_BAR; }
    PG8_BAR;
    if constexpr (Epi::AFTER_DRAIN) { E.fused(acc, cur, wr, wc, fr, fq, lds, wid, lane); S.done(cur); }
#undef PG8_SA
#undef PG8_SB
#undef PG8_STAGE
#undef PG8_LDA
#undef PG8_LDB
#undef PG8_MMA
#undef PG8_WAIT_V
#undef PG8_WAIT_L
#undef PG8_BAR
#undef PG8_SCHED
}
}
#define XB_TMO      128
#define XB_XCNT(j)  (256  + 64 * (j))
#define XB_XSUB(j)  (1280 + 64 * (j))
#define XB_XGEN(j)  (2304 + 64 * (j))
#define XB_TOP      3328
#define XB_TOPGEN   3392
#define XCD_BAR_WORDS 3456
#define XB_SPIN_CAP (1u << 18)
#define LAS __attribute__((address_space(3)))

__device__ __forceinline__ unsigned xb_ld(unsigned* p)              { return __hip_atomic_load(p, __ATOMIC_RELAXED, __HIP_MEMORY_SCOPE_AGENT); }
__device__ __forceinline__ unsigned xb_add(unsigned* p, unsigned v) { return __hip_atomic_fetch_add(p, v, __ATOMIC_RELAXED, __HIP_MEMORY_SCOPE_AGENT); }
__device__ __forceinline__ unsigned xb_xcc_id() { return (unsigned)__builtin_amdgcn_s_getreg((3 << 11) | 20) & 0xFu; }
#define XB_SPIN(cond, bar) do { unsigned _sp = 0; while (cond) { __builtin_amdgcn_s_sleep(1); \
    if ((++_sp & 255u) == 0u) { if (xb_ld(&(bar)[XB_TMO])) break; if (_sp > XB_SPIN_CAP) { atomicAdd(&(bar)[XB_TMO], 1u); break; } } } } while (0)

struct XcdBarrier {
    unsigned* bar; unsigned x;
    volatile LAS unsigned* st;
};

__device__ __forceinline__ XcdBarrier xcd_barrier_post(unsigned* bar, volatile LAS unsigned* st) {
    XcdBarrier b; b.bar = bar; b.x = xb_xcc_id(); b.st = st;
    if (threadIdx.x == 0) (void)xb_add(&bar[XB_XCNT(b.x)], 1u);
    return b;
}
__device__ __forceinline__ void xcd_barrier_complete(unsigned* bar, unsigned x, unsigned& nloc, unsigned& nx) {
    const unsigned G = gridDim.x * gridDim.y * gridDim.z;
    unsigned sum, cnt, mine, sp = 0u;
    for (;;) {
        sum = 0u; cnt = 0u; mine = 0u;
#pragma unroll
        for (unsigned j = 0; j < 16; ++j) { const unsigned c = xb_ld(&bar[XB_XCNT(j)]); sum += c; cnt += (c > 0u) ? 1u : 0u; mine = (j == x) ? c : mine; }
        if (sum == G) break;
        __builtin_amdgcn_s_sleep(1);
        if ((++sp & 255u) == 0u) { if (xb_ld(&bar[XB_TMO])) break; if (sp > XB_SPIN_CAP) { atomicAdd(&bar[XB_TMO], 1u); break; } }
    }
    nloc = mine > 0u ? mine : 1u; nx = cnt > 0u ? cnt : 1u;
}

__device__ __forceinline__ void xcd_barrier(const XcdBarrier& b) {
    asm volatile("s_waitcnt vmcnt(0)" ::: "memory");
    __syncthreads();
    if (threadIdx.x == 0) {
        unsigned* bar = b.bar;
        __builtin_amdgcn_s_waitcnt(0);
        unsigned nloc = b.st[0], nx = b.st[1];
        if (nloc == 0u) { xcd_barrier_complete(bar, b.x, nloc, nx); b.st[0] = nloc; b.st[1] = nx; }
        const unsigned old = xb_add(&bar[XB_XSUB(b.x)], 1u);
        const unsigned gen = old / nloc;
        if (old + 1u == (gen + 1u) * nloc) {
            __builtin_amdgcn_fence(__ATOMIC_RELEASE, "agent");
            asm volatile("s_waitcnt vmcnt(0)" ::: "memory");
            const unsigned og = xb_add(&bar[XB_TOP], 1u);
            const unsigned tg = og / nx;
            if (og + 1u == (tg + 1u) * nx) xb_add(&bar[XB_TOPGEN], 1u);
            else XB_SPIN(xb_ld(&bar[XB_TOPGEN]) == tg, bar);
            __builtin_amdgcn_fence(__ATOMIC_ACQUIRE, "agent");
            xb_add(&bar[XB_XGEN(b.x)], 1u);
            asm volatile("s_waitcnt vmcnt(0)" ::: "memory");
        } else {
            XB_SPIN(xb_ld(&bar[XB_XGEN(b.x)]) == gen, bar);
            __builtin_amdgcn_fence(__ATOMIC_ACQUIRE, "agent");
            asm volatile("s_waitcnt vmcnt(0)" ::: "memory");
        }
    }
    __syncthreads();
}


typedef pg8::bf16_t bf16_t;
typedef float vf4 __attribute__((ext_vector_type(4)));
typedef float vf2 __attribute__((ext_vector_type(2)));
typedef unsigned vu4 __attribute__((ext_vector_type(4)));
typedef LAS unsigned char lds_u8;
constexpr int DM = 2048, NTOK = 40960, DFF = 5632, NTHR = 512;
constexpr float EPSN = 1e-6f;
constexpr int LDS_BYTES = 155648;
constexpr int LDS_BAR_OFF = LDS_BYTES - 16;
constexpr size_t MiB = 1024 * 1024;
constexpr int WQ_WORD = 4096;
constexpr size_t WS_BAR = 0, WS_MOD = 65536;
constexpr size_t WS_H = 4 * MiB, WS_HO = 164 * MiB, WS_W = 324 * MiB, WS_ARENA = 448 * MiB, WS_END = 1536 * MiB;
constexpr size_t W_GU = 0, W_DN = 44 * MiB, W_MIN = 66 * MiB, W_MOUT = 107 * MiB;
constexpr int DN_LD = 8448, DN_LD2 = 2304;
constexpr int SSD_LD = 10496, SSD_LD2 = 4352;

struct Args { const float* in[47]; float* out; unsigned char* ws; int ph_lo, ph_hi; };
__device__ __forceinline__ const float* ARG_IN(int i) {
    const __attribute__((address_space(4))) unsigned char* base = (const __attribute__((address_space(4))) unsigned char*)__builtin_amdgcn_kernarg_segment_ptr();
    asm volatile("" : "+s"(base));
    return *(const float* const __attribute__((address_space(4)))*)(base + 8 * i); }

#define LDS_SYNC() do { asm volatile("s_waitcnt lgkmcnt(0)" ::: "memory"); __builtin_amdgcn_s_barrier(); asm volatile("" ::: "memory"); } while (0)
__device__ __forceinline__ int seq_of_row(int row) { return row < 32768 ? (row >> 13) : 4 + ((row - 32768) >> 12); }
__device__ __forceinline__ int seq_start(int s) { return s < 4 ? s * 8192 : 32768 + (s - 4) * 4096; }
__device__ __forceinline__ int seq_len(int s) { return s < 4 ? 8192 : 4096; }
__device__ __forceinline__ float bf2f(bf16_t b) { return __uint_as_float(((unsigned)b) << 16); }
__device__ __forceinline__ void unpack8(const vu4 w, float (&f)[8]) {
    f[0] = __uint_as_float(w.x << 16); f[1] = __uint_as_float(w.x & 0xffff0000u); f[2] = __uint_as_float(w.y << 16); f[3] = __uint_as_float(w.y & 0xffff0000u);
    f[4] = __uint_as_float(w.z << 16); f[5] = __uint_as_float(w.z & 0xffff0000u); f[6] = __uint_as_float(w.w << 16); f[7] = __uint_as_float(w.w & 0xffff0000u); }
__device__ __forceinline__ vu4 pack8(const float (&f)[8]) { vu4 w; w.x = pg8::cvt_pk_bf16(f[0], f[1]); w.y = pg8::cvt_pk_bf16(f[2], f[3]); w.z = pg8::cvt_pk_bf16(f[4], f[5]); w.w = pg8::cvt_pk_bf16(f[6], f[7]); return w; }

__device__ __forceinline__ float wave_scan_incl(float v) {
#define DPP_ADD(ctrl, rmask) v += __builtin_bit_cast(float, __builtin_amdgcn_update_dpp(0, __builtin_bit_cast(int, v), ctrl, rmask, 0xf, false))
    DPP_ADD(0x111, 0xf); DPP_ADD(0x112, 0xf); DPP_ADD(0x114, 0xf); DPP_ADD(0x118, 0xf); DPP_ADD(0x142, 0xa); DPP_ADD(0x143, 0xc);
#undef DPP_ADD
    return v; }
__device__ __forceinline__ float lane63(float v) { return __builtin_bit_cast(float, __builtin_amdgcn_readlane(__builtin_bit_cast(int, v), 63)); }
__device__ __forceinline__ float wave_sum(float v) { return lane63(wave_scan_incl(v)); }
__device__ __forceinline__ float softplus_fast(float x) { return x > 20.f ? x : __logf(1.0f + __expf(x)); }
__device__ __forceinline__ float silu_f(float x) { return x * __builtin_amdgcn_rcpf(1.0f + __expf(-x)); }
__device__ __forceinline__ float softplus_f(float x) { return x > 20.f ? x : log1pf(__expf(x)); }
__device__ __forceinline__ void load8f(const float* p, float (&f)[8]) { const vf4 a = *(const vf4*)p, b = *(const vf4*)(p + 4); f[0] = a.x; f[1] = a.y; f[2] = a.z; f[3] = a.w; f[4] = b.x; f[5] = b.y; f[6] = b.z; f[7] = b.w; }
__device__ __forceinline__ void store8f(float* p, const float (&f)[8]) { *(vf4*)p = (vf4){f[0], f[1], f[2], f[3]}; *(vf4*)(p + 4) = (vf4){f[4], f[5], f[6], f[7]}; }

__device__ __forceinline__ void ph_ada(const Args& a, lds_u8* lds, int u_lo, int u_hi, int rank, int nrank) {
    LAS float* cact = (LAS float*)lds;
    LAS float* red = cact + 6 * 2048;
    const int tid = threadIdx.x, lane = tid & 63, wave = __builtin_amdgcn_readfirstlane(tid >> 6);
    float* mod = (float*)(a.ws + WS_MOD);
    for (int i = tid; i < 6 * 2048; i += NTHR) { const int b = i >> 11, k = i & 2047; const float c = b < 4 ? ARG_IN(2)[b * 2048 + k] : ARG_IN(3)[(b - 4) * 2048 + k]; cact[i] = c / (1.0f + expf(-c)); }
    LDS_SYNC();
    for (int u = u_lo + rank; u < u_hi; u += nrank) {
        const int layer = u / 192, col0 = (u % 192) * 64;
        const float* W = ARG_IN(4) + (size_t)layer * 2048 * 12288 + col0 + lane;
        float acc[6] = {0.f, 0.f, 0.f, 0.f, 0.f, 0.f};
        const int k0 = wave * 256;
#pragma unroll 1
        for (int k = k0; k < k0 + 256; k += 16) {
            float w[16];
#pragma unroll
            for (int j = 0; j < 16; ++j) w[j] = W[(size_t)(k + j) * 12288];
#pragma unroll
            for (int j4 = 0; j4 < 4; ++j4)
#pragma unroll
                for (int b = 0; b < 6; ++b) { const vf4 c4 = *(const LAS vf4*)(cact + b * 2048 + k + 4 * j4); acc[b] += w[4 * j4] * c4.x + w[4 * j4 + 1] * c4.y + w[4 * j4 + 2] * c4.z + w[4 * j4 + 3] * c4.w; }
        }
#pragma unroll
        for (int b = 0; b < 6; ++b) red[(wave * 6 + b) * 64 + lane] = acc[b];
        LDS_SYNC();
        if (tid < 384) { const int b = tid >> 6; float s = 0.f;
#pragma unroll
            for (int w = 0; w < 8; ++w) s += red[(w * 6 + b) * 64 + lane];
            s += ARG_IN(5)[layer * 12288 + col0 + lane];
            { const int kidx = col0 >> 11, c = (col0 & 2047) + lane; const float* ng = ARG_IN(6) + (size_t)layer * 4 * 2048;
                if (kidx == 1) s = ng[0 * 2048 + c] * (1.0f + s); else if (kidx == 4) s = ng[2 * 2048 + c] * (1.0f + s); else if (kidx == 2) s *= ng[1 * 2048 + c]; else if (kidx == 5) s *= ng[3 * 2048 + c]; }
            mod[(size_t)(layer * 6 + b) * 12288 + col0 + lane] = s; }
        LDS_SYNC();
    }
}

__device__ __forceinline__ void cvt_wT(const float* W, int K, int N, bf16_t* Bt, int mode, lds_u8* lds, int rank = -1, int nrank = 0, const float* rowscale = nullptr) {
    LAS float* tile = (LAS float*)lds;
    const int tid = threadIdx.x;
    const int nkt = K >> 8, nnt = N >> 6;
    if (rank < 0) { rank = (int)blockIdx.x; nrank = (int)gridDim.x; }
    const unsigned voff = (unsigned)(tid >> 6) * (unsigned)N + (unsigned)(tid & 63);
    LAS float* tw = tile + (tid >> 6) * 65 + (tid & 63);
    float v32[32];
    if (rank < nkt * nnt) { const int kt = rank % nkt, nt = rank / nkt, k0 = kt * 256, n0 = nt * 64;
#pragma unroll
        for (int i = 0; i < 32; ++i) { const float* rowp = W + (size_t)(k0 + 8 * i) * N + n0; v32[i] = rowp[voff]; if (rowscale) v32[i] *= rowscale[k0 + 8 * i + (tid >> 6)]; } }
    for (int u = rank; u < nkt * nnt; u += nrank) {
        const int kt = u % nkt, nt = u / nkt, k0 = kt * 256, n0 = nt * 64;
#pragma unroll
        for (int i = 0; i < 32; ++i) tw[i * 8 * 65] = v32[i];
        LDS_SYNC();
        if (u + nrank < nkt * nnt) { const int u2 = u + nrank, kt2 = u2 % nkt, nt2 = u2 / nkt, k2 = kt2 * 256, n2 = nt2 * 64;
#pragma unroll
            for (int i = 0; i < 32; ++i) { const float* rowp = W + (size_t)(k2 + 8 * i) * N + n2; v32[i] = rowp[voff]; if (rowscale) v32[i] *= rowscale[k2 + 8 * i + (tid >> 6)]; } }
        { const int n = tid >> 3, kk = (tid & 7) * 8; const int nn = n0 + n; const int drow = mode == 0 ? nn : ((nn >> 7) * 256 + (nn & 127) + (mode == 2 ? 128 : 0));
#pragma unroll
            for (int q = 0; q < 4; ++q) { float v[8];
#pragma unroll
                for (int j = 0; j < 8; ++j) v[j] = tile[(q * 64 + kk + j) * 65 + n];
                *(vu4*)(Bt + (size_t)drow * K + k0 + q * 64 + kk) = pack8(v); } }
        LDS_SYNC();
    }
}
__device__ __forceinline__ void cvt_ffn(const Args& a, int layer, lds_u8* lds, int rank = -1, int nrank = 0, unsigned char* dst = nullptr) {
    bf16_t* wgu = (bf16_t*)(dst ? dst : a.ws + WS_W + W_GU); bf16_t* wdn = (bf16_t*)(dst ? dst + 44 * MiB : a.ws + WS_W + W_DN);
    cvt_wT(ARG_IN(7) + (size_t)layer * DM * DFF, DM, DFF, wgu, 1, lds, rank, nrank);
    cvt_wT(ARG_IN(8) + (size_t)layer * DM * DFF, DM, DFF, wgu, 2, lds, rank, nrank);
    cvt_wT(ARG_IN(9) + (size_t)layer * DFF * DM, DFF, DM, wdn, 0, lds, rank, nrank);
}
__device__ __forceinline__ void cvt_ffn_part(const Args& a, int layer, lds_u8* lds, int rank, int nrank, unsigned char* dst, bool down) {
    bf16_t* wgu = (bf16_t*)(dst ? dst : a.ws + WS_W + W_GU); bf16_t* wdn = (bf16_t*)(dst ? dst + 44 * MiB : a.ws + WS_W + W_DN);
    if (!down) { cvt_wT(ARG_IN(7) + (size_t)layer * DM * DFF, DM, DFF, wgu, 1, lds, rank, nrank); cvt_wT(ARG_IN(8) + (size_t)layer * DM * DFF, DM, DFF, wgu, 2, lds, rank, nrank); }
    else cvt_wT(ARG_IN(9) + (size_t)layer * DFF * DM, DFF, DM, wdn, 0, lds, rank, nrank);
}

template <bool XSRC_BF, bool XDST_BF>
__device__ __forceinline__ void ph_row(const float* __restrict__ x0, const float* __restrict__ x1, float* x_dst, const bf16_t* ho, const float* g_post, const float* mgate,
                                       const float* g_pre, const float* mpre, bf16_t* h, bf16_t* ug = nullptr) {
    const int tid = threadIdx.x, lane = tid & 63, wave = __builtin_amdgcn_readfirstlane(tid >> 6);
    const int G = gridDim.x, niter = (NTOK / 8 + G - 1) / G;
#define ROW_OF(it_) (ug ? ((blockIdx.x + G * ((it_) >> 2)) >= 1280 ? -1 : (int)(blockIdx.x + G * ((it_) >> 2)) * 32 + wave * 4 + ((it_) & 3)) : ((blockIdx.x + G * (it_)) >= NTOK / 8 ? -1 : (int)(blockIdx.x + G * (it_)) * 8 + wave))
    vu4 nxb[4], nho[4]; float nxf[4][8];
#define ROW_LOAD(r_) { const float* xr_ = (r_) < 32768 ? x0 + (size_t)(r_) * DM : x1 + (size_t)((r_) - 32768) * DM; \
        _Pragma("unroll") for (int j = 0; j < 4; ++j) { if (XSRC_BF) nxb[j] = *(const vu4*)((const bf16_t*)x0 + (size_t)(r_) * DM + 8 * lane + 512 * j); else load8f(xr_ + 8 * lane + 512 * j, nxf[j]); \
            if (ho) nho[j] = *(const vu4*)(ho + (size_t)(r_) * DM + 8 * lane + 512 * j); } }
    int rown = ROW_OF(0);
    if (rown >= 0) ROW_LOAD(rown)
    for (int it = 0; it < niter; ++it) {
        const int row = rown; if (row < 0) break;
        const int b = seq_of_row(row);
        float xv[4][8]; vu4 hraw[4];
#pragma unroll
        for (int j = 0; j < 4; ++j) { if (XSRC_BF) unpack8(nxb[j], xv[j]); else {
#pragma unroll
                for (int e = 0; e < 8; ++e) xv[j][e] = nxf[j][e]; }
            hraw[j] = nho[j]; }
        rown = it + 1 < niter ? ROW_OF(it + 1) : -1;
        if (rown >= 0) ROW_LOAD(rown)
        if (ho) {
            float hv[4][8]; float ss = 0.f;
#pragma unroll
            for (int j = 0; j < 4; ++j) { unpack8(hraw[j], hv[j]);
#pragma unroll
                for (int e = 0; e < 8; ++e) ss += hv[j][e] * hv[j][e]; }
            ss = wave_sum(ss);
            const float r1 = rsqrtf(ss * (1.0f / DM) + EPSN);
#pragma unroll
            for (int j = 0; j < 4; ++j) { float gt[8]; load8f(mgate + (size_t)b * 12288 + 8 * lane + 512 * j, gt);
#pragma unroll
                for (int e = 0; e < 8; ++e) xv[j][e] += gt[e] * (hv[j][e] * r1); }
        }
        if (x_dst) {
#pragma unroll
            for (int j = 0; j < 4; ++j) { if (XDST_BF) *(vu4*)((bf16_t*)x_dst + (size_t)row * DM + 8 * lane + 512 * j) = pack8(xv[j]); else store8f(x_dst + (size_t)row * DM + 8 * lane + 512 * j, xv[j]); }
        }
        if (h || ug) {
            float ss = 0.f;
#pragma unroll
            for (int j = 0; j < 4; ++j)
#pragma unroll
                for (int e = 0; e < 8; ++e) ss += xv[j][e] * xv[j][e];
            ss = wave_sum(ss);
            const float r2 = rsqrtf(ss * (1.0f / DM) + EPSN);
#pragma unroll
            for (int j = 0; j < 4; ++j) { float sh[8], sc[8], o[8]; load8f(mpre + (size_t)b * 12288 + 8 * lane + 512 * j, sh); load8f(mpre + (size_t)b * 12288 + 2048 + 8 * lane + 512 * j, sc);
#pragma unroll
                for (int e = 0; e < 8; ++e) o[e] = xv[j][e] * r2 * sc[e] + sh[e];
                if (ug) { const int col = 8 * lane + 512 * j; *(vu4*)(ug + ((size_t)((col >> 4) * 1280 + (row >> 5))) * 768 + (row & 31) * 16 + (col & 8)) = pack8(o); }
                else *(vu4*)(h + (size_t)row * DM + 8 * lane + 512 * j) = pack8(o); }
        }
    }
}

__device__ __forceinline__ void ph_dn_combine(const Args& a, const bf16_t* of, const bf16_t* ob, const bf16_t* proj, bf16_t* O) {
    const int tid = threadIdx.x, lane = tid & 63, wave = __builtin_amdgcn_readfirstlane(tid >> 6);
    const float* gn = ARG_IN(14);
    for (int row = blockIdx.x * 8 + wave; row < NTOK; row += gridDim.x * 8) {
#pragma unroll
        for (int j = 0; j < 4; ++j) { const int col = 8 * lane + 512 * j;
            float x[8], y[8], z[8], g8[8], o[8];
            unpack8(*(const vu4*)(of + (size_t)row * DM + col), x); unpack8(*(const vu4*)(ob + (size_t)row * DM + col), y);
            unpack8(*(const vu4*)(proj + (size_t)row * DN_LD2 + col), z); load8f(gn + (col & 127), g8);
            float ss = 0.f;
#pragma unroll
            for (int e = 0; e < 8; ++e) { x[e] += y[e]; ss += x[e] * x[e]; }
            ss += __shfl_xor(ss, 1); ss += __shfl_xor(ss, 2); ss += __shfl_xor(ss, 4); ss += __shfl_xor(ss, 8);
            const float r = rsqrtf(ss * (1.0f / 128.0f) + EPSN);
#pragma unroll
            for (int e = 0; e < 8; ++e) o[e] = x[e] * r * g8[e] * silu_f(z[e]);
            *(vu4*)(O + (size_t)row * DM + col) = pack8(o); }
    }
}
__device__ __forceinline__ void ph_ssd_combine(const Args& a, bf16_t* Y, const bf16_t* proj, const bf16_t* Yfs) {
    const int tid = threadIdx.x, lane = tid & 63, wave = __builtin_amdgcn_readfirstlane(tid >> 6);
    const float* gn = ARG_IN(31);
    for (int row = blockIdx.x * 8 + wave; row < NTOK; row += gridDim.x * 8) {
#pragma unroll
        for (int j = 0; j < 8; ++j) { const int col = 8 * lane + 512 * j;
            float y[8], z[8], o[8];
            unpack8(*(const vu4*)(Y + (size_t)row * 4096 + col), y); unpack8(*(const vu4*)(proj + (size_t)row * SSD_LD2 + col), z);
            if (row >= 32768) { float yf[8]; unpack8(*(const vu4*)(Yfs + (size_t)(row - 32768) * 4096 + col), yf);
#pragma unroll
                for (int e = 0; e < 8; ++e) y[e] += yf[e]; }
            float ss = 0.f;
#pragma unroll
            for (int e = 0; e < 8; ++e) { y[e] *= silu_f(z[e]); ss += y[e] * y[e]; }
            ss = wave_sum(ss);
            const float r = rsqrtf(ss * (1.0f / 512.0f) + EPSN);
#pragma unroll
            for (int e = 0; e < 8; ++e) o[e] = y[e] * r;
            *(vu4*)(Y + (size_t)row * 4096 + col) = pack8(o); }
    }
}

constexpr int S5_NCH = 1280, S5_LDA = 768;
struct BatchOrder {
    int nMg, nNg, per, total, G, c;
    __device__ void init(int nMg_, int nNg_, int G_, int c_) { nMg = nMg_; nNg = nNg_; per = nMg_ * nNg_; total = 128 * per; G = G_; c = c_; }
    __device__ bool next(int i, pg8::Unit& u) const { const long L0 = (long)i * G + c; if (L0 >= total) return false;
        const int L = (int)(L0 % 8) * (total / 8) + (int)(L0 / 8);
        const int g = L / per, r = L % per;
        u.pm = g * nMg + r % nMg; u.pn = g * nNg + r / nMg; return true; }
    __device__ __forceinline__ void a_ready(const pg8::Unit&) const {}
    __device__ __forceinline__ void done(const pg8::Unit&) const {}
};
struct EpiS5E {
    static constexpr bool PERM = false, AFTER_DRAIN = false;
    float* E;
    __device__ __forceinline__ void operator()(const pg8::f32x4 (&acc)[2][2][4][2], const pg8::Unit& u, int wr, int wc, int fr, int fq) const {
        const int row0 = u.pm * 256 + wr * 64 + fr, col0 = wc * 32 + 4 * fq;
#pragma unroll
        for (int ai = 0; ai < 2; ++ai)
#pragma unroll
            for (int m = 0; m < 4; ++m) { float* rowp = E + (size_t)(row0 + ai * 128 + m * 16) * 256 + col0;
#pragma unroll
                for (int bj = 0; bj < 2; ++bj)
#pragma unroll
                    for (int n = 0; n < 2; ++n) *(pg8::f32x4*)(rowp + bj * 128 + n * 16) = acc[ai][bj][m][n]; }
    }
};
__device__ __forceinline__ float gelu_tanh_f(float y) { const float z = 1.5957691216057308f * (y + 0.044715f * y * y * y); return y * __builtin_amdgcn_rcpf(1.0f + __expf(-z)); }
struct EpiS5Y {
    static constexpr bool PERM = true, AFTER_DRAIN = false;
    bf16_t* Y;
    __device__ __forceinline__ void operator()(const pg8::f32x4 (&acc)[2][2][4][2], const pg8::Unit& u, int wr, int wc, int fr, int fq) const {
        const int g = u.pm / 5, chunk0 = (u.pm % 5) * 256 + wr * 64 + fr, n0 = (u.pn & 1) * 256 + wc * 32 + 8 * fq;
#pragma unroll
        for (int ai = 0; ai < 2; ++ai)
#pragma unroll
            for (int m = 0; m < 4; ++m) { const int chunk = chunk0 + ai * 128 + m * 16;
#pragma unroll
                for (int bj = 0; bj < 2; ++bj) { const int n = n0 + bj * 128, t = n >> 4, c0 = n & 15;
                    const pg8::f32x4 v0 = acc[ai][bj][m][0], v1 = acc[ai][bj][m][1];
                    pg8::u32x4 w; w.x = pg8::cvt_pk_bf16(gelu_tanh_f(v0[0]), gelu_tanh_f(v0[1])); w.y = pg8::cvt_pk_bf16(gelu_tanh_f(v0[2]), gelu_tanh_f(v0[3]));
                    w.z = pg8::cvt_pk_bf16(gelu_tanh_f(v1[0]), gelu_tanh_f(v1[1])); w.w = pg8::cvt_pk_bf16(gelu_tanh_f(v1[2]), gelu_tanh_f(v1[3]));
                    *(pg8::u32x4*)(Y + (size_t)(chunk * 32 + t) * DM + g * 16 + c0) = w; } }
    }
};
__device__ __forceinline__ void ph_s5_tables(const Args& a, lds_u8* lds, bf16_t* BtY, bf16_t* BtE, float* LT, int rank, int nrank) {
    LAS float* bb = (LAS float*)lds;
    LAS float* cc = bb + 4096;
    LAS float* pw = cc + 4096;
    LAS float* kc = pw + 8448;
    const int tid = threadIdx.x;
    const float* lam_re = ARG_IN(16); const float* lam_im = ARG_IN(17); const float* log_step = ARG_IN(18);
    const float* b_re = ARG_IN(19); const float* b_im = ARG_IN(20); const float* c_re = ARG_IN(21); const float* c_im = ARG_IN(22); const float* dvec = ARG_IN(23);
    for (int g = rank; g < 128; g += nrank) {
        if (tid < 128) { const int dir = tid >> 6, p = tid & 63;
            const float step = expf(log_step[dir * 128 + g]);
            const float lr = fminf(lam_re[(dir * 128 + g) * 64 + p], -1e-4f), li = lam_im[(dir * 128 + g) * 64 + p];
#pragma unroll 1
            for (int n = 0; n <= 32; ++n) { const float mag = expf(lr * step * (float)n); float sn, cs; sincosf(li * step * (float)n, &sn, &cs);
                pw[((dir * 64 + p) * 33 + n) * 2] = mag * cs; pw[((dir * 64 + p) * 33 + n) * 2 + 1] = mag * sn; }
            const float ar = pw[((dir * 64 + p) * 33 + 1) * 2], ai = pw[((dir * 64 + p) * 33 + 1) * 2 + 1];
            const float den = lr * lr + li * li, nr = ar - 1.0f, cr = (nr * lr + ai * li) / den, ci = (ai * lr - nr * li) / den;
#pragma unroll 4
            for (int c = 0; c < 16; ++c) { const float br = b_re[(g * 64 + p) * 16 + c], bi = b_im[(g * 64 + p) * 16 + c];
                bb[((dir * 64 + p) * 16 + c) * 2] = cr * br - ci * bi; bb[((dir * 64 + p) * 16 + c) * 2 + 1] = cr * bi + ci * br; }
            LT[((g * 2 + dir) * 64 + p) * 2] = pw[((dir * 64 + p) * 33 + 32) * 2]; LT[((g * 2 + dir) * 64 + p) * 2 + 1] = pw[((dir * 64 + p) * 33 + 32) * 2 + 1];
        }
        for (int i = tid; i < 2048; i += NTHR) { const int dir = i >> 10, c = (i >> 6) & 15, p = i & 63;
            cc[i * 2] = c_re[((size_t)(dir * 128 + g) * 16 + c) * 64 + p]; cc[i * 2 + 1] = c_im[((size_t)(dir * 128 + g) * 16 + c) * 64 + p]; }
        LDS_SYNC();
#pragma unroll 1
        for (int idx = tid; idx < 63 * 256; idx += NTHR) { const int dd = (idx >> 8) - 31, c = (idx >> 4) & 15, c2 = idx & 15;
            float s = 0.f;
            if (dd >= 0) {
#pragma unroll 4
                for (int p = 0; p < 64; ++p) { const vf2 cv = *(const LAS vf2*)(cc + ((0 * 16 + c) * 64 + p) * 2), pv = *(const LAS vf2*)(pw + ((0 * 64 + p) * 33 + dd) * 2), bv = *(const LAS vf2*)(bb + ((0 * 64 + p) * 16 + c2) * 2);
                    const float tr = cv.x * pv.x - cv.y * pv.y, ti = cv.x * pv.y + cv.y * pv.x; s += tr * bv.x - ti * bv.y; } }
            if (dd <= 0) {
#pragma unroll 4
                for (int p = 0; p < 64; ++p) { const vf2 cv = *(const LAS vf2*)(cc + ((1 * 16 + c) * 64 + p) * 2), pv = *(const LAS vf2*)(pw + ((1 * 64 + p) * 33 - dd) * 2), bv = *(const LAS vf2*)(bb + ((1 * 64 + p) * 16 + c2) * 2);
                    const float tr = cv.x * pv.x - cv.y * pv.y, ti = cv.x * pv.y + cv.y * pv.x; s += tr * bv.x - ti * bv.y; } }
            if (dd == 0 && c == c2) s += dvec[g * 16 + c];
            kc[idx] = s; }
        LDS_SYNC();
#pragma unroll 1
        for (int idx = tid; idx < 512 * 64; idx += NTHR) { const int n = idx >> 6, piece = idx & 63, t = n >> 4, c = n & 15, s = piece >> 1, half = piece & 1;
            const LAS float* src = kc + ((t - s + 31) * 16 + c) * 16 + half * 8; float v[8];
            const vf4 a0 = *(const LAS vf4*)src, a1 = *(const LAS vf4*)(src + 4); v[0] = a0.x; v[1] = a0.y; v[2] = a0.z; v[3] = a0.w; v[4] = a1.x; v[5] = a1.y; v[6] = a1.z; v[7] = a1.w;
            *(vu4*)(BtY + ((size_t)(g * 512 + n)) * 768 + s * 16 + half * 8) = pack8(v); }
#pragma unroll 1
        for (int idx = tid; idx < 512 * 32; idx += NTHR) { const int n = idx >> 5, pc = idx & 31, which = pc >> 3, p0 = (pc & 7) * 8, t = n >> 4, c = n & 15, dir = which >> 1, nn = dir ? 32 - t : t + 1;
            float v[8];
#pragma unroll
            for (int j = 0; j < 8; ++j) { const int p = p0 + j; const vf2 cv = *(const LAS vf2*)(cc + ((dir * 16 + c) * 64 + p) * 2), pv = *(const LAS vf2*)(pw + ((dir * 64 + p) * 33 + nn) * 2);
                v[j] = (which & 1) ? -(cv.x * pv.y + cv.y * pv.x) : (cv.x * pv.x - cv.y * pv.y); }
            *(vu4*)(BtY + ((size_t)(g * 512 + n)) * 768 + 512 + which * 64 + p0) = pack8(v); }
#pragma unroll 1
        for (int idx = tid; idx < 256 * 64; idx += NTHR) { const int n2 = idx >> 6, piece = idx & 63, dir = n2 >> 7, reim = (n2 >> 6) & 1, p = n2 & 63, s = piece >> 1, half = piece & 1, nn = dir ? s : 31 - s;
            const vf2 pv = *(const LAS vf2*)(pw + ((dir * 64 + p) * 33 + nn) * 2); float v[8];
#pragma unroll
            for (int j = 0; j < 8; ++j) { const vf2 bv = *(const LAS vf2*)(bb + ((dir * 64 + p) * 16 + half * 8 + j) * 2); v[j] = reim ? (pv.x * bv.y + pv.y * bv.x) : (pv.x * bv.x - pv.y * bv.y); }
            *(vu4*)(BtE + ((size_t)(g * 256 + n2)) * 512 + s * 16 + half * 8) = pack8(v); }
        LDS_SYNC();
    }
}
__device__ __forceinline__ void ph_s5_scan(const float* E, const float* LT, bf16_t* UG) {
    for (int id = blockIdx.x * NTHR + threadIdx.x; id < 128 * 6 * 2 * 64; id += gridDim.x * NTHR) {
        const int p = id & 63, dir = (id >> 6) & 1, rest = id >> 7, s = rest % 6, g = rest / 6;
        const int c0 = seq_start(s) >> 5, nc = seq_len(s) >> 5;
        const float lr = LT[((g * 2 + dir) * 64 + p) * 2], li = LT[((g * 2 + dir) * 64 + p) * 2 + 1];
        float xr = 0.f, xi = 0.f;
#pragma unroll 8
        for (int m = 0; m < nc; ++m) { const int chunk = dir ? c0 + nc - 1 - m : c0 + m; const size_t row = (size_t)g * S5_NCH + chunk;
            UG[row * S5_LDA + 512 + dir * 128 + p] = (bf16_t)(pg8::cvt_pk_bf16(xr, xr) & 0xffffu); UG[row * S5_LDA + 512 + dir * 128 + 64 + p] = (bf16_t)(pg8::cvt_pk_bf16(xi, xi) & 0xffffu);
            const float er = E[row * 256 + dir * 128 + p], ei = E[row * 256 + dir * 128 + 64 + p];
            const float nxr = lr * xr - li * xi + er, nxi = lr * xi + li * xr + ei; xr = nxr; xi = nxi; }
    }
}
template <class Epi>
__device__ __forceinline__ void run_gemm_s5(lds_u8* lds, const bf16_t* A, const bf16_t* Bt, int nNg, int K, int ldb, const Epi& E) {
    pg8::Gemm g{A, Bt, 128 * S5_NCH, 128 * nNg * 256, K, S5_LDA, ldb}; BatchOrder S; S.init(5, nNg, (int)gridDim.x, (int)blockIdx.x);
    pg8::gemm_phase<Epi, BatchOrder, true, true>(lds, g, S, E);
}

__device__ __forceinline__ void ph_conv_inplace(lds_u8* lds, bf16_t* XT, const float* convw, const bf16_t* halo, int norm_mode) {
    LAS bf16_t* raw = (LAS bf16_t*)lds;
    const int tid = threadIdx.x, g8 = tid & 15;
    vu4 pb0, pb1, ph = (vu4){0u, 0u, 0u, 0u};
#define CONV_FETCH(uu) do { const int tt_ = (uu) / 48, cb_ = (uu) % 48; const size_t bs_ = (((size_t)tt_ * 768 + cb_ * 16 + g8) * 64 + (tid >> 4)) * 8; \
        pb0 = *(const vu4*)(XT + bs_); pb1 = *(const vu4*)(XT + bs_ + 32 * 8); \
        if (tid < 64) { const int hr_ = tid >> 4, rt0_ = tt_ * 64, s_ = seq_of_row(rt0_), t0_ = rt0_ - seq_start(s_); ph = (vu4){0u, 0u, 0u, 0u}; \
            if (hr_ < 2) { if (t0_ > 0) ph = *(const vu4*)(halo + ((size_t)(tt_ - 1) * 4 + 2 + hr_) * 6144 + cb_ * 128 + g8 * 8); } \
            else { if (t0_ + 64 < seq_len(s_)) ph = *(const vu4*)(halo + ((size_t)(tt_ + 1) * 4 + (hr_ - 2)) * 6144 + cb_ * 128 + g8 * 8); } } } while (0)
    if ((int)blockIdx.x < 640 * 48) CONV_FETCH((int)blockIdx.x);
    for (int u = blockIdx.x; u < 640 * 48; u += gridDim.x) {
        const int tt = u / 48, cb = u % 48, cc0 = cb * 128;
        *(LAS vu4*)(raw + ((tid >> 4) + 2) * 128 + g8 * 8) = pb0; *(LAS vu4*)(raw + ((tid >> 4) + 34) * 128 + g8 * 8) = pb1;
        if (tid < 64) { const int hr = tid >> 4; *(LAS vu4*)(raw + (hr < 2 ? hr : 64 + hr) * 128 + g8 * 8) = ph; }
        if (u + (int)gridDim.x < 640 * 48) CONV_FETCH(u + (int)gridDim.x);
        float cw[5][8];
#pragma unroll
        for (int tap = 0; tap < 5; ++tap) load8f(convw + tap * 6144 + cc0 + g8 * 8, cw[tap]);
        LDS_SYNC();
        vu4 outv[2];
#pragma unroll
        for (int i = 0; i < 2; ++i) { const int r = (tid >> 4) + 32 * i; float acc[8];
#pragma unroll
            for (int j = 0; j < 8; ++j) acc[j] = 0.f;
#pragma unroll
            for (int tap = 0; tap < 5; ++tap) { float xv[8]; unpack8(*(const LAS vu4*)(raw + (r + tap) * 128 + g8 * 8), xv);
#pragma unroll
                for (int j = 0; j < 8; ++j) acc[j] += cw[tap][j] * xv[j]; }
            float ss = 0.f;
#pragma unroll
            for (int j = 0; j < 8; ++j) { acc[j] = silu_f(acc[j]); ss += acc[j] * acc[j]; }
            if (norm_mode == 1 && cb < 32) { ss += __shfl_xor(ss, 1); ss += __shfl_xor(ss, 2); ss += __shfl_xor(ss, 4); ss += __shfl_xor(ss, 8);
                const float sc = rsqrtf(ss + EPSN) * (cb < 16 ? 0.08838834764831845f : 1.0f);
#pragma unroll
                for (int j = 0; j < 8; ++j) acc[j] *= sc; }
            outv[i] = pack8(acc); }
        { const size_t bs = (((size_t)tt * 768 + cb * 16 + g8) * 64 + (tid >> 4)) * 8; *(vu4*)(XT + bs) = outv[0]; *(vu4*)(XT + bs + 32 * 8) = outv[1]; }
        LDS_SYNC();
    }
#undef CONV_FETCH
}

typedef short bf16x8_t __attribute__((ext_vector_type(8)));
typedef unsigned vu2 __attribute__((ext_vector_type(2)));
__device__ __forceinline__ bf16x8_t ldfrag(const LAS bf16_t* base, int ld, int row0, int k0, int lane) { return *(const LAS bf16x8_t*)(base + (row0 + (lane & 15)) * ld + k0 + 8 * (lane >> 4)); }
__device__ __forceinline__ void stfragT(LAS bf16_t* base, int ld, int n0, int m0, int lane, const pg8::f32x4 v) {
    vu2 w; w.x = pg8::cvt_pk_bf16(v[0], v[1]); w.y = pg8::cvt_pk_bf16(v[2], v[3]); *(LAS vu2*)(base + (n0 + (lane & 15)) * ld + m0 + 4 * (lane >> 4)) = w; }
typedef short s16x4_t __attribute__((ext_vector_type(4)));
__device__ __forceinline__ bf16x8_t trfragp(const LAS bf16_t* T, int ld, int c, int ks, int lane) {
    const int g = lane >> 4, q = (lane & 15) >> 2, p = lane & 3;
    const LAS bf16_t* a0 = T + (32 * ks + 8 * g + 2 * q) * ld + 16 * c + 4 * p;
    const s16x4_t lo = __builtin_amdgcn_ds_read_tr16_b64_v4i16((LAS s16x4_t*)a0), hi = __builtin_amdgcn_ds_read_tr16_b64_v4i16((LAS s16x4_t*)(a0 + ld));
    return (bf16x8_t){lo[0], lo[1], lo[2], lo[3], hi[0], hi[1], hi[2], hi[3]}; }
#define MFMA16(a, b, c) __builtin_amdgcn_mfma_f32_16x16x32_bf16(a, b, c, 0, 0, 0)

template <int VAR> __device__ __forceinline__ void ph_ssd_core3(const Args& a, lds_u8* lds, const bf16_t* GT, const bf16_t* XT, bf16_t* Y, bf16_t* Yfs) {
    constexpr int LDN = 136, LDJ = 72, NB = 64 * LDN, JB = 64 * LDJ, CSB = 196;
    LAS bf16_t* Cb2 = (LAS bf16_t*)lds;
    LAS bf16_t* Bb2 = Cb2 + 2 * NB;
    LAS bf16_t* xs2 = Bb2 + 2 * NB;
    LAS bf16_t* xw2 = xs2 + 2 * JB;
    LAS bf16_t* MmT = xw2 + 2 * JB;
    LAS bf16_t* Sb = MmT + JB;
    LAS bf16_t* Ys = Sb + NB;
    LAS float* cs2 = (LAS float*)(Ys + JB);
    const int tid = threadIdx.x, lane = tid & 63, wave = __builtin_amdgcn_readfirstlane(tid >> 6), lr = lane & 15, lq = lane >> 4;
    const bool prod = wave < 4; const int pw = wave & 3;
    const float* a_log = ARG_IN(28); const float* dtb = ARG_IN(29); const float* Dp = ARG_IN(30);
    for (int i = tid; i < JB / 2; i += NTHR) ((LAS unsigned*)MmT)[i] = 0u;
    for (int u = blockIdx.x; u < 512; u += gridDim.x) {
        int s, hd, dlo, dhi;
        if (u < 256) { s = u >> 6; const int r = u & 63; hd = (r & 7) * 8 + (r >> 3); dlo = 0; dhi = 2; } else { const int v = u - 256, r = v & 127, rest = r >> 3; s = 4 + (v >> 7); hd = (r & 7) * 8 + (rest & 7); dlo = rest >> 3; dhi = dlo + 1; }
        const bool split = u >= 256;
        const int grp = hd >> 3, L = seq_len(s), row0 = seq_start(s), nT = L >> 6;
#pragma unroll 1
        for (int d = dlo; d < dhi; ++d) {
            if (prod) {
                const float Aneg = -expf(a_log[d * 64 + hd]), dtbias = dtb[d * 64 + hd];
                const float Dd = d == 0 ? Dp[hd] : 0.f;
                vu4 pre[10]; bf16_t pdt;
                { const int tile = d ? nT - 1 : 0; const size_t gt = (size_t)((row0 >> 6) + tile) * 768; const int tk = d ? 63 - lane : lane; const unsigned tko = (unsigned)tk * 8u;
#pragma unroll
                    for (int k = 0; k < 10; ++k) { const int gg = pw + 4 * k; const int cg = k < 2 ? hd * 8 + gg : (k < 6 ? 512 + grp * 16 + (gg - 8) : 640 + grp * 16 + (gg - 24)); const bf16_t* pp = XT + (gt + cg) * 512; pre[k] = *(const vu4*)(pp + tko); }
                    pdt = GT[((size_t)((row0 >> 6) + tile) * 128 + d * 64 + hd) * 64 + tk]; }
#pragma unroll 1
                for (int ti = 0; ti < nT; ++ti) {
                    const int bn = ti & 1;
                    LAS bf16_t* Cbn = Cb2 + bn * NB; LAS bf16_t* Bbn = Bb2 + bn * NB; LAS bf16_t* xsn = xs2 + bn * JB; LAS bf16_t* xwn = xw2 + bn * JB; LAS float* cs = cs2 + bn * CSB;
#pragma unroll
                    for (int k = 0; k < 10; ++k) { const int gg = pw + 4 * k; const vu4 rawv = pre[k];
                        if (k < 2) *(LAS vu4*)(xsn + lane * LDJ + gg * 8) = rawv;
                        else if (k < 6) *(LAS vu4*)(Bbn + lane * LDN + (gg - 8) * 8) = rawv;
                        else *(LAS vu4*)(Cbn + lane * LDN + (gg - 24) * 8) = rawv; }
                    const float dtv = softplus_fast(bf2f(pdt) + dtbias);
                    const float cum = wave_scan_incl(dtv * Aneg);
                    const float cumlast = lane63(cum);
                    const float xsc = dtv * __expf(cumlast - cum);
                    if (pw == 0) { cs[lane] = cum; cs[64 + lane] = __expf(cum); cs[128 + lane] = dtv; if (lane == 0) cs[192] = __expf(cumlast); }
#pragma unroll
                    for (int k = 0; k < 2; ++k) { const int gg = pw + 4 * k; float xv[8]; unpack8(pre[k], xv);
#pragma unroll
                        for (int j = 0; j < 8; ++j) xv[j] *= xsc;
                        *(LAS vu4*)(xwn + lane * LDJ + gg * 8) = pack8(xv); }
                    if (VAR == 1) {
#pragma unroll
                        for (int k = 0; k < 10; ++k) asm volatile("" : "+v"(pre[k]));
                    }
                    if (VAR != 1 && ti + 1 < nT) { const int tile2 = d ? nT - 2 - ti : ti + 1; const size_t gt = (size_t)((row0 >> 6) + tile2) * 768; const int tk = d ? 63 - lane : lane; const unsigned tko = (unsigned)tk * 8u;
#pragma unroll
                        for (int k = 0; k < 10; ++k) { const int gg = pw + 4 * k; const int cg = k < 2 ? hd * 8 + gg : (k < 6 ? 512 + grp * 16 + (gg - 8) : 640 + grp * 16 + (gg - 24)); const bf16_t* pp = XT + (gt + cg) * 512; pre[k] = *(const vu4*)(pp + tko); }
                        pdt = GT[((size_t)((row0 >> 6) + tile2) * 128 + d * 64 + hd) * 64 + tk]; }
                    LDS_SYNC();
                    bf16x8_t pc[3][4], pb[3][4];
#define SSD_P2_TILE(sl) int it, jt; bool on = true; \
                        if (sl == 0) { it = pw < 2 ? 3 : 2; jt = (pw & 1) * 2; } else if (sl == 1) { it = pw == 3 ? 1 : (pw < 2 ? 3 : 2); jt = pw == 1 ? 3 : 1; } else { it = pw; jt = 0; on = pw < 2; }
#define SSD_P2_LOAD(sl) { SSD_P2_TILE(sl) if (on) { _Pragma("unroll") for (int ks = 0; ks < 4; ++ks) { pc[sl][ks] = ldfrag(Cbn, LDN, it * 16, ks * 32, lane); pb[sl][ks] = ldfrag(Bbn, LDN, jt * 16, ks * 32, lane); } } }
#define SSD_P2_COMP(sl) { SSD_P2_TILE(sl) if (on) { pg8::f32x4 acc = (pg8::f32x4){0.f, 0.f, 0.f, 0.f}; \
                            _Pragma("unroll") for (int ks = 0; ks < 4; ++ks) acc = MFMA16(pc[sl][ks], pb[sl][ks], acc); \
                            const int i0 = it * 16 + 4 * lq, j = jt * 16 + lr; const float cj = cs[j], dj = cs[128 + j]; const vf4 ci = *(const LAS vf4*)(cs + i0); \
                            acc[0] = (j <= i0 + 0) ? acc[0] * (__expf(ci.x - cj) * dj) : 0.f; acc[1] = (j <= i0 + 1) ? acc[1] * (__expf(ci.y - cj) * dj) : 0.f; \
                            acc[2] = (j <= i0 + 2) ? acc[2] * (__expf(ci.z - cj) * dj) : 0.f; acc[3] = (j <= i0 + 3) ? acc[3] * (__expf(ci.w - cj) * dj) : 0.f; \
                            if (it == jt) { acc[0] += (j == i0 + 0) ? Dd : 0.f; acc[1] += (j == i0 + 1) ? Dd : 0.f; acc[2] += (j == i0 + 2) ? Dd : 0.f; acc[3] += (j == i0 + 3) ? Dd : 0.f; } \
                            stfragT(MmT, LDJ, jt * 16, it * 16, lane, acc); } }
                    SSD_P2_LOAD(0) SSD_P2_LOAD(1)
                    asm volatile("" ::: "memory");
                    SSD_P2_COMP(0)
                    asm volatile("" ::: "memory");
                    SSD_P2_LOAD(2)
                    SSD_P2_COMP(1)
                    asm volatile("" ::: "memory");
                    SSD_P2_COMP(2)
                    LDS_SYNC();
                }
                LDS_SYNC();
                LDS_SYNC();
            } else {
                const bool addf = d == 1 && !split;
                const int it = pw;
                pg8::f32x4 st[2][4];
#pragma unroll
                for (int q = 0; q < 2; ++q)
#pragma unroll
                    for (int pt = 0; pt < 4; ++pt) st[q][pt] = (pg8::f32x4){0.f, 0.f, 0.f, 0.f};
                for (int i = tid - 256; i < NB / 2; i += 256) ((LAS unsigned*)Sb)[i] = 0u;
                vu4 pyf[2] = {(vu4){0u, 0u, 0u, 0u}, (vu4){0u, 0u, 0u, 0u}};
                if (addf) {
#pragma unroll
                    for (int r = 0; r < 2; ++r) { const int idx = tid - 256 + 256 * r, i = idx >> 3, p8 = (idx & 7) * 8; pyf[r] = *(const vu4*)(Y + (size_t)(row0 + (nT - 1) * 64 + 63 - i) * 4096 + hd * 64 + p8); } }
                LDS_SYNC();
                LDS_SYNC();
#pragma unroll 1
                for (int sc = 0; sc < nT; ++sc) {
                    const int bc = sc & 1;
                    LAS const bf16_t* Cbc = Cb2 + bc * NB; LAS const bf16_t* xsc = xs2 + bc * JB; LAS const float* cs = cs2 + bc * CSB;
                    pg8::f32x4 acc[4];
#pragma unroll
                    for (int pt = 0; pt < 4; ++pt) acc[pt] = (pg8::f32x4){0.f, 0.f, 0.f, 0.f};
                    bf16x8_t cf[4], sf[4][4], mf[2], xf[2][4];
#pragma unroll
                    for (int ks = 0; ks < 2; ++ks) { cf[ks] = ldfrag(Cbc, LDN, it * 16, ks * 32, lane);
#pragma unroll
                        for (int pt = 0; pt < 4; ++pt) sf[ks][pt] = ldfrag(Sb, LDN, pt * 16, ks * 32, lane); }
                    const float ec = cs[64 + it * 16 + lr];
                    asm volatile("" ::: "memory");
#pragma unroll
                    for (int ks = 2; ks < 4; ++ks) { cf[ks] = ldfrag(Cbc, LDN, it * 16, ks * 32, lane);
#pragma unroll
                        for (int pt = 0; pt < 4; ++pt) sf[ks][pt] = ldfrag(Sb, LDN, pt * 16, ks * 32, lane); }
#pragma unroll
                    for (int ks = 0; ks < 2; ++ks)
#pragma unroll
                        for (int pt = 0; pt < 4; ++pt) acc[pt] = MFMA16(sf[ks][pt], cf[ks], acc[pt]);
                    asm volatile("" ::: "memory");
#pragma unroll
                    for (int ks = 0; ks < 2; ++ks) if (ks == 0 || it >= 2) { mf[ks] = trfragp(MmT, LDJ, it, ks, lane);
#pragma unroll
                        for (int pt = 0; pt < 4; ++pt) xf[ks][pt] = trfragp(xsc, LDJ, pt, ks, lane); }
#pragma unroll
                    for (int ks = 2; ks < 4; ++ks)
#pragma unroll
                        for (int pt = 0; pt < 4; ++pt) acc[pt] = MFMA16(sf[ks][pt], cf[ks], acc[pt]);
                    asm volatile("" ::: "memory");
#pragma unroll
                    for (int pt = 0; pt < 4; ++pt) acc[pt] = acc[pt] * ec;
#pragma unroll
                    for (int ks = 0; ks < 2; ++ks) if (ks == 0 || it >= 2) {
#pragma unroll
                        for (int pt = 0; pt < 4; ++pt) acc[pt] = MFMA16(xf[ks][pt], mf[ks], acc[pt]); }
#pragma unroll
                    for (int pt = 0; pt < 4; ++pt) stfragT(Ys, LDJ, it * 16, pt * 16, lane, acc[pt]);
                    LDS_SYNC();
                    LAS const bf16_t* Bbc = Bb2 + bc * NB; LAS const bf16_t* xwc = xw2 + bc * JB; const float declast = cs[192];
                    const int tile = d ? nT - 1 - sc : sc, t0 = tile * 64;
                    bf16x8_t wf[2][4], bfr[2][2];
#pragma unroll
                    for (int ks = 0; ks < 2; ++ks) {
#pragma unroll
                        for (int pt = 0; pt < 4; ++pt) wf[ks][pt] = trfragp(xwc, LDJ, pt, ks, lane);
#pragma unroll
                        for (int q = 0; q < 2; ++q) bfr[ks][q] = trfragp(Bbc, LDN, 2 * pw + q, ks, lane); }
                    vu4 yv[2];
#pragma unroll
                    for (int r = 0; r < 2; ++r) { const int idx = tid - 256 + 256 * r, i = idx >> 3, p8 = (idx & 7) * 8; yv[r] = *(const LAS vu4*)(Ys + i * LDJ + p8); }
                    asm volatile("" ::: "memory");
#pragma unroll
                    for (int q = 0; q < 2; ++q)
#pragma unroll
                        for (int pt = 0; pt < 4; ++pt) st[q][pt] = st[q][pt] * declast;
#pragma unroll
                    for (int ks = 0; ks < 2; ++ks)
#pragma unroll
                        for (int q = 0; q < 2; ++q)
#pragma unroll
                            for (int pt = 0; pt < 4; ++pt) st[q][pt] = MFMA16(bfr[ks][q], wf[ks][pt], st[q][pt]);
#pragma unroll
                    for (int q = 0; q < 2; ++q)
#pragma unroll
                        for (int pt = 0; pt < 4; ++pt) stfragT(Sb, LDN, pt * 16, (2 * pw + q) * 16, lane, st[q][pt]);
                    vu4 pyn[2] = {pyf[0], pyf[1]};
                    if (VAR != 1 && addf && sc + 1 < nT) { const int tile2 = nT - 2 - sc;
#pragma unroll
                        for (int r = 0; r < 2; ++r) { const int idx = tid - 256 + 256 * r, i = idx >> 3, p8 = (idx & 7) * 8; pyn[r] = *(const vu4*)(Y + (size_t)(row0 + tile2 * 64 + 63 - i) * 4096 + hd * 64 + p8); } }
#pragma unroll
                    for (int r = 0; r < 2; ++r) { const int idx = tid - 256 + 256 * r, i = idx >> 3, p8 = (idx & 7) * 8;
                        const int orow = row0 + t0 + (d ? 63 - i : i);
                        bf16_t* dst = (split && d == 0 ? Yfs + (size_t)(orow - 32768) * 4096 : Y + (size_t)orow * 4096) + hd * 64 + p8;
                        vu4 o = yv[r];
                        if (addf) { float of[8], pf[8]; unpack8(o, of); unpack8(pyf[r], pf);
#pragma unroll
                            for (int j = 0; j < 8; ++j) of[j] += pf[j];
                            o = pack8(of); }
                        if (VAR != 1) *(vu4*)dst = o; else asm volatile("" :: "v"(o)); }
                    pyf[0] = pyn[0]; pyf[1] = pyn[1];
                    LDS_SYNC();
                }
            }
            __syncthreads();
        }
    }
}

__device__ __forceinline__ bf16x8_t dn_afrag2(const LAS bf16_t* AD, int row, int c0, int c1, int lq) {
    const vu2 lo = *(const LAS vu2*)(AD + row * 72 + 16 * c0 + 4 * lq); vu2 hi = (vu2){0u, 0u}; if (c1 >= 0) hi = *(const LAS vu2*)(AD + row * 72 + 16 * c1 + 4 * lq);
    const vu4 w = (vu4){lo.x, lo.y, hi.x, hi.y}; return __builtin_bit_cast(bf16x8_t, w); }
__device__ __forceinline__ bf16x8_t dn_bfrag2(const pg8::f32x4 x0, const pg8::f32x4 x1, bool has1) {
    vu4 w; w.x = pg8::cvt_pk_bf16(x0[0], x0[1]); w.y = pg8::cvt_pk_bf16(x0[2], x0[3]); w.z = has1 ? pg8::cvt_pk_bf16(x1[0], x1[1]) : 0u; w.w = has1 ? pg8::cvt_pk_bf16(x1[2], x1[3]) : 0u;
    return __builtin_bit_cast(bf16x8_t, w); }

#define STAGE_IDS int lane_q = lane_f, wave_q = wave_f, tid_q = tid_f; asm volatile("" : "+v"(lane_q), "+s"(wave_q), "+v"(tid_q)); const int lane = lane_q, wave = wave_q, tid = tid_q, lr = lane & 15, lq = lane >> 4; (void)tid; (void)lr; (void)lq; (void)wave;
#ifndef DN_PREFETCH
#define DN_PREFETCH 1
#endif
__device__ __forceinline__ void ph_dn_core2(const Args& a, lds_u8* lds, const bf16_t* GT, const bf16_t* XT, bf16_t* of, bf16_t* ob) {
    constexpr int LDN = 136, LDJ = 72;
    LAS bf16_t* qsb = (LAS bf16_t*)lds;
    LAS bf16_t* ksb = qsb + 64 * LDN;
    LAS bf16_t* kwT = ksb + 64 * LDN;
    LAS bf16_t* vT = kwT + 128 * LDJ;
    LAS bf16_t* Sb = vT + 128 * LDJ;
    LAS bf16_t* Pm = Sb + 128 * LDN;
    LAS bf16_t* AD = Pm + 64 * LDJ;
    LAS float* Ad = (LAS float*)(AD + 64 * LDJ);
    LAS float* Gv = Ad + 4 * 16 * 20;
    LAS float* eG = Gv + 64;
    LAS float* bet = eG + 64;
    LAS bf16_t* Os = ksb; LAS bf16_t* VnT = vT;
    const int tid = threadIdx.x, lane = tid & 63, wave = __builtin_amdgcn_readfirstlane(tid >> 6);
    const int tid_f = tid, lane_f = lane, wave_f = wave;
    const float* a_log = ARG_IN(12); const float* dtb = ARG_IN(13);
    for (int u = blockIdx.x; u < 192; u += gridDim.x) {
        int s, rr; if (u < 128) { s = u >> 5; rr = u & 31; } else { s = 4 + ((u - 128) >> 5); rr = (u - 128) & 31; }
        const int h = rr >> 1, d = rr & 1;
        const int L = seq_len(s), row0 = seq_start(s), nT = L >> 6;
        const float Aneg = -expf(a_log[d * 16 + h]), dtbias = dtb[d * 16 + h];
        pg8::f32x4 st[8];
#pragma unroll
        for (int q = 0; q < 8; ++q) st[q] = (pg8::f32x4){0.f, 0.f, 0.f, 0.f};
        for (int i = tid; i < 128 * LDN / 2; i += NTHR) ((LAS unsigned*)Sb)[i] = 0u;
        for (int i = tid; i < 64 * LDJ / 2; i += NTHR) ((LAS unsigned*)Pm)[i] = 0u;
        vu4 pq[2], pk[2], pv[2]; bf16_t pb, pa;
        { const int tile = d ? nT - 1 : 0; const size_t gt = (size_t)((row0 >> 6) + tile) * 768; const int tk = d ? 63 - lane : lane;
#pragma unroll
            for (int k = 0; k < 2; ++k) { const int cg = h * 16 + wave + 8 * k; pq[k] = *(const vu4*)(XT + ((gt + cg) * 64 + tk) * 8); pk[k] = *(const vu4*)(XT + ((gt + 256 + cg) * 64 + tk) * 8); pv[k] = *(const vu4*)(XT + ((gt + 512 + cg) * 64 + tk) * 8); }
            pb = GT[((size_t)((row0 >> 6) + tile) * 64 + d * 16 + h) * 64 + tk]; pa = GT[((size_t)((row0 >> 6) + tile) * 64 + 32 + d * 16 + h) * 64 + tk]; }
#pragma unroll 1
        for (int ti = 0; ti < nT; ++ti) {
            const int tile = d ? nT - 1 - ti : ti, t0 = tile * 64;
            float declast;
            { STAGE_IDS
            const float be = __builtin_amdgcn_rcpf(1.0f + __expf(-bf2f(pb)));
            const float G = wave_scan_incl(Aneg * softplus_fast(bf2f(pa) + dtbias));
            const float Glast = lane63(G), wgt = __expf(Glast - G); declast = __expf(Glast);
            if (wave == 0) { Gv[lane] = G; eG[lane] = __expf(G); bet[lane] = be; }
#pragma unroll
            for (int k = 0; k < 2; ++k) { const int c0 = (wave + 8 * k) * 8;
                *(LAS vu4*)(qsb + lane * LDN + c0) = pq[k];
                *(LAS vu4*)(ksb + lane * LDN + c0) = pk[k]; float kv[8]; unpack8(pk[k], kv);
#pragma unroll
                for (int j = 0; j < 8; ++j) { const float x = kv[j] * wgt; kwT[(c0 + j) * LDJ + lane] = (bf16_t)(pg8::cvt_pk_bf16(x, x) & 0xffffu); }
                const vu4 rawv = pv[k];
                vT[(c0 + 0) * LDJ + lane] = (bf16_t)(rawv.x & 0xffffu); vT[(c0 + 1) * LDJ + lane] = (bf16_t)(rawv.x >> 16); vT[(c0 + 2) * LDJ + lane] = (bf16_t)(rawv.y & 0xffffu); vT[(c0 + 3) * LDJ + lane] = (bf16_t)(rawv.y >> 16);
                vT[(c0 + 4) * LDJ + lane] = (bf16_t)(rawv.z & 0xffffu); vT[(c0 + 5) * LDJ + lane] = (bf16_t)(rawv.z >> 16); vT[(c0 + 6) * LDJ + lane] = (bf16_t)(rawv.w & 0xffffu); vT[(c0 + 7) * LDJ + lane] = (bf16_t)(rawv.w >> 16); }
#if DN_PREFETCH
            if (ti + 1 < nT) { const int tile2 = d ? nT - 2 - ti : ti + 1; const size_t gt = (size_t)((row0 >> 6) + tile2) * 768; const int tk = d ? 63 - lane : lane;
#pragma unroll
                for (int k = 0; k < 2; ++k) { const int cg = h * 16 + wave + 8 * k; pq[k] = *(const vu4*)(XT + ((gt + cg) * 64 + tk) * 8); pk[k] = *(const vu4*)(XT + ((gt + 256 + cg) * 64 + tk) * 8); pv[k] = *(const vu4*)(XT + ((gt + 512 + cg) * 64 + tk) * 8); }
                pb = GT[((size_t)((row0 >> 6) + tile2) * 64 + d * 16 + h) * 64 + tk]; pa = GT[((size_t)((row0 >> 6) + tile2) * 64 + 32 + d * 16 + h) * 64 + tk]; }
#endif
            }
            LDS_SYNC();
            { STAGE_IDS
            { bf16x8_t ja[3][4], jc[3][4]; float jgi[3], jbi[3]; vf4 jgj[3]; pg8::f32x4 jacc[3];
#define DN_JOB(jb) const int idr = wave + 8 * jb; const bool on = idr < 20; const int id = on ? idr : 19; const int kind = id >= 10 ? 1 : 0, pr = id - 10 * kind, it = pr >= 6 ? 3 : (pr >= 3 ? 2 : (pr >= 1 ? 1 : 0)), jt = pr - (it * (it + 1)) / 2; \
                const int ii = it * 16 + lr, j0 = jt * 16 + 4 * lq;
#define DN_JOB_LOAD(jb) { DN_JOB(jb) const LAS bf16_t* bsrc = kind ? qsb : ksb; \
                    _Pragma("unroll") for (int ks = 0; ks < 4; ++ks) { ja[jb][ks] = ldfrag(ksb, LDN, jt * 16, ks * 32, lane); jc[jb][ks] = ldfrag(bsrc, LDN, it * 16, ks * 32, lane); } \
                    jgi[jb] = Gv[ii]; jgj[jb] = *(const LAS vf4*)(Gv + j0); jbi[jb] = bet[ii]; }
#define DN_JOB_MM(jb) { jacc[jb] = (pg8::f32x4){0.f, 0.f, 0.f, 0.f}; \
                    _Pragma("unroll") for (int ks = 0; ks < 4; ++ks) jacc[jb] = MFMA16(ja[jb][ks], jc[jb][ks], jacc[jb]); }
#define DN_JOB_EPI(jb) { DN_JOB(jb) const pg8::f32x4 acc = jacc[jb]; const float gi = jgi[jb]; const vf4 gj = jgj[jb]; const float mul = kind ? 1.0f : jbi[jb]; const int lim = ii + kind; pg8::f32x4 o; \
                    o[0] = (j0 + 0 < lim) ? mul * acc[0] * __expf(gi - gj.x) : 0.f; o[1] = (j0 + 1 < lim) ? mul * acc[1] * __expf(gi - gj.y) : 0.f; \
                    o[2] = (j0 + 2 < lim) ? mul * acc[2] * __expf(gi - gj.z) : 0.f; o[3] = (j0 + 3 < lim) ? mul * acc[3] * __expf(gi - gj.w) : 0.f; \
                    if (on) { if (kind) stfragT(Pm, LDJ, it * 16, jt * 16, lane, o); \
                        else if (it == jt) *(LAS vf4*)(Ad + (it * 16 + lr) * 20 + 4 * lq) = (vf4){o[0], o[1], o[2], o[3]}; \
                        else stfragT(AD, LDJ, it * 16, jt * 16, lane, o); } }
                DN_JOB_LOAD(0)
                asm volatile("" ::: "memory");
                DN_JOB_MM(0) DN_JOB_LOAD(1) DN_JOB_EPI(0)
                asm volatile("" ::: "memory");
                DN_JOB_MM(1) DN_JOB_LOAD(2) DN_JOB_EPI(1)
                asm volatile("" ::: "memory");
                DN_JOB_MM(2) DN_JOB_EPI(2) }
            }
            LDS_SYNC();
            { STAGE_IDS
            if (wave == 0) { const int b = lane >> 4, j = lane & 15; float x[16];
                const LAS float* Ab = Ad + b * 16 * 20;
                vf4 ar[16][4];
#define DN_INV_LD(r) { _Pragma("unroll") for (int r4 = 0; r4 < ((r) + 3) / 4; ++r4) ar[r][r4] = *(const LAS vf4*)(Ab + (r) * 20 + r4 * 4); }
#define DN_INV_ROW(r) { float s0 = ((r) == j) ? 1.0f : 0.0f, s1 = 0.f; \
                    _Pragma("unroll") for (int r4 = 0; r4 < ((r) + 3) / 4; ++r4) { const vf4 av = ar[r][r4]; \
                        if (r4 * 4 + 0 < (r)) s0 -= av.x * x[r4 * 4 + 0]; if (r4 * 4 + 1 < (r)) s1 -= av.y * x[r4 * 4 + 1]; if (r4 * 4 + 2 < (r)) s0 -= av.z * x[r4 * 4 + 2]; if (r4 * 4 + 3 < (r)) s1 -= av.w * x[r4 * 4 + 3]; } \
                    x[r] = s0 + s1; }
                DN_INV_LD(1) DN_INV_LD(2) DN_INV_LD(3) DN_INV_LD(4) DN_INV_LD(5) DN_INV_LD(6) DN_INV_LD(7) DN_INV_LD(8)
                asm volatile("" ::: "memory");
                DN_INV_ROW(0) DN_INV_ROW(1) DN_INV_ROW(2) DN_INV_ROW(3) DN_INV_ROW(4)
                DN_INV_LD(9) DN_INV_LD(10)
                asm volatile("" ::: "memory");
                DN_INV_ROW(5) DN_INV_ROW(6) DN_INV_ROW(7) DN_INV_ROW(8)
                DN_INV_LD(11) DN_INV_LD(12)
                asm volatile("" ::: "memory");
                DN_INV_ROW(9) DN_INV_ROW(10)
                DN_INV_LD(13) DN_INV_LD(14)
                asm volatile("" ::: "memory");
                DN_INV_ROW(11) DN_INV_ROW(12)
                DN_INV_LD(15)
                asm volatile("" ::: "memory");
                DN_INV_ROW(13) DN_INV_ROW(14) DN_INV_ROW(15)
#pragma unroll
                for (int r = 0; r < 16; ++r) AD[(16 * b + r) * LDJ + 16 * b + j] = (bf16_t)(pg8::cvt_pk_bf16(x[r], x[r]) & 0xffffu); }
            }
            pg8::f32x4 ao[4], Rr[4];
            { STAGE_IDS
            { bf16x8_t sbf[4], tf[8][4]; vf4 tb4[4], te4[4]; vu2 tvr[4];
#pragma unroll
                for (int ks = 0; ks < 4; ++ks) sbf[ks] = ldfrag(Sb, LDN, wave * 16, ks * 32, lane);
#define DN_T_LOAD(t) { if ((t) < 4) { _Pragma("unroll") for (int ks = 0; ks < 4; ++ks) tf[t][ks] = ldfrag(qsb, LDN, (t) * 16, ks * 32, lane); } \
                    else { _Pragma("unroll") for (int ks = 0; ks < 4; ++ks) tf[t][ks] = ldfrag(ksb, LDN, ((t) - 4) * 16, ks * 32, lane); \
                        const int j0 = ((t) - 4) * 16 + 4 * lq; tb4[(t) & 3] = *(const LAS vf4*)(bet + j0); te4[(t) & 3] = *(const LAS vf4*)(eG + j0); tvr[(t) & 3] = *(const LAS vu2*)(vT + (wave * 16 + lr) * LDJ + j0); } }
#define DN_T_COMP(t) { pg8::f32x4 acc = (pg8::f32x4){0.f, 0.f, 0.f, 0.f}; \
                    if ((t) < 4) { _Pragma("unroll") for (int ks = 0; ks < 4; ++ks) acc = MFMA16(sbf[ks], tf[t][ks], acc); ao[(t) & 3] = acc; } \
                    else { _Pragma("unroll") for (int ks = 0; ks < 4; ++ks) acc = MFMA16(tf[t][ks], sbf[ks], acc); \
                        const vf4 b4 = tb4[(t) & 3], e4 = te4[(t) & 3]; const vu2 vr = tvr[(t) & 3]; \
                        Rr[(t) & 3][0] = b4.x * (__uint_as_float(vr.x << 16) - e4.x * acc[0]); Rr[(t) & 3][1] = b4.y * (__uint_as_float(vr.x & 0xffff0000u) - e4.y * acc[1]); \
                        Rr[(t) & 3][2] = b4.z * (__uint_as_float(vr.y << 16) - e4.z * acc[2]); Rr[(t) & 3][3] = b4.w * (__uint_as_float(vr.y & 0xffff0000u) - e4.w * acc[3]); } }
                DN_T_LOAD(0)
                asm volatile("" ::: "memory");
                DN_T_LOAD(1) DN_T_COMP(0)
                asm volatile("" ::: "memory");
                DN_T_LOAD(2) DN_T_COMP(1)
                asm volatile("" ::: "memory");
                DN_T_LOAD(3) DN_T_COMP(2)
                asm volatile("" ::: "memory");
                DN_T_LOAD(4) DN_T_COMP(3)
                asm volatile("" ::: "memory");
                DN_T_LOAD(5) DN_T_COMP(4)
                asm volatile("" ::: "memory");
                DN_T_LOAD(6) DN_T_COMP(5)
                asm volatile("" ::: "memory");
                DN_T_LOAD(7) DN_T_COMP(6)
                asm volatile("" ::: "memory");
                DN_T_COMP(7) }
            }
            LDS_SYNC();
            { STAGE_IDS
            { const pg8::f32x4 z4 = (pg8::f32x4){0.f, 0.f, 0.f, 0.f};
                const bf16x8_t f00 = dn_afrag2(AD, 0 + lr, 0, -1, lq), f10 = dn_afrag2(AD, 16 + lr, 0, -1, lq), f11 = dn_afrag2(AD, 16 + lr, 1, -1, lq), f20 = dn_afrag2(AD, 32 + lr, 0, 1, lq), f22 = dn_afrag2(AD, 32 + lr, 2, -1, lq),
                    f30 = dn_afrag2(AD, 48 + lr, 0, 1, lq), f32 = dn_afrag2(AD, 48 + lr, 2, -1, lq), f33 = dn_afrag2(AD, 48 + lr, 3, -1, lq);
                asm volatile("" ::: "memory");
                const pg8::f32x4 V0 = MFMA16(f00, dn_bfrag2(Rr[0], z4, false), z4);
                const pg8::f32x4 U1 = MFMA16(f10, dn_bfrag2(V0, z4, false), z4);
                const pg8::f32x4 V1 = MFMA16(f11, dn_bfrag2(Rr[1] - U1, z4, false), z4);
                const pg8::f32x4 U2 = MFMA16(f20, dn_bfrag2(V0, V1, true), z4);
                const pg8::f32x4 V2 = MFMA16(f22, dn_bfrag2(Rr[2] - U2, z4, false), z4);
                pg8::f32x4 U3 = MFMA16(f30, dn_bfrag2(V0, V1, true), z4);
                U3 = MFMA16(f32, dn_bfrag2(V2, z4, false), U3);
                const pg8::f32x4 V3 = MFMA16(f33, dn_bfrag2(Rr[3] - U3, z4, false), z4);
                stfragT(VnT, LDJ, wave * 16, 0, lane, V0); stfragT(VnT, LDJ, wave * 16, 16, lane, V1); stfragT(VnT, LDJ, wave * 16, 32, lane, V2); stfragT(VnT, LDJ, wave * 16, 48, lane, V3); }
            }
            LDS_SYNC();
            { STAGE_IDS
            { bf16x8_t vn[2], pm[4][2], kw[2], vv[8][2]; float eg[4];
#pragma unroll
                for (int ks = 0; ks < 2; ++ks) { vn[ks] = ldfrag(VnT, LDJ, wave * 16, ks * 32, lane); kw[ks] = ldfrag(kwT, LDJ, wave * 16, ks * 32, lane); }
#pragma unroll
                for (int it = 0; it < 4; ++it) { eg[it] = eG[it * 16 + lr]; pm[it][0] = ldfrag(Pm, LDJ, it * 16, 0, lane); if (it >= 2) pm[it][1] = ldfrag(Pm, LDJ, it * 16, 32, lane); }
#define DN_V_LOAD(vt) { vv[vt][0] = ldfrag(VnT, LDJ, (vt) * 16, 0, lane); vv[vt][1] = ldfrag(VnT, LDJ, (vt) * 16, 32, lane); }
#define DN_V_COMP(vt) { st[vt] = st[vt] * declast; st[vt] = MFMA16(kw[0], vv[vt][0], st[vt]); st[vt] = MFMA16(kw[1], vv[vt][1], st[vt]); }
                DN_V_LOAD(0) DN_V_LOAD(1)
                asm volatile("" ::: "memory");
#pragma unroll
                for (int it = 0; it < 4; ++it) { ao[it] = ao[it] * eg[it];
                    ao[it] = MFMA16(vn[0], pm[it][0], ao[it]);
                    if (it >= 2) ao[it] = MFMA16(vn[1], pm[it][1], ao[it]);
                    stfragT(Os, LDN, it * 16, wave * 16, lane, ao[it]); }
                asm volatile("" ::: "memory");
                DN_V_LOAD(2) DN_V_LOAD(3) DN_V_COMP(0) DN_V_COMP(1)
                asm volatile("" ::: "memory");
                DN_V_LOAD(4) DN_V_LOAD(5) DN_V_COMP(2) DN_V_COMP(3)
                asm volatile("" ::: "memory");
                DN_V_LOAD(6) DN_V_LOAD(7) DN_V_COMP(4) DN_V_COMP(5)
                asm volatile("" ::: "memory");
                DN_V_COMP(6) DN_V_COMP(7) }
            }
            LDS_SYNC();
            { STAGE_IDS
#pragma unroll
            for (int vt = 0; vt < 8; ++vt) stfragT(Sb, LDN, vt * 16, wave * 16, lane, st[vt]);
            { const int i = tid >> 3, v16 = (tid & 7) * 16;
                bf16_t* dst = (d ? ob : of) + (size_t)(row0 + t0 + (d ? 63 - i : i)) * DM + h * 128 + v16;
                const vu4 o0 = *(const LAS vu4*)(Os + i * LDN + v16), o1 = *(const LAS vu4*)(Os + i * LDN + v16 + 8); *(vu4*)dst = o0; *(vu4*)(dst + 8) = o1; }
            }
            LDS_SYNC();
        }
    }
}

constexpr int HY_LD = 6144;
__device__ __forceinline__ void ph_hy_prep(const Args& a, lds_u8* lds, const bf16_t* proj, bf16_t* sT) {
    LAS float* tile = (LAS float*)lds;
    const int tid = threadIdx.x;
    const float* cw = ARG_IN(35);
    for (int u = blockIdx.x; u < 640 * 8; u += gridDim.x) {
        const int tt = u >> 3, ct = u & 7, row_t0 = tt * 64, c0 = ct * 256;
        const int s = seq_of_row(row_t0), L = seq_len(s), rs = seq_start(s), t0 = row_t0 - rs;
        { const int t = tid >> 3, c8s = (tid & 7) * 8;
            vu4 r1[4][3], r2[4][3];
#pragma unroll
            for (int q = 0; q < 4; ++q)
#pragma unroll
                for (int tap = 0; tap < 3; ++tap) { const int tq = t0 + t + tap - 1; r1[q][tap] = (vu4){0u, 0u, 0u, 0u}; r2[q][tap] = (vu4){0u, 0u, 0u, 0u};
                    if (tq >= 0 && tq < L) { const bf16_t* pr = proj + (size_t)(rs + tq) * HY_LD + c0 + q * 64 + c8s; r1[q][tap] = *(const vu4*)(pr + 2048); r2[q][tap] = *(const vu4*)(pr + 4096); } }
#pragma unroll
            for (int q = 0; q < 4; ++q) { float x1[8], vv[8];
#pragma unroll
                for (int j = 0; j < 8; ++j) { x1[j] = 0.f; vv[j] = 0.f; }
#pragma unroll
                for (int tap = 0; tap < 3; ++tap) { float f1[8], f2[8], w1[8], w2[8]; unpack8(r1[q][tap], f1); unpack8(r2[q][tap], f2);
                    load8f(cw + tap * 6144 + 2048 + c0 + q * 64 + c8s, w1); load8f(cw + tap * 6144 + 4096 + c0 + q * 64 + c8s, w2);
#pragma unroll
                    for (int j = 0; j < 8; ++j) { x1[j] += w1[j] * f1[j]; vv[j] += w2[j] * f2[j]; } }
#pragma unroll
                for (int j = 0; j < 8; ++j) tile[(q * 64 + c8s + j) * 65 + t] = x1[j] * vv[j]; } }
        LDS_SYNC();
        { const int c = tid >> 1, th = (tid & 1) * 32; bf16_t* dst = sT + (size_t)rs * DM + (size_t)(c0 + c) * L + t0 + th;
#pragma unroll
            for (int k = 0; k < 4; ++k) { float o[8];
#pragma unroll
                for (int j = 0; j < 8; ++j) o[j] = tile[c * 65 + th + k * 8 + j];
                *(vu4*)(dst + k * 8) = pack8(o); } }
        LDS_SYNC();
    }
}
__device__ __forceinline__ void ph_hy_fwoT(const float* fwo, bf16_t* fwoT) {
    for (int i8 = blockIdx.x * NTHR + threadIdx.x; i8 < 4096 * 8; i8 += gridDim.x * NTHR) { const int dcol = i8 >> 3, k0 = (i8 & 7) * 8; float v[8];
#pragma unroll
        for (int j = 0; j < 8; ++j) v[j] = fwo[(size_t)(k0 + j) * 4096 + dcol];
        *(vu4*)(fwoT + (size_t)dcol * 64 + k0) = pack8(v); }
}
__device__ __forceinline__ void ph_hy_filter(const Args& a, lds_u8* lds, const bf16_t* fwoT, float* hf8, float* hb8, float* hf4, float* hb4, int rank, int nrank) {
    LAS float* hA = (LAS float*)lds;
    LAS float* hB = hA + 64 * 64;
    LAS bf16_t* hdb = (LAS bf16_t*)(hB + 64 * 64);
    LAS float* outs = (LAS float*)(lds + 49152);
    const int tid = threadIdx.x, lane = tid & 63, wave = __builtin_amdgcn_readfirstlane(tid >> 6), lr = lane & 15, lq = lane >> 4;
    const float* fw1 = ARG_IN(36); const float* fb1 = ARG_IN(37); const float* fw2 = ARG_IN(38); const float* fb2 = ARG_IN(39);
    const float* fw3 = ARG_IN(40); const float* fb3 = ARG_IN(41); const float* freq = ARG_IN(43);
    for (int u = rank; u < 192; u += nrank) {
        int L, tt; if (u < 128) { L = 8192; tt = u; } else { L = 4096; tt = u - 128; }
        const int t0 = tt * 64; const float invLm1 = 1.0f / (float)(L - 1);
#pragma unroll 1
        for (int idx = tid; idx < 64 * 33; idx += NTHR) { const int t = idx / 33, f = idx % 33, ti = t0 + t; float val;
            if (f == 0) val = (float)ti / (float)(L - 1);
            else { const int j = (f - 1) & 15; const float fr = 1e-4f + (float)j * ((15.0f - 1e-4f) / 15.0f); float rev = fr * ((float)ti / (float)L); rev -= floorf(rev);
                const float ang = 6.283185307179586f * rev; val = f <= 16 ? cosf(ang) : -sinf(ang); }
            hA[t * 64 + f] = val; }
        LDS_SYNC();
        { const int t = tid >> 3, c8 = (tid & 7) * 8; float acc[8];
            load8f(fb1 + c8, acc);
#pragma unroll 1
            for (int f = 0; f < 33; ++f) { const float z = hA[t * 64 + f]; float w[8]; load8f(fw1 + f * 64 + c8, w);
#pragma unroll
                for (int j = 0; j < 8; ++j) acc[j] += z * w[j]; }
            float fq[8]; load8f(freq + c8, fq);
#pragma unroll
            for (int j = 0; j < 8; ++j) hB[t * 64 + c8 + j] = sinf(fq[j] * acc[j]); }
        LDS_SYNC();
        { const int t = tid >> 3, c8 = (tid & 7) * 8; float acc[8];
            load8f(fb2 + c8, acc);
#pragma unroll 2
            for (int f = 0; f < 64; ++f) { const float z = hB[t * 64 + f]; float w[8]; load8f(fw2 + f * 64 + c8, w);
#pragma unroll
                for (int j = 0; j < 8; ++j) acc[j] += z * w[j]; }
            float fq[8]; load8f(freq + 64 + c8, fq);
#pragma unroll
            for (int j = 0; j < 8; ++j) hA[t * 64 + c8 + j] = sinf(fq[j] * acc[j]); }
        LDS_SYNC();
        { const int t = tid >> 3, c8 = (tid & 7) * 8; float acc[8];
            load8f(fb3 + c8, acc);
#pragma unroll 2
            for (int f = 0; f < 64; ++f) { const float z = hA[t * 64 + f]; float w[8]; load8f(fw3 + f * 64 + c8, w);
#pragma unroll
                for (int j = 0; j < 8; ++j) acc[j] += z * w[j]; }
            float fq[8], o[8]; load8f(freq + 128 + c8, fq);
#pragma unroll
            for (int j = 0; j < 8; ++j) o[j] = sinf(fq[j] * acc[j]);
            *(LAS vu4*)(hdb + t * 72 + c8) = pack8(o); }
        LDS_SYNC();
        bf16x8_t Af[4][2];
#pragma unroll
        for (int tq = 0; tq < 4; ++tq)
#pragma unroll
            for (int ks = 0; ks < 2; ++ks) Af[tq][ks] = ldfrag(hdb, 72, tq * 16, ks * 32, lane);
        const float min_decay = -3.0701134573253944f, max_decay = -15.350567286626972f;
#pragma unroll 1
        for (int dc = 0; dc < 16; ++dc) {
#pragma unroll
            for (int q = 0; q < 2; ++q) { const int dcol = dc * 256 + wave * 32 + q * 16 + lr, ch = dcol & 2047;
                const bf16x8_t B0 = *(const bf16x8_t*)(fwoT + (size_t)dcol * 64 + 8 * lq), B1 = *(const bf16x8_t*)(fwoT + (size_t)dcol * 64 + 32 + 8 * lq);
                const float delta = (min_decay + (float)ch * ((max_decay - min_decay) / 2047.0f)) * invLm1;
                const float wb = __expf(delta * (float)(t0 + 4 * lq)), r1 = __expf(delta), r2 = r1 * r1, r3 = r2 * r1, r16 = __expf(16.0f * delta);
                float wt = wb;
#pragma unroll
                for (int tq = 0; tq < 4; ++tq) { pg8::f32x4 acc = (pg8::f32x4){0.f, 0.f, 0.f, 0.f};
                    acc = MFMA16(Af[tq][0], B0, acc); acc = MFMA16(Af[tq][1], B1, acc);
                    *(LAS vf4*)(outs + (wave * 32 + q * 16 + lr) * 68 + tq * 16 + 4 * lq) = (vf4){acc[0] * wt, acc[1] * (wt * r1), acc[2] * (wt * r2), acc[3] * (wt * r3)};
                    wt *= r16; } }
            LDS_SYNC();
            { const int dl = tid >> 1, th = (tid & 1) * 32, dcol = dc * 256 + dl, dir = dcol >> 11, ch = dcol & 2047;
                float* dst = (L == 8192 ? (dir ? hb8 : hf8) : (dir ? hb4 : hf4)) + (size_t)ch * L + t0 + th;
#pragma unroll
                for (int k = 0; k < 8; ++k) *(vf4*)(dst + k * 4) = *(const LAS vf4*)(outs + dl * 68 + th + k * 4); }
            LDS_SYNC();
        }
    }
}

template <int M, int Q, bool INV, int LS>
__device__ __forceinline__ void fft_group(vf2 (&v)[1 << Q], const int bl) {
    constexpr int R = 1 << Q, s0 = M - LS - Q;
    const float invN = 1.0f / (float)(1 << M);
    const float th0 = (float)(bl << s0) * invN;
    vf2 bp[Q]; bp[0] = (vf2){__builtin_amdgcn_cosf(th0), __builtin_amdgcn_sinf(th0)};
#pragma unroll
    for (int q = 1; q < Q; ++q) { const vf2 t = bp[q - 1]; bp[q] = (vf2){t.x * t.x - t.y * t.y, 2.0f * t.x * t.y}; }
#pragma unroll
    for (int qq = 0; qq < Q; ++qq) {
        const int q = INV ? Q - 1 - qq : qq;
        const int span = R >> (q + 1);
        float bqx = bp[q].x, bqy = bp[q].y; asm volatile("" : "+v"(bqx), "+v"(bqy), "+v"(v[0].x));
#pragma unroll
        for (int rl = 0; rl < span; ++rl) {
            const float cr = (float)__builtin_cos(6.283185307179586 * (rl << q) / R), sr = (float)__builtin_sin(6.283185307179586 * (rl << q) / R);
            const float c = rl == 0 ? bqx : bqx * cr - bqy * sr, sn = rl == 0 ? bqy : bqy * cr + bqx * sr;
#pragma unroll
            for (int rh = 0; rh < R; rh += 2 * span) { const int r = rh + rl;
                if (!INV) { const vf2 x = v[r], y = v[r + span]; v[r] = (vf2){x.x + y.x, x.y + y.y}; const float dx = x.x - y.x, dy = x.y - y.y;
                    v[r + span] = (vf2){dx * c + dy * sn, dy * c - dx * sn}; }
                else { const vf2 x = v[r], y = v[r + span]; const float bx = y.x * c - y.y * sn, by = y.y * c + y.x * sn;
                    v[r] = (vf2){x.x + bx, x.y + by}; v[r + span] = (vf2){x.x - bx, x.y - by}; } }
        }
    }
}
template <int M, int Q, bool INV, int LS>
__device__ __forceinline__ void fft_pass(LAS vf2* X, const int tid_in) {
    int tid = tid_in; asm volatile("" : "+v"(tid));
    constexpr int R = 1 << Q, HR = R / 2;
    constexpr int m = M, s0 = M - LS - Q, lstride = LS, stride = 1 << LS, groups = 1 << (M - Q);
    const float invN = 1.0f / (float)(1 << m);
#pragma unroll 1
    for (int g = tid; g < groups; g += NTHR) {
        const int bl = g & (stride - 1), bh = g >> lstride, base = (bh << (lstride + Q)) + bl;
        const int pb = LS >= 4 ? base + (base >> 4) : (LS + Q >= 4 ? base + (bh << (LS + Q - 4)) : base + (base >> 4));
#define FFT_POFF(r) (LS >= 4 ? (r) * ((1 << LS) + (1 << (LS >= 4 ? LS - 4 : 0))) : (LS + Q >= 4 ? ((r) << LS) + ((r) >> (4 - LS)) : (r)))
        vf2 v[R];
#pragma unroll
        for (int r = 0; r < R; ++r) v[r] = X[pb + FFT_POFF(r)];
            fft_group<M, Q, INV, LS>(v, bl);
#pragma unroll
        for (int r = 0; r < R; ++r) X[pb + FFT_POFF(r)] = v[r];
    }
}
template <int M> __device__ __forceinline__ void fft_fwd(LAS vf2* X, const int tid) {
    fft_pass<M, 4, false, M - 4>(X, tid); __syncthreads(); fft_pass<M, 4, false, M - 8>(X, tid); __syncthreads(); fft_pass<M, 4, false, M - 12>(X, tid); __syncthreads();
    fft_pass<M, M - 12, false, 0>(X, tid); __syncthreads(); }
template <int M>
__device__ __forceinline__ void fft_conv(LAS vf2* X, const int tid_in, const vf2* FS) {
    constexpr int groups = 1 << (M - 4);
    fft_pass<M, M - 12, false, 12>(X, tid_in); __syncthreads(); fft_pass<M, 4, false, 8>(X, tid_in); __syncthreads(); fft_pass<M, 4, false, 4>(X, tid_in); __syncthreads();
    int tid = tid_in; asm volatile("" : "+v"(tid));
    vf4 fA[8];
#pragma unroll
    for (int k = 0; k < 8; ++k) fA[k] = ((const vf4*)FS)[(unsigned)(8 * tid + k)];
    { const int pb = 17 * tid;
        vf2 v[16];
#pragma unroll
        for (int r = 0; r < 16; ++r) v[r] = X[pb + r];
        fft_group<M, 4, false, 0>(v, 0);
#pragma unroll
        for (int r = 0; r < 16; ++r) { const float fx = (r & 1) ? fA[r >> 1].z : fA[r >> 1].x, fy = (r & 1) ? fA[r >> 1].w : fA[r >> 1].y; const vf2 t = v[r]; v[r] = (vf2){t.x * fx - t.y * fy, t.x * fy + t.y * fx}; }
        fft_group<M, 4, true, 0>(v, 0);
#pragma unroll
        for (int r = 0; r < 16; ++r) X[pb + r] = v[r];
        if (groups > NTHR) { const int pb2 = 17 * (tid + NTHR);
            asm volatile("" ::: "memory");
            vf4 fB[8];
#pragma unroll
            for (int k = 0; k < 8; ++k) fB[k] = ((const vf4*)FS)[(unsigned)(8 * (tid + NTHR) + k)];
#pragma unroll
            for (int r = 0; r < 16; ++r) v[r] = X[pb2 + r];
            fft_group<M, 4, false, 0>(v, 0);
#pragma unroll
            for (int r = 0; r < 16; ++r) { const float fx = (r & 1) ? fB[r >> 1].z : fB[r >> 1].x, fy = (r & 1) ? fB[r >> 1].w : fB[r >> 1].y; const vf2 t = v[r]; v[r] = (vf2){t.x * fx - t.y * fy, t.x * fy + t.y * fx}; }
            fft_group<M, 4, true, 0>(v, 0);
#pragma unroll
            for (int r = 0; r < 16; ++r) X[pb2 + r] = v[r]; } }
    __syncthreads();
    fft_pass<M, 4, true, 4>(X, tid_in); __syncthreads(); fft_pass<M, 4, true, 8>(X, tid_in); __syncthreads(); fft_pass<M, M - 12, true, 12>(X, tid_in); __syncthreads();
}

template <int M>
__device__ __forceinline__ void hy_filter_spectra(LAS vf2* X, const int tid_in, const float* hfa, const float* hba, const float* hfb, const float* hbb, vf2* FSa, vf2* FSb) {
    constexpr int N = 1 << M, L = N >> 1;
    int tid = tid_in; asm volatile("" : "+v"(tid));
    { float va[N / NTHR], vb[N / NTHR];
#pragma unroll
        for (int j = 0; j < N / NTHR; ++j) { const int i = tid + NTHR * j; if (i < L) { va[j] = hfa[i]; vb[j] = hfb[i]; } else if (i == L) { va[j] = 0.f; vb[j] = 0.f; } else { va[j] = hba[N - i]; vb[j] = hbb[N - i]; } }
#pragma unroll
        for (int j = 0; j < N / NTHR; ++j) { const int i = tid + NTHR * j; X[i + (i >> 4)] = (vf2){va[j], vb[j]}; } }
    __syncthreads();
    fft_fwd<M>(X, tid);
    constexpr float sc = 0.5f / (float)N;
#pragma unroll 8
    for (int p = tid; p < N; p += NTHR) { const int k = (int)(__builtin_bitreverse32((unsigned)p) >> (32 - M)), kq = (N - k) & (N - 1), q = (int)(__builtin_bitreverse32((unsigned)kq) >> (32 - M));
        const vf2 zp = X[p + (p >> 4)], zq = X[q + (q >> 4)];
        FSa[p] = (vf2){(zp.x + zq.x) * sc, (zp.y - zq.y) * sc};
        FSb[p] = (vf2){(zp.y + zq.y) * sc, (zq.x - zp.x) * sc}; }
    __syncthreads();
}
template <int M, int NPAIR>
__device__ __forceinline__ void hy_fft_pairs(LAS vf2* X, const int tid_in, bf16_t* sA, const vf2* FSa, const vf2* FSb, const float fba, const float fbb, const vu4 (&first0)[(1 << (M - 1)) / 8 / NTHR], const vu4 (&first1)[(1 << (M - 1)) / 8 / NTHR]) {
    constexpr int N = 1 << M, L = N >> 1, NCH = L / 8 / NTHR;
    vu4 nin0[NCH], nin1[NCH];
#define HYP_SEQ(q_, k_) (sA + (size_t)((q_) / NPAIR) * L + (size_t)(2 * ((q_) % NPAIR) + (k_)) * L * DM)
#pragma unroll
    for (int j = 0; j < NCH; ++j) { nin0[j] = first0[j]; nin1[j] = first1[j]; }
#pragma unroll 1
    for (int q = 0; q < 2 * NPAIR; ++q) {
        int tid = tid_in; asm volatile("" : "+v"(tid));
        bf16_t* s0 = HYP_SEQ(q, 0); bf16_t* s1 = HYP_SEQ(q, 1);
        const vf2* FS = q < NPAIR ? FSa : FSb; const float fbias = q < NPAIR ? fba : fbb;
        vu4 in0[NCH], in1[NCH];
#pragma unroll
        for (int j = 0; j < NCH; ++j) { in0[j] = nin0[j]; in1[j] = nin1[j]; }
#pragma unroll 8
        for (int i = L + tid; i < N; i += NTHR) X[i + (i >> 4)] = (vf2){0.f, 0.f};
#pragma unroll
        for (int j = 0; j < NCH; ++j) { const int c = tid + NTHR * j; float f0[8], f1[8]; unpack8(in0[j], f0); unpack8(in1[j], f1);
#pragma unroll
            for (int e = 0; e < 8; ++e) { const int i = c * 8 + e; X[i + (i >> 4)] = (vf2){f0[e], f1[e]}; } }
        if (q + 1 < 2 * NPAIR) {
#pragma unroll
            for (int j = 0; j < NCH; ++j) { const int c = tid + NTHR * j; nin0[j] = ((const vu4*)HYP_SEQ(q + 1, 0))[(unsigned)c]; nin1[j] = ((const vu4*)HYP_SEQ(q + 1, 1))[(unsigned)c]; } }
        __syncthreads();
        fft_conv<M>(X, tid, FS);
#pragma unroll
        for (int j = 0; j < NCH; ++j) { const int c = tid + NTHR * j; float f0[8], f1[8], o0[8], o1[8]; unpack8(in0[j], f0); unpack8(in1[j], f1);
#pragma unroll
            for (int e = 0; e < 8; ++e) { const int i = c * 8 + e; const vf2 t = X[i + (i >> 4)]; o0[e] = t.x + f0[e] * fbias; o1[e] = t.y + f1[e] * fbias; }
            ((vu4*)s0)[(unsigned)c] = pack8(o0); ((vu4*)s1)[(unsigned)c] = pack8(o1); }
        __syncthreads();
    }
}
__device__ __forceinline__ void ph_hy_fft(lds_u8* lds, bf16_t* sT, const float* hf8, const float* hb8, const float* hf4, const float* hb4, vf2* FSall, const float* fbias) {
    LAS vf2* X = (LAS vf2*)lds;
    const int tid = threadIdx.x;
    vf2* FSa = FSall + (size_t)blockIdx.x * 32768; vf2* FSb = FSa + 16384;
    for (int cp = blockIdx.x; cp < DM / 2; cp += gridDim.x) {
        const int ca = 2 * cp, cb = ca + 1; const float fba = fbias[ca], fbb = fbias[cb];
        vu4 f8a[2], f8b[2];
#pragma unroll
        for (int j = 0; j < 2; ++j) { const unsigned c = (unsigned)(tid + NTHR * j); f8a[j] = ((const vu4*)(sT + (size_t)ca * 8192))[c]; f8b[j] = ((const vu4*)(sT + (size_t)ca * 8192 + (size_t)8192 * DM))[c]; }
        hy_filter_spectra<14>(X, tid, hf8 + (size_t)ca * 8192, hb8 + (size_t)ca * 8192, hf8 + (size_t)cb * 8192, hb8 + (size_t)cb * 8192, FSa, FSb);
        hy_fft_pairs<14, 2>(X, tid, sT + (size_t)ca * 8192, FSa, FSb, fba, fbb, f8a, f8b);
        vu4 f4a[1], f4b[1];
        { const unsigned c = (unsigned)tid; f4a[0] = ((const vu4*)(sT + (size_t)32768 * DM + (size_t)ca * 4096))[c]; f4b[0] = ((const vu4*)(sT + (size_t)32768 * DM + (size_t)ca * 4096 + (size_t)4096 * DM))[c]; }
        hy_filter_spectra<13>(X, tid, hf4 + (size_t)ca * 4096, hb4 + (size_t)ca * 4096, hf4 + (size_t)cb * 4096, hb4 + (size_t)cb * 4096, FSa, FSb);
        hy_fft_pairs<13, 1>(X, tid, sT + (size_t)32768 * DM + (size_t)ca * 4096, FSa, FSb, fba, fbb, f4a, f4b);
    }
}
__device__ __forceinline__ void ph_hy_post(const Args& a, lds_u8* lds, const bf16_t* proj, const bf16_t* sT, bf16_t* Yo) {
    LAS float* tile = (LAS float*)lds;
    const int tid = threadIdx.x;
    const float* cw = ARG_IN(35);
    for (int u = blockIdx.x; u < 640 * 8; u += gridDim.x) {
        const int tt = u >> 3, ct = u & 7, row_t0 = tt * 64, c0 = ct * 256;
        const int s = seq_of_row(row_t0), L = seq_len(s), rs = seq_start(s), t0 = row_t0 - rs;
        { const int c = tid >> 1, th = (tid & 1) * 32; const bf16_t* src = sT + (size_t)rs * DM + (size_t)(c0 + c) * L + t0 + th;
            vu4 w[4];
#pragma unroll
            for (int k = 0; k < 4; ++k) w[k] = *(const vu4*)(src + k * 8);
#pragma unroll
            for (int k = 0; k < 4; ++k) { float o[8]; unpack8(w[k], o);
#pragma unroll
                for (int j = 0; j < 8; ++j) tile[c * 65 + th + k * 8 + j] = o[j]; } }
        LDS_SYNC();
        { const int t = tid >> 3, c8s = (tid & 7) * 8;
#pragma unroll
            for (int q = 0; q < 4; ++q) { float x0[8], o[8]; const int cc = c0 + q * 64 + c8s;
#pragma unroll
                for (int j = 0; j < 8; ++j) x0[j] = 0.f;
#pragma unroll
                for (int tap = 0; tap < 3; ++tap) { const int tq = t0 + t + tap - 1;
                    if (tq >= 0 && tq < L) { float r0[8], w0[8]; unpack8(*(const vu4*)(proj + (size_t)(rs + tq) * HY_LD + cc), r0); load8f(cw + tap * 6144 + cc, w0);
#pragma unroll
                        for (int j = 0; j < 8; ++j) x0[j] += w0[j] * r0[j]; } }
#pragma unroll
                for (int j = 0; j < 8; ++j) o[j] = tile[(q * 64 + c8s + j) * 65 + t] * x0[j];
                *(vu4*)(Yo + (size_t)(row_t0 + t) * DM + cc) = pack8(o); } }
        LDS_SYNC();
    }
}

#ifndef MK_PER_PHASE
#define MK_PER_PHASE 0
#endif
constexpr int N_PHASES = 37;

template <class Epi>
__device__ __forceinline__ void run_gemm(lds_u8* lds, const bf16_t* A, const bf16_t* Bt, int N, int K, const Epi& E) {
    pg8::Gemm g{A, Bt, NTOK, N, K, K, K}; pg8::StaticOrder S; S.init(NTOK, N, (int)gridDim.x, (int)blockIdx.x);
    pg8::gemm_phase<Epi, pg8::StaticOrder, true, true>(lds, g, S, E);
}

__global__ void __launch_bounds__(512, 2) mega_fwd(const Args args) {
    extern __shared__ __attribute__((aligned(16))) unsigned char shm[];
    lds_u8* lds = (lds_u8*)shm;
    const int lo = args.ph_lo, hi = args.ph_hi;
    XcdBarrier bar; bar.bar = (unsigned*)(args.ws + WS_BAR); bar.x = 0; bar.st = nullptr;
    if (hi - lo > 1) {
        if (threadIdx.x == 0) *(LAS vu4*)(lds + LDS_BAR_OFF) = (vu4){0u, 0u, 0u, 0u};
        __syncthreads();
        bar = xcd_barrier_post((unsigned*)(args.ws + WS_BAR), (volatile LAS unsigned*)(lds + LDS_BAR_OFF));
    }
#ifdef ONLY_PHASE
#define IN(k) ((k) == ONLY_PHASE && lo <= (k) && (k) < hi)
#else
#define IN(k) (lo <= (k) && (k) < hi)
#endif
#define SEAM(k) do { if (IN((k) + 1)) xcd_barrier(bar); } while (0)
#ifndef DUPMASK
#define DUPMASK 0ull
#endif
#define DUP(k) ((DUPMASK >> (k)) & 1ull)
#define PH(k, ...) if (IN(k)) { __VA_ARGS__ if (DUP(k)) { xcd_barrier(bar); __VA_ARGS__ } SEAM(k); }
#define PHL(k, ...) if (IN(k)) { __VA_ARGS__ }
    unsigned char* ws = args.ws;
    float* X = args.out;
    bf16_t* XB = (bf16_t*)(ws + WS_ARENA + 928 * MiB);
    float* mod = (float*)(ws + WS_MOD);
    unsigned char* XO = (unsigned char*)args.out;
    bf16_t* S5BY = (bf16_t*)XO; bf16_t* S5BE = (bf16_t*)(XO + 96 * MiB); float* S5LT = (float*)(ws + 3 * MiB);
    float* HF8 = (float*)(XO + 128 * MiB); float* HB8 = (float*)(XO + 192 * MiB); float* HF4 = (float*)(XO + 256 * MiB); float* HB4 = (float*)(XO + 288 * MiB);
    bf16_t* H = (bf16_t*)(ws + WS_H); bf16_t* HO = (bf16_t*)(ws + WS_HO);
    bf16_t* Wgu = (bf16_t*)(ws + WS_W + W_GU); bf16_t* Wdn = (bf16_t*)(ws + WS_W + W_DN); bf16_t* Wmi = (bf16_t*)(ws + WS_W + W_MIN); bf16_t* Wmo = (bf16_t*)(ws + WS_W + W_MOUT);
    unsigned char* AR = ws + WS_ARENA;
    bf16_t* ACT = (bf16_t*)AR;
    const float* ng = ARG_IN(6);
#define MODL(layer, k) (mod + (size_t)(layer) * 6 * 12288 + (size_t)(k) * 2048)
#define NG(layer, k) (ng + ((layer) * 4 + (k)) * 2048)

    PH(0, ph_ada(args, lds, 0, 192, (int)blockIdx.x, (int)gridDim.x); __syncthreads();
        ph_hy_fwoT(ARG_IN(42), (bf16_t*)(ws + 2 * MiB));
        cvt_wT(ARG_IN(10), DM, 8256, Wmi, 0, lds); cvt_wT(ARG_IN(15), DM, DM, Wmo, 0, lds);)
    PH(1, ph_row<false, false>(ARG_IN(0), ARG_IN(1), nullptr, nullptr, nullptr, nullptr, NG(0, 0), MODL(0, 0), H);)
    bf16_t* DNP = (bf16_t*)AR; bf16_t* DNXT = (bf16_t*)(AR + 180 * MiB); bf16_t* DNO = (bf16_t*)(AR + 660 * MiB);
    bf16_t* DNHALO = (bf16_t*)(AR + 820 * MiB);
    PH(2, run_gemm(lds, H, Wmi, DN_LD, DM, pg8::EpiStoreTiled{DNP, DN_LD2, DNXT, DNHALO, 0, (bf16_t*)(AR + 850 * MiB), 8192, 64});
        if (blockIdx.x >= 160) { __syncthreads(); cvt_ffn_part(args, 0, lds, (int)blockIdx.x - 160, 96, nullptr, false); })
    PH(3, ph_conv_inplace(lds, DNXT, ARG_IN(11), DNHALO, 1);)
    PH(4, ph_dn_core2(args, lds, (const bf16_t*)(AR + 850 * MiB), DNXT, H, HO);
        if (blockIdx.x >= 192) { __syncthreads(); cvt_ffn_part(args, 0, lds, (int)blockIdx.x - 192, 64, nullptr, true); __syncthreads(); ph_s5_tables(args, lds, S5BY, S5BE, S5LT, (int)blockIdx.x - 192, 64); __syncthreads();
            ph_hy_filter(args, lds, (const bf16_t*)(ws + 2 * MiB), HF8, HB8, HF4, HB4, (int)blockIdx.x - 192, 64); __syncthreads(); cvt_wT(ARG_IN(26), DM, 10368, Wmi, 0, lds, (int)blockIdx.x - 192, 64); }
        else if (blockIdx.x >= 128) { __syncthreads(); ph_ada(args, lds, 192, 768, (int)blockIdx.x - 128, 64); })
    PH(5, ph_dn_combine(args, H, HO, DNP, DNO);)
    PH(6, run_gemm(lds, DNO, Wmo, DM, DM, pg8::EpiStoreT<false>{HO, DM, nullptr});)
    PH(7, ph_row<false, true>(ARG_IN(0), ARG_IN(1), (float*)XB, HO, NG(0, 1), MODL(0, 2), NG(0, 2), MODL(0, 3), H);)
    PH(8, run_gemm(lds, H, Wgu, 2 * DFF, DM, pg8::EpiSwiGLU{ACT, DFF}); if (blockIdx.x >= 128) { __syncthreads(); cvt_wT(ARG_IN(24), DM, DM, Wmo, 0, lds, (int)blockIdx.x - 128, 128); __syncthreads(); cvt_ffn_part(args, 1, lds, (int)blockIdx.x - 128, 128, AR + 856 * MiB, false); } else { __syncthreads(); cvt_ffn_part(args, 1, lds, (int)blockIdx.x, 128, AR + 856 * MiB, true); })
    PH(9, run_gemm(lds, ACT, Wdn, DM, DFF, pg8::EpiStoreT<false>{HO, DM, nullptr});)
    bf16_t* S5UG = (bf16_t*)AR; float* S5E = (float*)(AR + 368 * MiB);
    PH(10, ph_row<true, true>((const float*)XB, nullptr, (float*)XB, HO, NG(0, 3), MODL(0, 5), NG(1, 0), MODL(1, 0), nullptr, S5UG);
        )
    PH(11, run_gemm_s5(lds, S5UG, S5BE, 1, 512, 512, EpiS5E{S5E});)
    PH(12, ph_s5_scan(S5E, S5LT, S5UG);)
    PH(13, run_gemm_s5(lds, S5UG, S5BY, 2, 768, 768, EpiS5Y{H});)
    PH(14, run_gemm(lds, H, Wmo, DM, DM, pg8::EpiGLU{HO, DM, ARG_IN(25), H});)
    PH(15, ph_row<true, true>((const float*)XB, nullptr, (float*)XB, HO, NG(1, 1), MODL(1, 2), NG(1, 2), MODL(1, 3), H);)
    PH(16, run_gemm(lds, H, (const bf16_t*)(AR + 856 * MiB), 2 * DFF, DM, pg8::EpiSwiGLU{ACT, DFF}); if (blockIdx.x >= 128) { __syncthreads(); cvt_wT(ARG_IN(32), 4096, DM, Wmo, 0, lds, (int)blockIdx.x - 128, 128, ARG_IN(31)); __syncthreads(); cvt_ffn_part(args, 2, lds, (int)blockIdx.x - 128, 128, nullptr, false); } else { __syncthreads(); cvt_ffn_part(args, 2, lds, (int)blockIdx.x, 128, nullptr, true); })
    PH(17, run_gemm(lds, ACT, (const bf16_t*)(AR + 900 * MiB), DM, DFF, pg8::EpiStoreT<false>{HO, DM, nullptr});)
    PH(18, ph_row<true, true>((const float*)XB, nullptr, (float*)XB, HO, NG(1, 3), MODL(1, 5), NG(2, 0), MODL(2, 0), H);)
    bf16_t* SSP = (bf16_t*)AR; bf16_t* SSY = (bf16_t*)(ws + WS_H);
    bf16_t* HO2 = (bf16_t*)AR;
    bf16_t* SSHALO = (bf16_t*)(AR + 820 * MiB);
    bf16_t* SSXT = (bf16_t*)(AR + 340 * MiB);
    PH(19, run_gemm(lds, H, Wmi, SSD_LD, DM, pg8::EpiStoreTiled{SSP, SSD_LD2, SSXT, SSHALO, 4096, (bf16_t*)(AR + 850 * MiB), 10240, 128});)
    PH(20, ph_conv_inplace(lds, SSXT, ARG_IN(27), SSHALO, 0);)
#define SSD_ARGS (args, lds, (const bf16_t*)(AR + 850 * MiB), SSXT, SSY, (bf16_t*)(AR + 862 * MiB))
#ifdef SSD_PROBE
#define SSD_RUN { int nrep = 2; asm volatile("" : "+s"(nrep)); for (int rep = 0; rep < nrep; ++rep) { ph_ssd_core3<0> SSD_ARGS; if (rep + 1 < nrep) xcd_barrier(bar); } }
#else
#define SSD_RUN ph_ssd_core3<0> SSD_ARGS;
#endif
    PH(21, SSD_RUN)
    PH(22, ph_ssd_combine(args, SSY, SSP, (const bf16_t*)(AR + 862 * MiB));)
    PH(23, run_gemm(lds, SSY, Wmo, DM, 4096, pg8::EpiStoreT<false>{HO2, DM, nullptr});)
    PH(24, ph_row<true, true>((const float*)XB, nullptr, (float*)XB, HO2, NG(2, 1), MODL(2, 2), NG(2, 2), MODL(2, 3), H);)
    PH(25, run_gemm(lds, H, Wgu, 2 * DFF, DM, pg8::EpiSwiGLU{ACT, DFF}); if (blockIdx.x >= 128) { __syncthreads(); cvt_wT(ARG_IN(33), DM, 6144, Wmi, 0, lds, (int)blockIdx.x - 128, 128); cvt_wT(ARG_IN(45), DM, DM, Wmo, 0, lds, (int)blockIdx.x - 128, 128); __syncthreads(); cvt_ffn_part(args, 3, lds, (int)blockIdx.x - 128, 128, AR + 856 * MiB, false); } else { __syncthreads(); cvt_ffn_part(args, 3, lds, (int)blockIdx.x, 128, AR + 856 * MiB, true); })
    PH(26, run_gemm(lds, ACT, Wdn, DM, DFF, pg8::EpiStoreT<false>{HO, DM, nullptr});)
    PH(27, ph_row<true, true>((const float*)XB, nullptr, (float*)XB, HO, NG(2, 3), MODL(2, 5), NG(3, 0), MODL(3, 0), H);)
    bf16_t* HYP = (bf16_t*)AR; bf16_t* HYS = (bf16_t*)(AR + 480 * MiB);
    PH(28, run_gemm(lds, H, Wmi, HY_LD, DM, pg8::EpiStoreT<true>{HYP, HY_LD, ARG_IN(34)});)
    PH(29, ph_hy_prep(args, lds, HYP, HYS);)
    PH(30, ph_hy_fft(lds, HYS, HF8, HB8, HF4, HB4, (vf2*)(ws + WS_HO + 64 * MiB), ARG_IN(44));
        if (DUPMASK >> 63) { xcd_barrier(bar); ph_hy_prep(args, lds, HYP, HYS); xcd_barrier(bar); ph_hy_fft(lds, HYS, HF8, HB8, HF4, HB4, (vf2*)(ws + WS_HO + 64 * MiB), ARG_IN(44)); })
    PH(31, ph_hy_post(args, lds, HYP, HYS, H);)
    PH(32, run_gemm(lds, H, Wmo, DM, DM, pg8::EpiStoreT<true>{HO, DM, ARG_IN(46)});)
    PH(33, ph_row<true, true>((const float*)XB, nullptr, (float*)XB, HO, NG(3, 1), MODL(3, 2), NG(3, 2), MODL(3, 3), H);)
    PH(34, run_gemm(lds, H, (const bf16_t*)(AR + 856 * MiB), 2 * DFF, DM, pg8::EpiSwiGLU{ACT, DFF});)
    PH(35, run_gemm(lds, ACT, (const bf16_t*)(AR + 900 * MiB), DM, DFF, pg8::EpiStoreT<false>{HO, DM, nullptr});)
    PHL(36, ph_row<true, false>((const float*)XB, nullptr, X, HO, NG(3, 3), MODL(3, 5), nullptr, nullptr, nullptr);)
#undef IN
#undef SEAM
}

extern "C" void kernel_launch(void* const* d_in, const int* in_sizes, int n_in, void* d_out, int out_size, void* d_ws, size_t ws_size, hipStream_t stream) {
    static int grid = 0;
    if (grid == 0) {
        if (n_in != 47 || out_size != NTOK * DM || ws_size < WS_END) { fprintf(stderr, "kernel_launch: unexpected shapes (n_in %d, out %d, ws %zu); nothing launched\n", n_in, out_size, ws_size); grid = -1; return; }
        int dev = 0, cus = 0, per_cu = 0;
        if (hipGetDevice(&dev) != hipSuccess || hipDeviceGetAttribute(&cus, hipDeviceAttributeMultiprocessorCount, dev) != hipSuccess) { grid = -1; return; }
        if (hipFuncSetAttribute((const void*)mega_fwd, hipFuncAttributeMaxDynamicSharedMemorySize, LDS_BYTES) != hipSuccess) { fprintf(stderr, "kernel_launch: hipFuncSetAttribute failed\n"); grid = -1; return; }
        if (hipOccupancyMaxActiveBlocksPerMultiprocessor(&per_cu, (const void*)mega_fwd, NTHR, LDS_BYTES) != hipSuccess || per_cu < 1) { fprintf(stderr, "kernel_launch: occupancy query reports %d blocks per CU\n", per_cu); }
        (void)hipGetLastError();
        grid = cus;
    }
    if (grid < 0) return;
    (void)hipMemsetAsync((char*)d_ws + WS_BAR, 0, XCD_BAR_WORDS * sizeof(unsigned), stream);
    Args a{};
    for (int i = 0; i < 47; ++i) a.in[i] = (const float*)d_in[i];
    a.out = (float*)d_out; a.ws = (unsigned char*)d_ws;
#if MK_PER_PHASE
    for (int p = 0; p < N_PHASES; ++p) { a.ph_lo = p; a.ph_hi = p + 1; hipLaunchKernelGGL(mega_fwd, dim3(grid), dim3(NTHR), LDS_BYTES, stream, a); }
#else
    a.ph_lo = 0; a.ph_hi = N_PHASES;
    hipLaunchKernelGGL(mega_fwd, dim3(grid), dim3(NTHR), LDS_BYTES, stream, a);
#endif
}
```
